# Optimizing an MI355X kernel written in HIP

```python
import math
import jax
import jax.numpy as jnp
from jax import lax
import numpy as np

D_MODEL = 1024
BATCH = 4
SEQ = 8192
DEPTH = 4

MIX = D_MODEL
A_WIDTH = MIX // 2
M_WIDTH = MIX - A_WIDTH
A_HEADS = 4
A_DH = A_WIDTH // (2 * A_HEADS)
A_DV = 2 * A_DH
M_HEADS = 4
M_DH = M_WIDTH // M_HEADS
CONV_K = 4
CHUNK = 64
Q_BLOCK = 128
N_BUCKETS = 32
MAX_DIST = 128
D_FF = (7 * D_MODEL) // 2
N_EXPERTS = 8
TOP_K = 2
EPS = 1e-6
IN_SIZES = (A_WIDTH, A_WIDTH, A_WIDTH, M_WIDTH, M_WIDTH, M_WIDTH, M_WIDTH, M_HEADS, M_HEADS)
IN_W = sum(IN_SIZES)
IN_SPLITS = tuple(int(s) for s in np.cumsum(IN_SIZES)[:-1])

kernel_name = "hymba_diffattn_mlstm_moe_trunk"

F32 = jnp.float32


def rmsnorm(x, g):
    xf = x.astype(F32)
    y = xf * lax.rsqrt(jnp.mean(xf * xf, axis=-1, keepdims=True) + EPS)
    return (y * g.astype(F32)).astype(x.dtype)


def t5_bucket(n):
    max_exact = N_BUCKETS // 2
    nf = jnp.maximum(n, 1).astype(F32)
    large = max_exact + (jnp.log(nf / max_exact) / math.log(MAX_DIST / max_exact)
                         * (N_BUCKETS - max_exact)).astype(jnp.int32)
    large = jnp.minimum(large, N_BUCKETS - 1)
    return jnp.where(n < max_exact, n, large)


def causal_dwconv(x, w, b):
    S = x.shape[1]
    xp = jnp.pad(x, ((0, 0), (CONV_K - 1, 0), (0, 0)))
    y = b
    for j in range(CONV_K):
        y = y + xp[:, j:j + S] * w[j]
    return y


def diff_attention(q, k, v, lam, lam_init, dist_bias, norm_g):
    B, S = q.shape[0], q.shape[1]
    nb = S // Q_BLOCK
    q = q * (A_DH ** -0.5)
    kpos = jnp.arange(S)

    def block(i):
        q0 = i * Q_BLOCK
        qb = lax.dynamic_slice_in_dim(q, q0, Q_BLOCK, axis=1)
        dist = (q0 + jnp.arange(Q_BLOCK))[:, None] - kpos[None, :]
        bias = jnp.take(dist_bias, jnp.clip(dist, 0, S - 1), axis=1)
        s = jnp.einsum('bqhcd,bkhcd->bhcqk', qb, k).astype(F32) + bias[None, :, None]
        s = jnp.where(dist >= 0, s, -jnp.inf)
        p = jax.nn.softmax(s, axis=-1)
        a = p[:, :, 0] - lam * p[:, :, 1]
        return jnp.einsum('bhqk,bkhe->bqhe', a.astype(v.dtype), v)

    o = lax.map(block, jnp.arange(nb))
    o = jnp.moveaxis(o, 0, 1).reshape(B, S, A_HEADS, A_DV)
    return rmsnorm(o, norm_g) * (1.0 - lam_init)


def mlstm_chunkwise(q, k, v, i_pre, f_pre):
    B, S, H, d = q.shape
    nc = S // CHUNK

    def chunks(t):
        t = t.astype(F32).reshape((B, nc, CHUNK, H) + t.shape[3:])
        return jnp.moveaxis(t, 3, 1)

    qc, kc, vc = chunks(q), chunks(k * (d ** -0.5)), chunks(v)
    ig = chunks(i_pre)
    lf = jax.nn.log_sigmoid(chunks(f_pre))
    b = jnp.cumsum(lf, axis=-1)
    b_last = b[..., -1]
    a = b_last[..., None] - b + ig

    def step(carry, xs):
        C, n, m = carry
        a_c, bl_c, k_c, v_c = xs
        m_new = jnp.maximum(bl_c + m, jnp.max(a_c, axis=-1))
        decay = jnp.exp(bl_c + m - m_new)
        w = jnp.exp(a_c - m_new[..., None])
        C_new = decay[..., None, None] * C + jnp.einsum('bhl,bhlk,bhlv->bhkv', w, k_c, v_c)
        n_new = decay[..., None] * n + jnp.einsum('bhl,bhlk->bhk', w, k_c)
        return (C_new, n_new, m_new), (C, n, m)

    init = (jnp.zeros((B, H, d, d), F32), jnp.zeros((B, H, d), F32), jnp.zeros((B, H), F32))
    xs = (jnp.moveaxis(a, 2, 0), jnp.moveaxis(b_last, 2, 0),
          jnp.moveaxis(kc, 2, 0), jnp.moveaxis(vc, 2, 0))
    _, (C_prev, n_prev, m_prev) = lax.scan(step, init, xs)
    C_prev = jnp.moveaxis(C_prev, 0, 2)
    n_prev = jnp.moveaxis(n_prev, 0, 2)
    m_prev = jnp.moveaxis(m_prev, 0, 2)

    tri = jnp.tril(jnp.ones((CHUNK, CHUNK), dtype=bool))
    Dm = jnp.where(tri, b[..., :, None] - b[..., None, :] + ig[..., None, :], -jnp.inf)
    inter = b + m_prev[..., None]
    m_t = jnp.maximum(inter, jnp.max(Dm, axis=-1))
    Sw = jnp.einsum('bhnld,bhnsd->bhnls', qc, kc) * jnp.exp(Dm - m_t[..., None])
    dec = jnp.exp(inter - m_t)
    num = (dec[..., None] * jnp.einsum('bhnld,bhnde->bhnle', qc, C_prev)
           + jnp.einsum('bhnls,bhnse->bhnle', Sw, vc))
    den = dec * jnp.einsum('bhnld,bhnd->bhnl', qc, n_prev) + jnp.sum(Sw, axis=-1)
    h = num / jnp.maximum(jnp.abs(den), jnp.exp(-m_t))[..., None]
    return jnp.moveaxis(h, 1, 3).reshape(B, S, H, d)


def swiglu(t, w1, w3, w2):
    return (jax.nn.silu(t @ w1) * (t @ w3)) @ w2


def moe_swiglu(h, router_w, w1, w3, w2):
    B, S, D = h.shape
    t = h.reshape(B * S, D)
    logits = (t @ router_w).astype(F32)
    top_v, top_i = lax.top_k(logits, TOP_K)
    wts = jax.nn.softmax(top_v, axis=-1)
    gates = jnp.sum(jax.nn.one_hot(top_i, N_EXPERTS, dtype=F32) * wts[..., None], axis=1)
    out = jnp.zeros_like(t)
    for e in range(N_EXPERTS):
        out = out + gates[:, e:e + 1].astype(t.dtype) * swiglu(t, w1[e], w3[e], w2[e])
    return out.reshape(B, S, D)


def setup_inputs(seed: int = 0) -> dict:
    key = jax.random.key(seed)
    ks = jax.random.split(key, 24)
    n_dense = (DEPTH + 1) // 2
    n_moe = DEPTH // 2
    D = D_MODEL
    nrm = jax.random.normal
    gate_b = jnp.stack([
        0.1 * nrm(ks[8], (DEPTH, M_HEADS), F32),
        jnp.linspace(3.0, 6.0, M_HEADS, dtype=F32)[None, :] + 0.1 * nrm(ks[9], (DEPTH, M_HEADS), F32),
    ], axis=1)
    return {
        "x": nrm(ks[0], (BATCH, SEQ, D), F32),
        "c": nrm(ks[1], (BATCH, D), F32),
        "rel_bias": 0.5 * nrm(ks[2], (N_BUCKETS, A_HEADS), F32),
        "ada_w": 0.5 * D ** -0.5 * nrm(ks[3], (DEPTH, D, 6 * D), F32),
        "ada_b": 0.02 * nrm(ks[4], (DEPTH, 6 * D), F32),
        "norm_g": 1.0 + 0.05 * nrm(ks[5], (DEPTH, 4, D), F32),
        "w_in": D ** -0.5 * nrm(ks[6], (DEPTH, D, IN_W), F32),
        "gate_b": gate_b,
        "conv_w": CONV_K ** -0.5 * nrm(ks[10], (DEPTH, CONV_K, 2 * M_WIDTH), F32),
        "conv_b": 0.02 * nrm(ks[11], (DEPTH, 2 * M_WIDTH), F32),
        "lam_vec": 0.1 * nrm(ks[12], (DEPTH, 4, A_DH), F32),
        "attn_norm_g": 1.0 + 0.05 * nrm(ks[13], (DEPTH, A_DV), F32),
        "mlstm_norm_g": 1.0 + 0.05 * nrm(ks[14], (DEPTH, M_WIDTH), F32),
        "w_out": MIX ** -0.5 * nrm(ks[15], (DEPTH, MIX, D), F32),
        "ffn_w1": D ** -0.5 * nrm(ks[16], (n_dense, D, D_FF), F32),
        "ffn_w3": D ** -0.5 * nrm(ks[17], (n_dense, D, D_FF), F32),
        "ffn_w2": D_FF ** -0.5 * nrm(ks[18], (n_dense, D_FF, D), F32),
        "router_w": D ** -0.5 * nrm(ks[19], (n_moe, D, N_EXPERTS), F32),
        "moe_w1": D ** -0.5 * nrm(ks[20], (n_moe, N_EXPERTS, D, D_FF), F32),
        "moe_w3": D ** -0.5 * nrm(ks[21], (n_moe, N_EXPERTS, D, D_FF), F32),
        "moe_w2": D_FF ** -0.5 * nrm(ks[22], (n_moe, N_EXPERTS, D_FF, D), F32),
    }


def reference(x, c, rel_bias, ada_w, ada_b, norm_g, w_in, gate_b, conv_w, conv_b, lam_vec,
              attn_norm_g, mlstm_norm_g, w_out, ffn_w1, ffn_w3, ffn_w2, router_w,
              moe_w1, moe_w3, moe_w2):
    B, S, D = x.shape
    dist_bias = rel_bias[t5_bucket(jnp.arange(S, dtype=jnp.int32))].T.astype(F32)
    c_act = jax.nn.silu(c)
    for i in range(DEPTH):
        mod = c_act @ ada_w[i] + ada_b[i]
        sh1, sc1, g1, sh2, sc2, g2 = jnp.split(mod, 6, axis=-1)

        h = rmsnorm(x, norm_g[i, 0]) * (1.0 + sc1[:, None]) + sh1[:, None]
        proj = h @ w_in[i]
        aq, ak, av, mq, mk, mv, mo, mi, mf = jnp.split(proj, IN_SPLITS, axis=-1)

        lv = lam_vec[i].astype(F32)
        lam_init = 0.8 - 0.6 * math.exp(-0.3 * i)
        lam = jnp.exp(jnp.sum(lv[0] * lv[1])) - jnp.exp(jnp.sum(lv[2] * lv[3])) + lam_init
        a_out = diff_attention(aq.reshape(B, S, A_HEADS, 2, A_DH),
                               ak.reshape(B, S, A_HEADS, 2, A_DH),
                               av.reshape(B, S, A_HEADS, A_DV),
                               lam, lam_init, dist_bias, attn_norm_g[i])

        qk = jax.nn.silu(causal_dwconv(jnp.concatenate([mq, mk], axis=-1), conv_w[i], conv_b[i]))
        mq_c, mk_c = jnp.split(qk, 2, axis=-1)
        h_t = mlstm_chunkwise(mq_c.reshape(B, S, M_HEADS, M_DH),
                              mk_c.reshape(B, S, M_HEADS, M_DH),
                              mv.reshape(B, S, M_HEADS, M_DH),
                              mi + gate_b[i, 0], mf + gate_b[i, 1])
        h_m = jax.nn.sigmoid(mo.astype(F32)).reshape(B, S, M_HEADS, M_DH) * h_t
        h_m = rmsnorm(h_m, mlstm_norm_g[i].reshape(M_HEADS, M_DH)).astype(x.dtype)

        mixed = jnp.concatenate([a_out.reshape(B, S, A_WIDTH), h_m.reshape(B, S, M_WIDTH)], axis=-1)
        y = mixed @ w_out[i]
        x = x + g1[:, None] * rmsnorm(y, norm_g[i, 1])

        h = rmsnorm(x, norm_g[i, 2]) * (1.0 + sc2[:, None]) + sh2[:, None]
        if i % 2 == 0:
            j = i // 2
            y = swiglu(h, ffn_w1[j], ffn_w3[j], ffn_w2[j])
        else:
            j = i // 2
            y = moe_swiglu(h, router_w[j], moe_w1[j], moe_w3[j], moe_w2[j])
        x = x + g2[:, None] * rmsnorm(y, norm_g[i, 3])
    return x
```

```cpp
#include <hip/hip_runtime.h>
#include <cstdio>
#include <cstdint>
namespace pg8 {
#define PG8_LAS __attribute__((address_space(3)))
typedef unsigned short bf16_t;
typedef short bf16x8 __attribute__((ext_vector_type(8)));
typedef float f32x4 __attribute__((ext_vector_type(4)));
typedef unsigned u32x4 __attribute__((ext_vector_type(4)));
constexpr int BM = 256, BK = 64, HALF = 128, HTB = HALF * BK * 2  , STAGE_BYTES = 8 * HTB, NXCD = 8, WGM = 8;

__host__ __device__ __forceinline__ int lds_byte(int r, int c) { const int st = (r >> 4) * 2 + (c >> 5), rr = r & 15, cc = c & 31, ob = rr * 64 + cc * 2; return st * 1024 + (ob ^ (((ob >> 9) & 1) << 5)); }
__host__ __device__ __forceinline__ void stage_rc(int b, int& R, int& C) { const int st = b / 1024, sb = b % 1024, swz = sb ^ (((sb >> 9) & 1) << 5); R = (st >> 1) * 16 + swz / 64; C = (st & 1) * 32 + (swz % 64) / 2; }
__host__ __device__ __forceinline__ int perm32(int rho) { const int n = rho >> 4, i = rho & 15; return 8 * (i >> 2) + 4 * n + (i & 3); }

struct Unit { int pm, pn; };
struct Gemm { const bf16_t* A; const bf16_t* Bt; int M, N, K; };

struct StaticOrder {
    int nM, nN, nwg, G, c;
    __host__ __device__ void init(int M, int N, int G_, int c_) { nM = M / BM; nN = N / BM; nwg = nM * nN; G = G_; c = c_; }
    __host__ __device__ bool next(int i, Unit& u) const {
        const long L = (long)i * G + c; if (L >= nwg) return false;
        int wgid = (int)L; { const int q = nwg / NXCD, r = nwg % NXCD, xcd = wgid % NXCD, off = wgid / NXCD; wgid = (xcd < r ? xcd * (q + 1) : r * (q + 1) + (xcd - r) * q) + off; }
        const int nig = WGM * nN, gid = wgid / nig, fm = gid * WGM, gsz = (nM - fm) < WGM ? (nM - fm) : WGM;
        u.pm = fm + ((wgid % nig) % gsz); u.pn = (wgid % nig) / gsz; return true;
    }
    __device__ __forceinline__ void a_ready(const Unit&) const {}
    __device__ __forceinline__ void done(const Unit&) const {}
};

__device__ __forceinline__ unsigned cvt_pk_bf16(float lo, float hi) { unsigned r; asm volatile("v_cvt_pk_bf16_f32 %0, %1, %2" : "=v"(r) : "v"(lo), "v"(hi)); return r; }
typedef float f32x2 __attribute__((ext_vector_type(2)));
__device__ __forceinline__ f32x2 gelu_pk(f32x2 v) {
    const f32x2 av = __builtin_elementwise_abs(v), d = av * 0.2316418882f + 1.0f;
    f32x2 t; t.x = __builtin_amdgcn_rcpf(d.x); t.y = __builtin_amdgcn_rcpf(d.y);
    f32x2 q = t * 0.5307027145f + (-0.7265760135f); q = q * t + 0.7107068705f; q = q * t + (-0.142248368f); q = q * t + 0.127414796f; q = q * t;
    const f32x2 s = (v * v) * (-0.72134752044f);
    f32x2 e; e.x = __builtin_amdgcn_exp2f(s.x); e.y = __builtin_amdgcn_exp2f(s.y);
    const f32x2 m = v * (q * e), r = v - m;
    f32x2 o; o.x = v.x < 0.f ? m.x : r.x; o.y = v.y < 0.f ? m.y : r.y; return o;
}

template <int ACT  > struct EpiBf16 {
    static constexpr bool PERM = true, AFTER_DRAIN = false; static_assert(ACT == 0 || ACT == 1, "EpiBf16: ACT is 0 (none) or 1 (gelu_pk)");
    bf16_t* O; int ldc; const float* bias; int split_cols; size_t split_stride; float scale0;
    __device__ __forceinline__ void operator()(const f32x4 (&acc)[2][2][4][2], const Unit& u, int wr, int wc, int fr, int fq) const {
        const int row0 = u.pm * BM + wr * 64 + fr; int colt = u.pn * BM; bf16_t* base = O;
        float sc = 1.f; if (split_cols) { const int t = colt / split_cols; base += (size_t)t * split_stride; colt -= t * split_cols; if (t == 0) sc = scale0; }
        const int col0 = colt + wc * 32 + 8 * fq, bcol0 = u.pn * BM + wc * 32 + 8 * fq;
        f32x4 bv[2][2];
#pragma unroll
        for (int bj = 0; bj < 2; ++bj)
#pragma unroll
            for (int n = 0; n < 2; ++n) bv[bj][n] = bias ? *(const f32x4*)(bias + bcol0 + bj * HALF + 4 * n) : (f32x4){0.f, 0.f, 0.f, 0.f};
#pragma unroll
        for (int ai = 0; ai < 2; ++ai)
#pragma unroll
            for (int m = 0; m < 4; ++m) { bf16_t* rowp = base + (size_t)(row0 + ai * HALF + m * 16) * ldc + col0;
#pragma unroll
                for (int bj = 0; bj < 2; ++bj) { f32x4 v0 = acc[ai][bj][m][0] + bv[bj][0], v1 = acc[ai][bj][m][1] + bv[bj][1];
                    if (ACT == 1) { f32x2 a = gelu_pk((f32x2){v0[0], v0[1]}), b = gelu_pk((f32x2){v0[2], v0[3]}), c = gelu_pk((f32x2){v1[0], v1[1]}), d = gelu_pk((f32x2){v1[2], v1[3]});
                        v0 = (f32x4){a.x, a.y, b.x, b.y}; v1 = (f32x4){c.x, c.y, d.x, d.y}; }
                    v0 = v0 * sc; v1 = v1 * sc; u32x4 w; w.x = cvt_pk_bf16(v0[0], v0[1]); w.y = cvt_pk_bf16(v0[2], v0[3]); w.z = cvt_pk_bf16(v1[0], v1[1]); w.w = cvt_pk_bf16(v1[2], v1[3]);
                    *(u32x4*)(rowp + bj * HALF) = w; } }
    }
};


template <class Epi, class Sched, bool ALIGN_EPI = false, bool SP2 = false>
__device__ __forceinline__ void gemm_phase(PG8_LAS unsigned char* lds, const Gemm g, const Sched& S, const Epi& E, const int tid) {
    const int wid = __builtin_amdgcn_readfirstlane(tid >> 6), lane = tid & 63, wr = wid >> 2, wc = wid & 3, fr = lane & 15, fq = lane >> 4;
    const int K = g.K, nt = K / BK;
    unsigned voffA[2], voffB[2];
#pragma unroll
    for (int i = 0; i < 2; ++i) { int R, C; stage_rc(tid * 16 + i * 8192, R, C); const int Rb = Epi::PERM ? ((R & ~31) + perm32(R & 31)) : R;
        voffA[i] = (unsigned)(R * K + C) * 2u; voffB[i] = (unsigned)(Rb * K + C) * 2u; }
    const size_t kstep = (size_t)(BK * 2);
    const size_t hstep = (size_t)HALF * K * 2;
    const size_t tstep = 2 * hstep;
    const unsigned ldsw = (unsigned)wid * 1024u;
    const int aoff = lds_byte(wr * 64 + fr, fq * 8), boff = lds_byte(wc * 32 + fr, fq * 8);
#define PG8_SA(b, h) (((b) * 2 + (h)) * HTB)
#define PG8_SB(b, h) ((4 + (b) * 2 + (h)) * HTB)
#define PG8_STAGE(bufoff, gbase, voff) do { _Pragma("unroll") for (int _i = 0; _i < 2; ++_i) \
        __builtin_amdgcn_global_load_lds((const unsigned*)((const char*)(gbase) + (voff)[_i]), (PG8_LAS unsigned*)(lds + (bufoff) + ldsw + _i * 8192), 16, 0, 0); } while (0)
#define PG8_LDA(dst, b, h) do { _Pragma("unroll") for (int m = 0; m < 4; ++m) _Pragma("unroll") for (int k = 0; k < 2; ++k) dst[m][k] = *(const PG8_LAS bf16x8*)(lds + PG8_SA(b, h) + aoff + m * 2048 + k * 1024); } while (0)
#define PG8_LDB(dst, b, h) do { _Pragma("unroll") for (int n = 0; n < 2; ++n) _Pragma("unroll") for (int k = 0; k < 2; ++k) dst[n][k] = *(const PG8_LAS bf16x8*)(lds + PG8_SB(b, h) + boff + n * 2048 + k * 1024); } while (0)
#define PG8_MMA(ai, bj, At, Bt) do { __builtin_amdgcn_s_setprio(1); _Pragma("unroll") for (int m = 0; m < 4; ++m) _Pragma("unroll") for (int n = 0; n < 2; ++n) _Pragma("unroll") for (int k = 0; k < 2; ++k) \
        acc[ai][bj][m][n] = __builtin_amdgcn_mfma_f32_16x16x32_bf16(Bt[n][k], At[m][k], acc[ai][bj][m][n], 0, 0, 0); __builtin_amdgcn_s_setprio(0); } while (0)
#define PG8_WAIT_V(n) asm volatile("s_waitcnt vmcnt(" #n ")" ::: "memory")
#define PG8_WAIT_L(n) asm volatile("s_waitcnt lgkmcnt(" #n ")" ::: "memory")
#define PG8_BAR __builtin_amdgcn_s_barrier()
#define PG8_SCHED __builtin_amdgcn_sched_barrier(0)
    Unit cur, nxt; int ui = 0;
    if (!S.next(0, cur)) return;
    f32x4 acc[2][2][4][2];
#pragma unroll
    for (int a = 0; a < 2; ++a)
#pragma unroll
        for (int b = 0; b < 2; ++b)
#pragma unroll
            for (int m = 0; m < 4; ++m)
#pragma unroll
                for (int n = 0; n < 2; ++n) acc[a][b][m][n] = (f32x4){0.f, 0.f, 0.f, 0.f};
    bf16x8 At[4][2], B0[2][2], B1[2][2];
    const char* cA = (const char*)g.A + (size_t)cur.pm * tstep; const char* cB = (const char*)g.Bt + (size_t)cur.pn * tstep;
    S.a_ready(cur);
    if constexpr (SP2) {
        PG8_STAGE(PG8_SB(0, 0), cB, voffB); PG8_STAGE(PG8_SB(0, 1), cB + hstep, voffB); PG8_STAGE(PG8_SA(0, 0), cA, voffA); PG8_STAGE(PG8_SA(0, 1), cA + hstep, voffA);
        if (wr == 1) PG8_BAR;
        PG8_WAIT_V(2); PG8_BAR;
        PG8_STAGE(PG8_SB(1, 0), cB + kstep, voffB); PG8_STAGE(PG8_SA(1, 0), cA + kstep, voffA); PG8_STAGE(PG8_SB(1, 1), cB + hstep + kstep, voffB);
        PG8_WAIT_V(6); PG8_BAR;
    } else {
        PG8_STAGE(PG8_SB(0, 0), cB, voffB); PG8_STAGE(PG8_SA(0, 0), cA, voffA); PG8_STAGE(PG8_SB(0, 1), cB + hstep, voffB); PG8_STAGE(PG8_SA(0, 1), cA + hstep, voffA);
        if (wr == 1) PG8_BAR;
        PG8_WAIT_V(4); PG8_BAR;
        PG8_STAGE(PG8_SB(1, 0), cB + kstep, voffB); PG8_STAGE(PG8_SA(1, 0), cA + kstep, voffA); PG8_STAGE(PG8_SB(1, 1), cB + hstep + kstep, voffB);
        PG8_WAIT_V(6); PG8_BAR;
    }
    for (;;) {
        const bool has_next = S.next(ui + 1, nxt);
        const char* nA = has_next ? (const char*)g.A + (size_t)nxt.pm * tstep : cA; const char* nB = has_next ? (const char*)g.Bt + (size_t)nxt.pn * tstep : cB;
        for (int t = 0; t < nt; t += 2) {
            const bool last = (t == nt - 2);
            const char* a1 = cA + (size_t)(t + 1) * kstep;
            const char* a2 = last ? nA : cA + (size_t)(t + 2) * kstep; const char* b2 = last ? nB : cB + (size_t)(t + 2) * kstep;
            const char* a3 = a2 + kstep; const char* b3 = b2 + kstep;
            if (last && has_next) S.a_ready(nxt);
            if constexpr (SP2) {
            PG8_LDB(B0, 0, 0); PG8_LDB(B1, 0, 1); PG8_SCHED; PG8_LDA(At, 0, 0); PG8_STAGE(PG8_SA(1, 1), a1 + hstep, voffA);
            PG8_WAIT_V(8); PG8_WAIT_L(0); PG8_BAR; PG8_MMA(0, 0, At, B0); PG8_MMA(0, 1, At, B1); PG8_BAR; PG8_SCHED;
            PG8_LDA(At, 0, 1); PG8_STAGE(PG8_SB(0, 0), b2, voffB); PG8_STAGE(PG8_SB(0, 1), b2 + hstep, voffB); PG8_STAGE(PG8_SA(0, 0), a2, voffA);
            PG8_WAIT_V(8); PG8_WAIT_L(0); PG8_BAR; PG8_MMA(1, 0, At, B0); PG8_MMA(1, 1, At, B1); PG8_BAR; PG8_SCHED;
            PG8_LDB(B0, 1, 0); PG8_LDB(B1, 1, 1); PG8_SCHED; PG8_LDA(At, 1, 0); PG8_STAGE(PG8_SA(0, 1), a2 + hstep, voffA);
            PG8_WAIT_V(8); PG8_WAIT_L(0); PG8_BAR; PG8_MMA(0, 0, At, B0); PG8_MMA(0, 1, At, B1); PG8_BAR; PG8_SCHED;
            PG8_LDA(At, 1, 1); PG8_STAGE(PG8_SB(1, 0), b3, voffB); PG8_STAGE(PG8_SB(1, 1), b3 + hstep, voffB); PG8_STAGE(PG8_SA(1, 0), a3, voffA);
            PG8_WAIT_V(8); PG8_WAIT_L(0); PG8_BAR; PG8_MMA(1, 0, At, B0); PG8_MMA(1, 1, At, B1); PG8_BAR; PG8_SCHED;
            } else {
            PG8_LDB(B0, 0, 0); PG8_SCHED; PG8_LDA(At, 0, 0); PG8_STAGE(PG8_SA(1, 1), a1 + hstep, voffA);
            PG8_WAIT_L(8); PG8_BAR; PG8_WAIT_L(0); PG8_MMA(0, 0, At, B0); PG8_BAR; PG8_SCHED;
            PG8_LDB(B1, 0, 1); PG8_STAGE(PG8_SB(0, 0), b2, voffB);
            PG8_BAR; PG8_WAIT_L(0); PG8_MMA(0, 1, At, B1); PG8_BAR;
            PG8_LDA(At, 0, 1); PG8_STAGE(PG8_SA(0, 0), a2, voffA);
            PG8_BAR; PG8_WAIT_L(0); PG8_MMA(1, 0, At, B0); PG8_BAR; PG8_SCHED;
            PG8_STAGE(PG8_SB(0, 1), b2 + hstep, voffB);
            PG8_WAIT_V(6); PG8_BAR; PG8_MMA(1, 1, At, B1); PG8_BAR;
            PG8_LDB(B0, 1, 0); PG8_SCHED; PG8_LDA(At, 1, 0); PG8_STAGE(PG8_SA(0, 1), a2 + hstep, voffA);
            PG8_WAIT_L(8); PG8_BAR; PG8_WAIT_L(0); PG8_MMA(0, 0, At, B0); PG8_BAR; PG8_SCHED;
            PG8_LDB(B1, 1, 1); PG8_STAGE(PG8_SB(1, 0), b3, voffB);
            PG8_BAR; PG8_WAIT_L(0); PG8_MMA(0, 1, At, B1); PG8_BAR;
            PG8_LDA(At, 1, 1); PG8_STAGE(PG8_SA(1, 0), a3, voffA);
            PG8_BAR; PG8_WAIT_L(0); PG8_MMA(1, 0, At, B0); PG8_BAR; PG8_SCHED;
            PG8_STAGE(PG8_SB(1, 1), b3 + hstep, voffB);
            PG8_WAIT_V(6); PG8_BAR; PG8_MMA(1, 1, At, B1); PG8_BAR;
            }
        }
        if constexpr (ALIGN_EPI) { if (wr == 0) PG8_BAR; }
        if constexpr (!Epi::AFTER_DRAIN) { E(acc, cur, wr, wc, fr, fq); S.done(cur); }
        if (!has_next) break;
#pragma unroll
        for (int a = 0; a < 2; ++a)
#pragma unroll
            for (int b = 0; b < 2; ++b)
#pragma unroll
                for (int m = 0; m < 4; ++m)
#pragma unroll
                    for (int n = 0; n < 2; ++n) acc[a][b][m][n] = (f32x4){0.f, 0.f, 0.f, 0.f};
        cur = nxt; cA = nA; cB = nB; ++ui;
        if constexpr (ALIGN_EPI) { if (wr == 1) PG8_BAR; }
    }
    PG8_WAIT_V(0);
    if constexpr (!ALIGN_EPI) { if (wr == 0) PG8_BAR; }
    PG8_BAR;
    if constexpr (Epi::AFTER_DRAIN) { E.fused(acc, cur, wr, wc, fr, fq, lds, wid, lane); S.done(cur); }
#undef PG8_SA
#undef PG8_SB
#undef PG8_STAGE
#undef PG8_LDA
#undef PG8_LDB
#undef PG8_MMA
#undef PG8_WAIT_V
#undef PG8_WAIT_L
#undef PG8_BAR
#undef PG8_SCHED
}
}

#ifndef PG8_SP2
#define PG8_SP2 true
#endif
#ifndef PG8_ALIGN
#define PG8_ALIGN true
#endif
namespace pg8 {
struct EpiPlain {
    static constexpr bool PERM = true, AFTER_DRAIN = false;
    bf16_t* O; int ldc; int qcols; float scale0; int pn_mod;
    __device__ __forceinline__ void operator()(const f32x4 (&acc)[2][2][4][2], const Unit& u, int wr, int wc, int fr, int fq) const {
        const int pn = pn_mod ? (u.pn % pn_mod) : u.pn;
        const int colt = pn * BM; const float sc = (colt < qcols) ? scale0 : 1.f;
        const int row0 = u.pm * BM + wr * 64 + fr, col0 = colt + wc * 32 + 8 * fq;
#pragma unroll
        for (int ai = 0; ai < 2; ++ai)
#pragma unroll
            for (int m = 0; m < 4; ++m) { bf16_t* rowp = O + (size_t)(row0 + ai * HALF + m * 16) * ldc + col0;
#pragma unroll
                for (int bj = 0; bj < 2; ++bj) { const f32x4 v0 = acc[ai][bj][m][0] * sc, v1 = acc[ai][bj][m][1] * sc;
                    u32x4 w; w.x = cvt_pk_bf16(v0[0], v0[1]); w.y = cvt_pk_bf16(v0[2], v0[3]); w.z = cvt_pk_bf16(v1[0], v1[1]); w.w = cvt_pk_bf16(v1[2], v1[3]);
                    *(u32x4*)(rowp + bj * HALF) = w; } }
    }
};
__device__ __forceinline__ float silu_f(float x) { return x * __builtin_amdgcn_rcpf(1.0f + __builtin_amdgcn_exp2f(-1.4426950408889634f * x)); }
struct EpiSwiglu {
    static constexpr bool PERM = true, AFTER_DRAIN = false;
    bf16_t* O; int ldc; int pn_mod;
    __device__ __forceinline__ void operator()(const f32x4 (&acc)[2][2][4][2], const Unit& u, int wr, int wc, int fr, int fq) const {
        const int pn = pn_mod ? (u.pn % pn_mod) : u.pn;
        const int row0 = u.pm * BM + wr * 64 + fr, col0 = pn * HALF + wc * 32 + 8 * fq;
#pragma unroll
        for (int ai = 0; ai < 2; ++ai)
#pragma unroll
            for (int m = 0; m < 4; ++m) { bf16_t* rowp = O + (size_t)(row0 + ai * HALF + m * 16) * ldc + col0;
                const f32x4 g0 = acc[ai][0][m][0], g1 = acc[ai][0][m][1], u0 = acc[ai][1][m][0], u1 = acc[ai][1][m][1];
                float h[8];
#pragma unroll
                for (int i = 0; i < 4; ++i) { h[i] = silu_f(g0[i]) * u0[i]; h[4 + i] = silu_f(g1[i]) * u1[i]; }
                u32x4 w; w.x = cvt_pk_bf16(h[0], h[1]); w.y = cvt_pk_bf16(h[2], h[3]); w.z = cvt_pk_bf16(h[4], h[5]); w.w = cvt_pk_bf16(h[6], h[7]);
                *(u32x4*)rowp = w; }
    }
};
struct MoeOrder {
    int pt1, pt2, pt3, pt4, pt5, pt6, pt7, pt8; int NT, G, c, nwg;
    __device__ __forceinline__ void init(const unsigned* cnt, int NT_, int G_, int c_) {
        NT = NT_; G = G_; c = c_;
        pt1 = (int)((cnt[0] + 255u) >> 8); pt2 = pt1 + (int)((cnt[1] + 255u) >> 8); pt3 = pt2 + (int)((cnt[2] + 255u) >> 8); pt4 = pt3 + (int)((cnt[3] + 255u) >> 8);
        pt5 = pt4 + (int)((cnt[4] + 255u) >> 8); pt6 = pt5 + (int)((cnt[5] + 255u) >> 8); pt7 = pt6 + (int)((cnt[6] + 255u) >> 8); pt8 = pt7 + (int)((cnt[7] + 255u) >> 8);
        nwg = pt8 * NT;
    }
    __device__ __forceinline__ bool next(int i, Unit& u) const {
        const long L = (long)i * G + c; if (L >= nwg) return false;
        int wgid = (int)L; { const int q = nwg / NXCD, r = nwg % NXCD, xcd = wgid % NXCD, off = wgid / NXCD; wgid = (xcd < r ? xcd * (q + 1) : r * (q + 1) + (xcd - r) * q) + off; }
        int e = 0, lo = 0, hi = pt1;
        if (wgid >= pt1 * NT) { e = 1; lo = pt1; hi = pt2; }
        if (wgid >= pt2 * NT) { e = 2; lo = pt2; hi = pt3; }
        if (wgid >= pt3 * NT) { e = 3; lo = pt3; hi = pt4; }
        if (wgid >= pt4 * NT) { e = 4; lo = pt4; hi = pt5; }
        if (wgid >= pt5 * NT) { e = 5; lo = pt5; hi = pt6; }
        if (wgid >= pt6 * NT) { e = 6; lo = pt6; hi = pt7; }
        if (wgid >= pt7 * NT) { e = 7; lo = pt7; hi = pt8; }
        const int j = wgid - lo * NT, nM = hi - lo;
        const int nig = WGM * NT, gid = j / nig, fm = gid * WGM, gsz = (nM - fm) < WGM ? (nM - fm) : WGM;
        u.pm = lo + fm + ((j % nig) % gsz); u.pn = e * NT + (j % nig) / gsz; return true;
    }
    __device__ __forceinline__ void a_ready(const Unit&) const {}
    __device__ __forceinline__ void done(const Unit&) const {}
};
}
#include <hip/hip_bf16.h>
#include <cmath>
namespace attn_body {
using bf16=__hip_bfloat16;
using bf16x8=__attribute__((ext_vector_type(8)))short;
using s16x4=__attribute__((ext_vector_type(4)))short;
using f32x16=__attribute__((ext_vector_type(16)))float;
using u32x4=__attribute__((ext_vector_type(4)))unsigned;
constexpr int BATCH=4,SEQ=8192,D=64,DM=3584,DMO=1024;
constexpr int NW=8,QBLK=32,QB=QBLK*NW,KVBLK=64,NQB=SEQ/QB;
constexpr int ATTN_UNIT_ROWS=QB;
__device__ __forceinline__ int crow(int r,int hi){return (r&3)+8*(r>>2)+4*hi;}
#define SBAR() __builtin_amdgcn_sched_barrier(0)
__device__ __forceinline__ void cmask(f32x16&p0,f32x16&p1,int jb,int qrel,int hi){
  const float NEG=-INFINITY; int kb=64*jb+4*hi;
  #pragma unroll
  for(int r=0;r<16;++r){int kv=kb+(r&3)+8*(r>>2); if(kv>qrel)p0[r]=NEG; if(kv+32>qrel)p1[r]=NEG;}
}

typedef const __attribute__((address_space(3))) float* lds_cfptr;
__device__ __forceinline__ void bmask(f32x16&p0,f32x16&p1,int jb,int qrel,int hi,lds_cfptr tabR){
  int j0=383-(qrel-64*jb-4*hi); j0=j0>452?452:j0; const lds_cfptr tp=tabR+j0;
  #pragma unroll
  for(int r=0;r<16;++r){const int c=(r&3)+8*(r>>2); p0[r]+=tp[c]; p1[r]+=tp[c+32];}
  if(jb>=0)cmask(p0,p1,jb,qrel,hi);
}
constexpr int NSLOT=3, SLOTB=8192;
constexpr int LDS_K=0, LDS_V=NSLOT*SLOTB, LDS_WS=2*NSLOT*SLOTB, LDS_OST=LDS_WS+NW*64*4, LDS_BYTES=LDS_OST+NW*4096;
constexpr float C2=0.125f*1.4426950408889634f;
__device__ __forceinline__ void glds16(const void*gsrc,unsigned lds_dst){unsigned keep;
  asm volatile("s_mov_b32 %0, m0\n\ts_mov_b32 m0, %2\n\ts_nop 0\n\tglobal_load_lds_dwordx4 %1, off\n\ts_mov_b32 m0, %0":"=&s"(keep):"v"(gsrc),"s"(lds_dst):"memory");}
__device__ __forceinline__ float max3f(float a,float b,float c){float r;asm("v_max3_f32 %0, %1, %2, %3":"=v"(r):"v"(a),"v"(b),"v"(c));return r;}
__device__ __forceinline__ float max2f(float a,float b){float r;asm("v_max_f32_e32 %0, %1, %2":"=v"(r):"v"(a),"v"(b));return r;}
__device__ __forceinline__ float fadd_s(float a,float b){float r;asm("v_add_f32_e32 %0, %1, %2":"=v"(r):"v"(a),"v"(b));return r;}
__device__ __forceinline__ float fsub_s(float a,float b){float r;asm("v_sub_f32_e32 %0, %1, %2":"=v"(r):"v"(a),"v"(b));return r;}
typedef float f32x2_t __attribute__((ext_vector_type(2))); typedef __bf16 bf16x2_t __attribute__((ext_vector_type(2)));
__device__ __forceinline__ unsigned cvtpk_s(float lo,float hi){f32x2_t v={lo,hi};bf16x2_t b=__builtin_convertvector(v,bf16x2_t);return __builtin_bit_cast(unsigned,b);}
#define WAIT_BAR(N) asm volatile("s_waitcnt vmcnt(" #N ") lgkmcnt(0)\n\ts_barrier":::"memory")

__device__ __forceinline__ void qkt(f32x16&p0,f32x16&p1,const char*Kslot,const bf16x8*qr,const f32x16&negm,int r32,int hi){
  const char*kb=Kslot+hi*1024+r32*16;
  #pragma unroll
  for(int d0=0;d0<4;++d0){
    const bf16x8 b0=*reinterpret_cast<const bf16x8*>(kb+d0*2048);
    const bf16x8 b1=*reinterpret_cast<const bf16x8*>(kb+d0*2048+512);
    if(d0==0){p0=__builtin_amdgcn_mfma_f32_32x32x16_bf16(b0,qr[0],negm,0,0,0);p1=__builtin_amdgcn_mfma_f32_32x32x16_bf16(b1,qr[0],negm,0,0,0);}
    else{p0=__builtin_amdgcn_mfma_f32_32x32x16_bf16(b0,qr[d0],p0,0,0,0);p1=__builtin_amdgcn_mfma_f32_32x32x16_bf16(b1,qr[d0],p1,0,0,0);}}
}
typedef __attribute__((address_space(3))) const char* lds_cptr;
typedef short v4i16_t __attribute__((ext_vector_type(4)));
__device__ __forceinline__ void kload8(bf16x8*kf,lds_cptr kp){
  kf[0]=*(const __attribute__((address_space(3))) bf16x8*)(kp);      kf[1]=*(const __attribute__((address_space(3))) bf16x8*)(kp+512);
  kf[2]=*(const __attribute__((address_space(3))) bf16x8*)(kp+2048); kf[3]=*(const __attribute__((address_space(3))) bf16x8*)(kp+2560);
  kf[4]=*(const __attribute__((address_space(3))) bf16x8*)(kp+4096); kf[5]=*(const __attribute__((address_space(3))) bf16x8*)(kp+4608);
  kf[6]=*(const __attribute__((address_space(3))) bf16x8*)(kp+6144); kf[7]=*(const __attribute__((address_space(3))) bf16x8*)(kp+6656);
}
__device__ __forceinline__ void kload2(bf16x8*kf,lds_cptr kp,int j){ kf[2*j]=*(const __attribute__((address_space(3))) bf16x8*)(kp+j*2048); kf[2*j+1]=*(const __attribute__((address_space(3))) bf16x8*)(kp+j*2048+512); }
__device__ __forceinline__ s16x4 vtr(lds_cptr p){ return __builtin_bit_cast(s16x4,__builtin_amdgcn_ds_read_tr16_b64_v4i16((__attribute__((address_space(3))) v4i16_t*)p)); }
__device__ __forceinline__ float rowmax(const f32x16&p0,const f32x16&p1){
  float a=max3f(p0[0],p0[1],p1[0]),b=max3f(p0[2],p0[3],p1[1]);a=max3f(a,p1[2],p1[3]);
  #pragma unroll
  for(int r=4;r<16;r+=4){a=max3f(a,p0[r],p0[r+1]);b=max3f(b,p0[r+2],p0[r+3]);a=max3f(a,p1[r],p1[r+1]);b=max3f(b,p1[r+2],p1[r+3]);}
  const float m=max2f(a,b);
  auto rr=__builtin_amdgcn_permlane32_swap(__float_as_uint(m),__float_as_uint(m),false,false);
  return max2f(__uint_as_float(rr[0]),__uint_as_float(rr[1]));
}
__device__ __forceinline__ void pv(f32x16*o,int vb,bf16x8 pa0,bf16x8 pa1,bf16x8 pa2,bf16x8 pa3){
  #pragma unroll
  for(int d0=0;d0<2;++d0){s16x4 lo[4],hi[4];
    #pragma unroll
    for(int ks=0;ks<4;++ks){
      asm volatile("ds_read_b64_tr_b16 %0,%1 offset:%c2":"=&v"(lo[ks]):"v"(vb),"i"(d0*4096+ks*1024):"memory");
      asm volatile("ds_read_b64_tr_b16 %0,%1 offset:%c2":"=&v"(hi[ks]):"v"(vb),"i"(d0*4096+ks*1024+512):"memory");}
    asm volatile("s_waitcnt lgkmcnt(0)":::"memory");SBAR();
    #define PK(k) (bf16x8){lo[k][0],lo[k][1],lo[k][2],lo[k][3],hi[k][0],hi[k][1],hi[k][2],hi[k][3]}
    o[d0]=__builtin_amdgcn_mfma_f32_32x32x16_bf16(pa0,PK(0),o[d0],0,0,0);
    o[d0]=__builtin_amdgcn_mfma_f32_32x32x16_bf16(pa1,PK(1),o[d0],0,0,0);
    o[d0]=__builtin_amdgcn_mfma_f32_32x32x16_bf16(pa2,PK(2),o[d0],0,0,0);
    o[d0]=__builtin_amdgcn_mfma_f32_32x32x16_bf16(pa3,PK(3),o[d0],0,0,0);
    #undef PK
  }
}

#ifndef ATTN_STORE16
#define ATTN_STORE16(p,v) (*(u32x4*)(p)=(v))
#endif
template<int THRL> __device__ __forceinline__ void attn_unit(int b,int qcol,int kcol,int vcol,int ocol,int qb,const bf16*__restrict__ PJ,bf16*O,char*shm,lds_cfptr tabR){
  int tid_=threadIdx.x; asm volatile("":"+v"(tid_)); const int tid=tid_,lane=tid&63,r32=lane&31,hi=lane>>5; const int wid=__builtin_amdgcn_readfirstlane(tid>>6);
  const long rowbase=(long)b*SEQ; const int q0=qb*QB;
  const bf16*Qw=PJ+(rowbase+q0+wid*QBLK)*DM+qcol;
  const bf16*Kh=PJ+rowbase*DM+kcol,*Vh=PJ+rowbase*DM+vcol;
  const unsigned lds0=(unsigned)(uintptr_t)shm;
  float*wsf=(float*)(shm+LDS_WS)+wid*64;
  const bf16*ksrc=Kh+(long)lane*DM+wid*8;
  const bf16*vsrc=Vh+(long)(16*(wid&3)+(lane>>2))*DM+(wid>>2)*32+(lane&3)*8;
  const unsigned kdst=lds0+LDS_K+wid*1024, vdst=lds0+LDS_V+wid*1024;
  #define DMA_K(t,slot) glds16(ksrc+(long)(t)*KVBLK*DM,(unsigned)__builtin_amdgcn_readfirstlane(kdst+(slot)))
  #define DMA_V(t,slot) glds16(vsrc+(long)(t)*KVBLK*DM,(unsigned)__builtin_amdgcn_readfirstlane(vdst+(slot)))
  const int vb0=(int)(lds0+LDS_V)+((lane>>4)&1)*32+(lane&3)*8+(4*hi+((lane&15)>>2))*64;
  const char*Kbase=shm+LDS_K; bf16x8 kf[8];
  const lds_cptr shm3=(lds_cptr)shm; const lds_cptr kp0=shm3+LDS_K+hi*1024+r32*16; const lds_cptr vp0=shm3+LDS_V+((lane>>4)&1)*32+(lane&3)*8+(4*hi+((lane&15)>>2))*64;
  const int NT=(q0+QB)/KVBLK;
  DMA_K(0,0);DMA_V(0,0);DMA_K(1,SLOTB);
  bf16x8 qr[4];
  #pragma unroll
  for(int d0=0;d0<4;++d0)qr[d0]=*reinterpret_cast<const bf16x8*>(&Qw[(long)r32*DM+d0*16+hi*8]);
  float mhat=0.f,l_reg=0.f;f32x16 o[2];o[0]=f32x16{};o[1]=f32x16{};f32x16 negm=f32x16{};asm volatile("":"+v"(negm));
  const int qrel=wid*QBLK+r32;
  #define CMASK(P0,P1,t) do{int jb_=(t)-(NT-4); if(jb_>=-2)bmask(P0,P1,jb_,qrel,hi,tabR);}while(0)
  bool resc=false;
  #define START(P0,P1) do{ const float rm=rowmax(P0,P1); resc=false; \
    { const float dl=rm; mhat=fadd_s(mhat,dl); \
      _Pragma("unroll") for(int r=0;r<16;++r){P0[r]=fsub_s(P0[r],dl);P1[r]=fsub_s(P1[r],dl);} \
      _Pragma("unroll") for(int r=0;r<16;++r)negm[r]=-mhat; asm volatile("":"+v"(negm)); } \
    _Pragma("unroll") for(int r=0;r<16;++r)P0[r]=__builtin_amdgcn_exp2f(P0[r]); }while(0)
  #define RESC() do{ if(resc){ asm volatile("s_waitcnt lgkmcnt(0)":::"memory"); \
      _Pragma("unroll") for(int d_=0;d_<2;++d_) _Pragma("unroll") for(int r=0;r<16;++r)o[d_][r]*=wsf[crow(r,hi)]; } }while(0)
  f32x16 pA0,pA1,pB0,pB1;
  int sl_prev=0,sl_cur=0,sl_next=SLOTB;
  #define ROT() do{sl_prev=sl_cur;sl_cur=sl_next;sl_next=(sl_next==(NSLOT-1)*SLOTB)?0:sl_next+SLOTB;}while(0)
  DMA_K(2,2*SLOTB);
  WAIT_BAR(3);
  qkt(pA0,pA1,Kbase,qr,negm,r32,hi);asm volatile("s_nop 15\n\ts_nop 7":"+v"(pA0),"+v"(pA1));CMASK(pA0,pA1,0);
  START(pA0,pA1);
  _Pragma("unroll") for(int r=0;r<16;++r)pA1[r]=__builtin_amdgcn_exp2f(pA1[r]);
  WAIT_BAR(0);
  DMA_K(3,0);DMA_V(1,SLOTB);
  ROT();
  kload8(kf,kp0+sl_cur);
  WAIT_BAR(2);
  s16x4 vlo[8],vhi[8]; u32x4 pw0,pw1,pw2,pw3;
  #define PKW(P,B) cvtpk_s(P[B],P[B+1])
  #define PAF(k) __builtin_bit_cast(bf16x8,pw##k)
  #define VFR(i) (bf16x8){vlo[i][0],vlo[i][1],vlo[i][2],vlo[i][3],vhi[i][0],vhi[i][1],vhi[i][2],vhi[i][3]}
  #define PIN(x) asm volatile("":"+v"(x))
  #define MX3(a,b,c) __builtin_fmaxf(__builtin_fmaxf((a),(b)),(c))
  #define GAPA(MF,A0,A1,A2,A3,W0,W1,PW) do{ MF; sacc+=A0; sacc+=A1; sacc+=A2; sacc+=A3; PIN(sacc); W0; W1; PIN(PW); SBAR(); }while(0)
  #define EX(v) __builtin_amdgcn_exp2f(v)
  #define GAPB(MF,X,B) do{ MF; X[B]=EX(X[B]); X[B+1]=EX(X[B+1]); X[B+2]=EX(X[B+2]); X[B+3]=EX(X[B+3]); PIN(X); SBAR(); }while(0)
  #define VRD(i) do{ vlo[i]=vtr(vp_+(((i)>>2)*4096+((i)&3)*1024)); vhi[i]=vtr(vp_+(((i)>>2)*4096+((i)&3)*1024+512)); }while(0)
  #define KRD(G,j) do{ if(G){ kload2(kf,kp0+sl_next,j); SBAR(); } }while(0)
  #define STEP(C0,C1,P0,P1,t,GK,GV,GL) do{ SBAR(); \
    const lds_cptr vp_=vp0+sl_prev; \
    VRD(0); SBAR(); float sacc=(P0[0]+P0[1]); \
    GAPA(C0=__builtin_amdgcn_mfma_f32_32x32x16_bf16(kf[0],qr[0],negm,0,0,0), P0[2],P0[3],P0[4],P0[5],     pw0[0]=PKW(P0,0), pw0[1]=PKW(P0,2), pw0); \
    VRD(4); SBAR(); GAPA(C1=__builtin_amdgcn_mfma_f32_32x32x16_bf16(kf[1],qr[0],negm,0,0,0), P0[6],P0[7],P0[8],P0[9],     pw0[2]=PKW(P0,4), pw0[3]=PKW(P0,6), pw0); \
    VRD(1); SBAR(); GAPA(C0=__builtin_amdgcn_mfma_f32_32x32x16_bf16(kf[2],qr[1],C0,0,0,0),   P0[10],P0[11],P0[12],P0[13], pw1[0]=PKW(P0,8), pw1[1]=PKW(P0,10), pw1); \
    VRD(5); SBAR(); GAPA(C1=__builtin_amdgcn_mfma_f32_32x32x16_bf16(kf[3],qr[1],C1,0,0,0),   P0[14],P0[15],P1[0],P1[1],   pw1[2]=PKW(P0,12),pw1[3]=PKW(P0,14), pw1); \
    VRD(2); SBAR(); GAPA(C0=__builtin_amdgcn_mfma_f32_32x32x16_bf16(kf[4],qr[2],C0,0,0,0),   P1[2],P1[3],P1[4],P1[5],     pw2[0]=PKW(P1,0), pw2[1]=PKW(P1,2), pw2); \
    VRD(6); SBAR(); GAPA(C1=__builtin_amdgcn_mfma_f32_32x32x16_bf16(kf[5],qr[2],C1,0,0,0),   P1[6],P1[7],P1[8],P1[9],     pw2[2]=PKW(P1,4), pw2[3]=PKW(P1,6), pw2); \
    VRD(3); SBAR(); GAPA(C0=__builtin_amdgcn_mfma_f32_32x32x16_bf16(kf[6],qr[3],C0,0,0,0),   P1[10],P1[11],P1[12],P1[13], pw3[0]=PKW(P1,8), pw3[1]=PKW(P1,10), pw3); \
    VRD(7); SBAR(); GAPA(C1=__builtin_amdgcn_mfma_f32_32x32x16_bf16(kf[7],qr[3],C1,0,0,0),   P1[14],P1[15],0.f,0.f,       pw3[2]=PKW(P1,12),pw3[3]=PKW(P1,14), pw3); \
    l_reg+=sacc; \
    if(GK){DMA_K((t)+3,sl_cur);} if(GV){DMA_V((t)+1,sl_next);} \
    CMASK(C0,C1,t); \
    { float a=MX3(C0[0],C0[1],C1[0]),b=MX3(C0[2],C0[3],C1[1]); a=MX3(a,C1[2],C1[3]); \
      _Pragma("unroll") for(int r=4;r<16;r+=4){a=MX3(a,C0[r],C0[r+1]);b=MX3(b,C0[r+2],C0[r+3]);a=MX3(a,C1[r],C1[r+1]);b=MX3(b,C1[r+2],C1[r+3]);} \
      float rm=__builtin_fmaxf(a,b); { auto rr=__builtin_amdgcn_permlane32_swap(__float_as_uint(rm),__float_as_uint(rm),false,false); rm=__builtin_fmaxf(__uint_as_float(rr[0]),__uint_as_float(rr[1])); } \
      resc=false; \
      if(__builtin_expect(__any(rm>(float)THRL),0)){ const float dl=__builtin_fmaxf(rm,0.f); mhat+=dl; \
        _Pragma("unroll") for(int r=0;r<16;++r){C0[r]-=dl;C1[r]-=dl;} \
        _Pragma("unroll") for(int r=0;r<16;++r)negm[r]=-mhat; asm volatile("":"+v"(negm)); \
        const float f=__builtin_amdgcn_exp2f(-dl); l_reg*=f; if(hi==0)wsf[r32]=f; resc=true; } } \
    SBAR(); \
    GAPB(o[0]=__builtin_amdgcn_mfma_f32_32x32x16_bf16(PAF(0),VFR(0),o[0],0,0,0), C0,0); \
    GAPB(o[1]=__builtin_amdgcn_mfma_f32_32x32x16_bf16(PAF(0),VFR(4),o[1],0,0,0), C0,4); \
    KRD(GL,0); GAPB(o[0]=__builtin_amdgcn_mfma_f32_32x32x16_bf16(PAF(1),VFR(1),o[0],0,0,0), C0,8); \
    KRD(GL,1); GAPB(o[1]=__builtin_amdgcn_mfma_f32_32x32x16_bf16(PAF(1),VFR(5),o[1],0,0,0), C0,12); \
    KRD(GL,2); GAPB(o[0]=__builtin_amdgcn_mfma_f32_32x32x16_bf16(PAF(2),VFR(2),o[0],0,0,0), C1,0); \
    KRD(GL,3); GAPB(o[1]=__builtin_amdgcn_mfma_f32_32x32x16_bf16(PAF(2),VFR(6),o[1],0,0,0), C1,4); \
    GAPB(o[0]=__builtin_amdgcn_mfma_f32_32x32x16_bf16(PAF(3),VFR(3),o[0],0,0,0), C1,8); \
    GAPB(o[1]=__builtin_amdgcn_mfma_f32_32x32x16_bf16(PAF(3),VFR(7),o[1],0,0,0), C1,12); \
    }while(0)
  int t=1;
  #undef CMASK
  #define CMASK(P0,P1,t) do{}while(0)
  for(;t+7<NT;t+=2){
    STEP(pB0,pB1,pA0,pA1,t,true,true,true);     WAIT_BAR(2); RESC(); ROT();
    STEP(pA0,pA1,pB0,pB1,t+1,true,true,true);   WAIT_BAR(2); RESC(); ROT();
  }
  #undef CMASK
  #define CMASK(P0,P1,t) do{int jb_=(t)-(NT-4); if(jb_>=-2)bmask(P0,P1,jb_,qrel,hi,tabR);}while(0)
  #define ENDW(tt) do{ if((tt)+3<NT){WAIT_BAR(2);} else if((tt)+2<NT){WAIT_BAR(1);} else {WAIT_BAR(0);} }while(0)
  for(;t+1<NT;t+=2){
    STEP(pB0,pB1,pA0,pA1,t,(t+3<NT),(t+1<NT),(t+1<NT));       ENDW(t);   RESC(); ROT();
    STEP(pA0,pA1,pB0,pB1,t+1,(t+4<NT),(t+2<NT),(t+2<NT));     ENDW(t+1); RESC(); ROT();
  }
  STEP(pB0,pB1,pA0,pA1,NT-1,false,false,false); RESC();
  { float sacc=pB0[0]+pB0[1]; _Pragma("unroll") for(int r=2;r<16;++r)sacc+=pB0[r]; _Pragma("unroll") for(int r=0;r<16;++r)sacc+=pB1[r]; l_reg+=sacc;
    pw0=(u32x4){PKW(pB0,0),PKW(pB0,2),PKW(pB0,4),PKW(pB0,6)};pw1=(u32x4){PKW(pB0,8),PKW(pB0,10),PKW(pB0,12),PKW(pB0,14)};pw2=(u32x4){PKW(pB1,0),PKW(pB1,2),PKW(pB1,4),PKW(pB1,6)};pw3=(u32x4){PKW(pB1,8),PKW(pB1,10),PKW(pB1,12),PKW(pB1,14)};
    SBAR(); pv(o,vb0+sl_cur,PAF(0),PAF(1),PAF(2),PAF(3)); }
  #undef PKW
  #undef PAF
  #undef VFR
  #undef PIN
  #undef MX3
  #undef GAPA
  #undef GAPB
  #undef EX
  #undef VRD
  #undef KRD
  #undef STEP
  #undef ENDW
  {auto rr=__builtin_amdgcn_permlane32_swap(__float_as_uint(l_reg),__float_as_uint(l_reg),false,false);l_reg=__uint_as_float(rr[0])+__uint_as_float(rr[1]);}
  if(hi==0)wsf[32+r32]=l_reg;asm volatile("s_waitcnt lgkmcnt(0)":::"memory");
  float rli[16];
  #pragma unroll
  for(int r=0;r<16;++r)rli[r]=__builtin_amdgcn_rcpf(wsf[32+crow(r,hi)]);
  bf16*Ow=O+(rowbase+q0+wid*QBLK)*DMO+ocol;
  { bf16*stg=(bf16*)(shm+LDS_OST)+wid*2048;
    #pragma unroll
    for(int r=0;r<16;++r){const int orow=crow(r,hi);
      #pragma unroll
      for(int d0=0;d0<2;++d0)stg[orow*64+d0*32+r32]=__float2bfloat16(o[d0][r]*rli[r]);}
    asm volatile("s_waitcnt lgkmcnt(0)":::"memory");
    #pragma unroll
    for(int i=0;i<4;++i){const int row=i*8+(lane>>3),ch=lane&7; const u32x4 v=*(const u32x4*)(stg+row*64+ch*8); ATTN_STORE16(Ow+(long)row*DMO+ch*8,v);} }
  asm volatile("s_waitcnt lgkmcnt(0)\n\ts_barrier":::"memory");
  #undef DMA_K
  #undef DMA_V
  #undef CMASK
  #undef START
  #undef RESC
  #undef ROT
}
constexpr int ATTN_LDS_BYTES=LDS_BYTES;
#undef SBAR
#undef WAIT_BAR
}
#define GAS __attribute__((address_space(1)))
#define LAS __attribute__((address_space(3)))
typedef unsigned short bf16;
typedef unsigned v4u __attribute__((ext_vector_type(4)));
typedef float f32x4 __attribute__((ext_vector_type(4)));
typedef short bf16x8 __attribute__((ext_vector_type(8)));
typedef GAS unsigned gu32;
typedef GAS unsigned long long gu64;
#define RLX_AGENT __ATOMIC_RELAXED, __HIP_MEMORY_SCOPE_AGENT
#define LDS_WAIT() asm volatile("s_waitcnt lgkmcnt(0)" ::: "memory")
#define VM_WAIT() asm volatile("s_waitcnt vmcnt(0)" ::: "memory")
__device__ __forceinline__ unsigned long long rt() { return __builtin_amdgcn_s_memrealtime(); }
__device__ __forceinline__ unsigned f2bf(float f) { unsigned u = __builtin_bit_cast(unsigned, f); return (u + 0x7fffu + ((u >> 16) & 1u)) >> 16; }
__device__ __forceinline__ unsigned pk2(float lo, float hi) { return f2bf(lo) | (f2bf(hi) << 16); }

#define XB_TMO      128
#define XB_XCNT(j)  (256  + 64 * (j))
#define XB_XSUB(j)  (1280 + 64 * (j))
#define XB_XGEN(j)  (2304 + 64 * (j))
#define XB_TOP      3328
#define XB_TOPGEN   3392
#define XCD_BAR_WORDS 3456
#define XB_SPIN_CAP (1u << 18)

__device__ __forceinline__ unsigned xb_ld(unsigned* p)              { return __hip_atomic_load(p, __ATOMIC_RELAXED, __HIP_MEMORY_SCOPE_AGENT); }
__device__ __forceinline__ unsigned xb_add(unsigned* p, unsigned v) { return __hip_atomic_fetch_add(p, v, __ATOMIC_RELAXED, __HIP_MEMORY_SCOPE_AGENT); }
__device__ __forceinline__ unsigned xb_xcc_id() { return (unsigned)__builtin_amdgcn_s_getreg((3 << 11) | 20) & 0xFu; }
#define XB_SPIN(cond, bar) do { unsigned _sp = 0; while (cond) { __builtin_amdgcn_s_sleep(1); \
    if ((++_sp & 255u) == 0u) { if (xb_ld(&(bar)[XB_TMO])) break; if (_sp > XB_SPIN_CAP) { atomicAdd(&(bar)[XB_TMO], 1u); break; } } } } while (0)

struct XcdBarrier {
    unsigned* bar; unsigned x;
    volatile LAS unsigned* st;
};

__device__ __forceinline__ XcdBarrier xcd_barrier_post(unsigned* bar, volatile LAS unsigned* st) {
    XcdBarrier b; b.bar = bar; b.x = xb_xcc_id(); b.st = st;
    if (threadIdx.x == 0) (void)xb_add(&bar[XB_XCNT(b.x)], 1u);
    return b;
}
__device__ __forceinline__ void xcd_barrier_complete(unsigned* bar, unsigned x, unsigned& nloc, unsigned& nx) {
    const unsigned G = gridDim.x * gridDim.y * gridDim.z;
    unsigned sum, cnt, mine, sp = 0u;
    for (;;) {
        sum = 0u; cnt = 0u; mine = 0u;
#pragma unroll
        for (unsigned j = 0; j < 16; ++j) { const unsigned c = xb_ld(&bar[XB_XCNT(j)]); sum += c; cnt += (c > 0u) ? 1u : 0u; mine = (j == x) ? c : mine; }
        if (sum == G) break;
        __builtin_amdgcn_s_sleep(1);
        if ((++sp & 255u) == 0u) { if (xb_ld(&bar[XB_TMO])) break; if (sp > XB_SPIN_CAP) { atomicAdd(&bar[XB_TMO], 1u); break; } }
    }
    nloc = mine > 0u ? mine : 1u; nx = cnt > 0u ? cnt : 1u;
}

__device__ __forceinline__ void xcd_barrier(const XcdBarrier& b) {
    asm volatile("s_waitcnt vmcnt(0)" ::: "memory");
    __syncthreads();
    if (threadIdx.x == 0) {
        unsigned* bar = b.bar;
        __builtin_amdgcn_s_waitcnt(0);
        unsigned nloc = b.st[0], nx = b.st[1];
        if (nloc == 0u) { xcd_barrier_complete(bar, b.x, nloc, nx); b.st[0] = nloc; b.st[1] = nx; }
        const unsigned old = xb_add(&bar[XB_XSUB(b.x)], 1u);
        const unsigned gen = old / nloc;
        if (old + 1u == (gen + 1u) * nloc) {
            __builtin_amdgcn_fence(__ATOMIC_RELEASE, "agent");
            asm volatile("s_waitcnt vmcnt(0)" ::: "memory");
            const unsigned og = xb_add(&bar[XB_TOP], 1u);
            const unsigned tg = og / nx;
            if (og + 1u == (tg + 1u) * nx) xb_add(&bar[XB_TOPGEN], 1u);
            else XB_SPIN(xb_ld(&bar[XB_TOPGEN]) == tg, bar);
            __builtin_amdgcn_fence(__ATOMIC_ACQUIRE, "agent");
            xb_add(&bar[XB_XGEN(b.x)], 1u);
            asm volatile("s_waitcnt vmcnt(0)" ::: "memory");
        } else {
            XB_SPIN(xb_ld(&bar[XB_XGEN(b.x)]) == gen, bar);
            __builtin_amdgcn_fence(__ATOMIC_ACQUIRE, "agent");
            asm volatile("s_waitcnt vmcnt(0)" ::: "memory");
        }
    }
    __syncthreads();
}
constexpr int NWAVES = 8;
#ifndef MK_ONE_LAUNCH
#define MK_ONE_LAUNCH 0
#endif
constexpr int NB = 4, SEQ = 8192, DM = 1024, M = NB * SEQ, DEPTH = 4;
constexpr int NPROJ = 3584, INW = 3592, DFF = 3584, NUP = 2 * DFF, NEXP = 8;
constexpr int PJ_AQ = 0, PJ_AK = 512, PJ_AV = 1024, PJ_MQ = 1536, PJ_MK = 2048, PJ_MV = 2560, PJ_MO = 3072;
constexpr float EPS = 1e-6f;
constexpr int MPAD = 2 * M + NEXP * 256;
constexpr int NCH = SEQ / 64;
constexpr int NPH = 11;
constexpr int PH_TOTAL = 2 + DEPTH * NPH;

constexpr size_t MiB = 1u << 20;
constexpr size_t WS_CTL = 0, CTL_ZERO_BYTES = 1 * MiB;
constexpr size_t WS_MOD = 1 * MiB;
constexpr size_t WS_GATE = 2 * MiB;
constexpr size_t WS_BL = 3 * MiB;
constexpr size_t WS_UN = 4 * MiB;
constexpr size_t WS_NP = 5 * MiB;
constexpr size_t WS_TOK = 6 * MiB;
constexpr size_t WS_ROWIDX = 7 * MiB;
constexpr size_t WS_WIN = 16 * MiB;
constexpr size_t WS_WOUT = 44 * MiB;
constexpr size_t WS_WUP = 52 * MiB;
constexpr size_t WS_WDN = 80 * MiB;
constexpr size_t WS_WMUP = 94 * MiB;
constexpr size_t WS_WMDN = 206 * MiB;
constexpr size_t WS_H = 262 * MiB;
constexpr size_t WS_Y = 326 * MiB;
constexpr size_t WS_R = 458 * MiB;
constexpr size_t WS_END = 920 * MiB;
static_assert(WS_Y + (size_t)MPAD * 1024 * 2 <= WS_R && WS_R + (size_t)MPAD * 3584 * 2 <= WS_END, "d_ws map");
constexpr int CW_TMO = 0, CW_CODE = 1, CW_BAR = 4096, CW_MOECNT = 8192;

constexpr int RING_OFF = 0, RING_BYTES = 131072;
constexpr int LDSCTL_OFF = RING_BYTES, MISC_OFF = LDSCTL_OFF + 320;
constexpr int BIAS_OFF = 132096;
constexpr int LDS_BYTES = 147456;
static_assert(MISC_OFF + 128 <= BIAS_OFF && BIAS_OFF + 8192 <= LDS_BYTES, "LDS map");

__device__ const int T5_BUCKET[128] = {0, 1, 2, 3, 4, 5, 6, 7, 8, 9, 10, 11, 12, 13, 14, 15, 16, 16, 16, 17, 17, 18, 18, 18, 19, 19, 19, 20, 20, 20, 20, 21, 21, 21, 21, 22, 22, 22, 22, 22, 23, 23, 23, 23, 23, 23, 24, 24, 24, 24, 24, 24, 25, 25, 25, 25, 25, 25, 25, 26, 26, 26, 26, 26, 26, 26, 26, 27, 27, 27, 27, 27, 27, 27, 27, 27, 27, 28, 28, 28, 28, 28, 28, 28, 28, 28, 28, 29, 29, 29, 29, 29, 29, 29, 29, 29, 29, 29, 29, 30, 30, 30, 30, 30, 30, 30, 30, 30, 30, 30, 30, 30, 30, 31, 31, 31, 31, 31, 31, 31, 31, 31, 31, 31, 31, 31, 31, 31};

typedef unsigned v2u __attribute__((ext_vector_type(2)));
typedef float v2f __attribute__((ext_vector_type(2)));
#ifndef PH_MASK
#define PH_MASK 0xFFFFFFu
#endif
#define PHM(b) ((PH_MASK >> (b)) & 1u)
struct Frame {
    LAS unsigned char* lds;
    volatile LAS unsigned* MISC;
    gu32* ctl;
    int tid, lane, wave, vcu, bx, G;
    unsigned char* ws;
    const __attribute__((address_space(4))) void* karg;
    float* out;
    __device__ __forceinline__ const float* in(int i) const { return ((const float* const __attribute__((address_space(4)))*)karg)[i]; }
};
#define PHASE_BEGIN() do { int t_ = threadIdx.x; asm volatile("" : "+v"(t_)); F.tid = t_; F.lane = t_ & 63; F.wave = __builtin_amdgcn_readfirstlane(t_ >> 6); \
    int b_ = blockIdx.x; asm volatile("" : "+s"(b_)); F.bx = b_; F.vcu = (F.G % 8 == 0) ? (b_ % 8) * (F.G / 8) + b_ / 8 : b_; \
    const __attribute__((address_space(4))) void* k_ = (const __attribute__((address_space(4))) void*)__builtin_amdgcn_kernarg_segment_ptr(); asm volatile("" : "+s"(k_)); F.karg = k_; } while (0)
__device__ __forceinline__ float wave_sum(float v) {
#pragma unroll
    for (int o = 1; o < 64; o <<= 1) v += __shfl_xor(v, o);
    return v;
}
__device__ __forceinline__ float wave_max(float v) {
#pragma unroll
    for (int o = 1; o < 64; o <<= 1) v = fmaxf(v, __shfl_xor(v, o));
    return v;
}
__device__ __forceinline__ float bf2f(unsigned short b) { return __uint_as_float((unsigned)b << 16); }
__device__ __forceinline__ float bflo(unsigned w) { return __uint_as_float(w << 16); }
__device__ __forceinline__ float bfhi(unsigned w) { return __uint_as_float(w & 0xffff0000u); }

__device__ __forceinline__ void p_ada(Frame& F) {
    LAS float* cact = (LAS float*)(F.lds);
    LAS float* red = (LAS float*)(F.lds + 16384);
    for (int i = F.tid; i < NB * DM; i += NWAVES * 64) { const float v = F.in(1)[i]; cact[i] = v / (1.0f + __expf(-v)); }
    __syncthreads();
    float* mod = (float*)(F.ws + WS_MOD);
    for (int item = F.bx; item < DEPTH * 48; item += F.G) {
        const int l = item / 48, col0 = (item % 48) * 128, q = F.tid & 31, kg = F.tid >> 5;
        const float* w = F.in(3) + ((size_t)l * DM + kg * 64) * (6 * DM) + col0 + 4 * q;
        f32x4 acc[4];
#pragma unroll
        for (int b = 0; b < 4; ++b) acc[b] = (f32x4){0.f, 0.f, 0.f, 0.f};
#pragma unroll 8
        for (int k = 0; k < 64; ++k) { const f32x4 wv = *(const GAS f32x4*)(w + (size_t)k * (6 * DM));
#pragma unroll
            for (int b = 0; b < 4; ++b) acc[b] += cact[b * DM + kg * 64 + k] * wv; }
#pragma unroll
        for (int b = 0; b < 4; ++b) *(LAS f32x4*)&red[(kg * 4 + b) * 128 + 4 * q] = acc[b];
        __syncthreads();
        { const int b = F.tid >> 7, ci = F.tid & 127; float s = 0.f;
#pragma unroll
          for (int g = 0; g < 16; ++g) s += red[(g * 4 + b) * 128 + ci];
          mod[(size_t)(l * NB + b) * (6 * DM) + col0 + ci] = s + F.in(4)[l * (6 * DM) + col0 + ci]; }
        __syncthreads();
    }
}
__device__ __forceinline__ void tr_item(const float* W, int ldw, int N, int K, bf16* WT, int rstride, int roff, LAS float* scr, int item, int lane) {
    const int nblk = N / 32, kb = item / nblk, nb = item % nblk, k0 = 64 * kb, n0 = 32 * nb;
#pragma unroll 8
    for (int i = 0; i < 32; ++i) { const int kk = 2 * i + (lane >> 5); scr[kk * 33 + (lane & 31)] = W[(size_t)(k0 + kk) * ldw + n0 + (lane & 31)]; }
    LDS_WAIT(); asm volatile("" ::: "memory");
    const int c = lane & 7;
#pragma unroll
    for (int j = 0; j < 4; ++j) { const int n = (lane >> 3) + 8 * j; const LAS float* s = scr + (8 * c) * 33 + n;
        v4u o; o.x = pk2(s[0 * 33], s[1 * 33]); o.y = pk2(s[2 * 33], s[3 * 33]); o.z = pk2(s[4 * 33], s[5 * 33]); o.w = pk2(s[6 * 33], s[7 * 33]);
        const int nn = n0 + n, orow = (nn >> 7) * rstride + roff + (nn & 127);
        *(GAS v4u*)(WT + (size_t)orow * K + k0 + 8 * c) = o; }
    LDS_WAIT(); asm volatile("" ::: "memory");
}
constexpr int TRI = 1792;
__device__ __forceinline__ void p_convert_dense(Frame& F) {
    LAS float* scr = (LAS float*)(F.lds + RING_OFF + F.wave * 16384);
    const int gw = F.vcu * NWAVES + F.wave, NGW = F.G * NWAVES;
    constexpr int PER_L = TRI + 512, N1 = DEPTH * PER_L, N2 = 2 * 3 * TRI;
    for (int it = gw; it < N1 + N2; it += NGW) {
        if (it < N1) { const int l = it / PER_L, r = it % PER_L;
            if (r < TRI) tr_item(F.in(6) + (size_t)l * DM * INW, INW, NPROJ, DM, (bf16*)(F.ws + WS_WIN) + (size_t)l * NPROJ * DM, 128, 0, scr, r, F.lane);
            else tr_item(F.in(13) + (size_t)l * DM * DM, DM, DM, DM, (bf16*)(F.ws + WS_WOUT) + (size_t)l * DM * DM, 128, 0, scr, r - TRI, F.lane);
        } else { const int r0 = it - N1, j = r0 / (3 * TRI), r = r0 % (3 * TRI), which = r / TRI, rr = r % TRI;
            if (which == 0) tr_item(F.in(14) + (size_t)j * DM * DFF, DFF, DFF, DM, (bf16*)(F.ws + WS_WUP) + (size_t)j * NUP * DM, 256, 0, scr, rr, F.lane);
            else if (which == 1) tr_item(F.in(15) + (size_t)j * DM * DFF, DFF, DFF, DM, (bf16*)(F.ws + WS_WUP) + (size_t)j * NUP * DM, 256, 128, scr, rr, F.lane);
            else tr_item(F.in(16) + (size_t)j * DFF * DM, DM, DM, DFF, (bf16*)(F.ws + WS_WDN) + (size_t)j * DM * DFF, 128, 0, scr, rr, F.lane);
        }
    }
}
__device__ __forceinline__ void p_convert_moe(Frame& F, int j) {
    LAS float* scr = (LAS float*)(F.lds + RING_OFF + 65536 + F.wave * 8448);
    const int gw = F.vcu * NWAVES + F.wave, NGW = F.G * NWAVES;
    for (int it = gw; it < NEXP * 3 * TRI; it += NGW) {
        const int e = it / (3 * TRI), r = it % (3 * TRI), which = r / TRI, rr = r % TRI;
        const size_t we = (size_t)(j * NEXP + e);
        if (which == 0) tr_item(F.in(18) + we * DM * DFF, DFF, DFF, DM, (bf16*)(F.ws + WS_WMUP) + (size_t)e * NUP * DM, 256, 0, scr, rr, F.lane);
        else if (which == 1) tr_item(F.in(19) + we * DM * DFF, DFF, DFF, DM, (bf16*)(F.ws + WS_WMUP) + (size_t)e * NUP * DM, 256, 128, scr, rr, F.lane);
        else tr_item(F.in(20) + we * DFF * DM, DM, DM, DFF, (bf16*)(F.ws + WS_WMDN) + (size_t)e * DM * DFF, 128, 0, scr, rr, F.lane);
    }
}

__device__ __forceinline__ void row_phase(Frame& F, const int l, const int mode) {
    const bool has_res = mode != 0;
    const bool moe = (l & 1) != 0;
    const int ln = (mode == 2) ? l + 1 : l;
    const bool do_norm = (mode != 2) || (l + 1 < DEPTH);
    const bool do_gates = do_norm && (mode != 1);
    const bool do_router = (mode == 1) && moe;
    const bool y_moe = (mode == 2) && moe;
    const float* xsrc = (mode == 0 || (mode == 1 && l == 0)) ? F.in(0) : F.out;
    const float* mod = (const float*)(F.ws + WS_MOD);
    LAS float* W8 = (LAS float*)(F.lds);
    LAS int* te = (LAS int*)(F.lds + 32768);
    LAS float* tg = (LAS float*)(F.lds + 32768 + 1024);
    LAS int* tl = (LAS int*)(F.lds + 32768 + 2048);
    LAS int* lcnt = (LAS int*)(F.lds + 32768 + 3072);
    float* gate = (float*)(F.ws + WS_GATE);
    bf16* H = (bf16*)(F.ws + WS_H);
    const bf16* Y = (const bf16*)(F.ws + WS_Y);
    const int mj = l >> 1;
    gu32* gcnt = F.ctl + CW_MOECNT + 64 * mj;
    int* tok_e = (int*)(F.ws + WS_TOK); int* tok_p = (int*)(F.ws + WS_TOK + 262144); float* tok_g = (float*)(F.ws + WS_TOK + 524288);
    int* rowidx = (int*)(F.ws + WS_ROWIDX);
    if (do_gates) { for (int i = F.tid; i < DM * 8; i += NWAVES * 64) W8[i] = F.in(6)[((size_t)ln * DM + (i >> 3)) * INW + NPROJ + (i & 7)]; }
    if (do_router) { for (int i = F.tid; i < DM * 8; i += NWAVES * 64) W8[i] = F.in(17)[(size_t)mj * DM * 8 + i]; }
    if (y_moe && F.tid == 0) { int pb = 0; for (int e = 0; e < NEXP; ++e) { lcnt[16 + e] = pb; pb += (int)((gcnt[e] + 255u) >> 8) * 256; } }
    __syncthreads();
    for (int item = F.bx; item < M / 128; item += F.G) {
        const int b = item / (SEQ / 128);
        if (do_router && F.tid < 8) lcnt[F.tid] = 0;
        f32x4 cy[4], ca[4], cb[4];
#pragma unroll
        for (int j = 0; j < 4; ++j) { const int col = 4 * F.lane + 256 * j;
            if (has_res) { const f32x4 g = *(const GAS f32x4*)(mod + (size_t)(l * NB + b) * (6 * DM) + (mode == 1 ? 2 : 5) * DM + col);
                           const f32x4 ng = *(const GAS f32x4*)(F.in(5) + (size_t)(l * 4 + (mode == 1 ? 1 : 3)) * DM + col); cy[j] = g * ng; }
            if (do_norm) { const int sub = (mode == 1) ? 1 : 0;
                           const f32x4 sc = *(const GAS f32x4*)(mod + (size_t)(ln * NB + b) * (6 * DM) + (sub ? 4 : 1) * DM + col);
                           const f32x4 sh = *(const GAS f32x4*)(mod + (size_t)(ln * NB + b) * (6 * DM) + (sub ? 3 : 0) * DM + col);
                           const f32x4 ng = *(const GAS f32x4*)(F.in(5) + (size_t)(ln * 4 + (sub ? 2 : 0)) * DM + col);
                           ca[j] = ng * (sc + 1.0f); cb[j] = sh; } }
        for (int i = 0; i < 16; ++i) {
            const int rl = F.wave * 16 + i; const size_t row = (size_t)item * 128 + rl;
            f32x4 xv[4];
#pragma unroll
            for (int j = 0; j < 4; ++j) xv[j] = *(const GAS f32x4*)(xsrc + row * DM + 4 * F.lane + 256 * j);
            if (has_res) {
                f32x4 yv[4];
                if (!y_moe) {
#pragma unroll
                    for (int j = 0; j < 4; ++j) { const v2u w = *(const GAS v2u*)(Y + row * DM + 4 * F.lane + 256 * j); yv[j] = (f32x4){bflo(w.x), bfhi(w.x), bflo(w.y), bfhi(w.y)}; }
                } else {
                    const int e0 = tok_e[row * 2], e1 = tok_e[row * 2 + 1]; const float g0 = tok_g[row * 2], g1 = tok_g[row * 2 + 1];
                    const size_t s0 = (size_t)(lcnt[16 + e0] + tok_p[row * 2]), s1 = (size_t)(lcnt[16 + e1] + tok_p[row * 2 + 1]);
#pragma unroll
                    for (int j = 0; j < 4; ++j) { const v2u w0 = *(const GAS v2u*)(Y + s0 * DM + 4 * F.lane + 256 * j), w1 = *(const GAS v2u*)(Y + s1 * DM + 4 * F.lane + 256 * j);
                        yv[j] = (f32x4){g0 * bflo(w0.x) + g1 * bflo(w1.x), g0 * bfhi(w0.x) + g1 * bfhi(w1.x), g0 * bflo(w0.y) + g1 * bflo(w1.y), g0 * bfhi(w0.y) + g1 * bfhi(w1.y)}; }
                }
                float ss = 0.f;
#pragma unroll
                for (int j = 0; j < 4; ++j) ss += (yv[j].x * yv[j].x + yv[j].y * yv[j].y) + (yv[j].z * yv[j].z + yv[j].w * yv[j].w);
                const float rstd = 1.0f / sqrtf(wave_sum(ss) * (1.0f / DM) + EPS);
#pragma unroll
                for (int j = 0; j < 4; ++j) { xv[j] += cy[j] * (yv[j] * rstd); *(GAS f32x4*)(F.out + row * DM + 4 * F.lane + 256 * j) = xv[j]; }
            }
            if (do_norm) {
                float ss = 0.f;
#pragma unroll
                for (int j = 0; j < 4; ++j) ss += (xv[j].x * xv[j].x + xv[j].y * xv[j].y) + (xv[j].z * xv[j].z + xv[j].w * xv[j].w);
                const float rstd = 1.0f / sqrtf(wave_sum(ss) * (1.0f / DM) + EPS);
                f32x4 hv[4];
#pragma unroll
                for (int j = 0; j < 4; ++j) { hv[j] = (xv[j] * rstd) * ca[j] + cb[j];
                    v2u w; w.x = pk2(hv[j].x, hv[j].y); w.y = pk2(hv[j].z, hv[j].w); *(GAS v2u*)(H + row * DM + 4 * F.lane + 256 * j) = w; }
                if (do_gates || do_router) {
                    float a8[8];
#pragma unroll
                    for (int o = 0; o < 8; ++o) a8[o] = 0.f;
#pragma unroll
                    for (int j = 0; j < 4; ++j)
#pragma unroll
                        for (int cc = 0; cc < 4; ++cc) { const int k = 4 * F.lane + 256 * j + cc; const f32x4 w0 = *(const LAS f32x4*)&W8[k * 8], w1 = *(const LAS f32x4*)&W8[k * 8 + 4]; const float hk = hv[j][cc];
                            a8[0] += hk * w0.x; a8[1] += hk * w0.y; a8[2] += hk * w0.z; a8[3] += hk * w0.w; a8[4] += hk * w1.x; a8[5] += hk * w1.y; a8[6] += hk * w1.z; a8[7] += hk * w1.w; }
#pragma unroll
                    for (int o = 0; o < 8; ++o) a8[o] = wave_sum(a8[o]);
                    if (do_gates) {
                        float v = a8[0];
#pragma unroll
                        for (int o = 1; o < 8; ++o) v = (F.lane == o) ? a8[o] : v;
                        if (F.lane < 8) gate[row * 8 + F.lane] = v + F.in(7)[ln * 8 + F.lane];
                    } else {
                        int e0 = 0; float v0 = a8[0];
#pragma unroll
                        for (int o = 1; o < 8; ++o) if (a8[o] > v0) { v0 = a8[o]; e0 = o; }
                        int e1 = -1; float v1 = -INFINITY;
#pragma unroll
                        for (int o = 0; o < 8; ++o) if (o != e0 && a8[o] > v1) { v1 = a8[o]; e1 = o; }
                        const float g0 = 1.0f / (1.0f + __expf(v1 - v0));
                        if (F.lane == 0) { te[rl * 2] = e0; te[rl * 2 + 1] = e1; tg[rl * 2] = g0; tg[rl * 2 + 1] = 1.0f - g0; }
                    }
                }
            }
        }
        if (do_router) {
            __syncthreads();
            if (F.tid < 256) tl[F.tid] = __hip_atomic_fetch_add(&lcnt[te[F.tid]], 1, __ATOMIC_RELAXED, __HIP_MEMORY_SCOPE_WORKGROUP);
            __syncthreads();
            if (F.tid < 8) lcnt[8 + F.tid] = (int)__hip_atomic_fetch_add(gcnt + F.tid, (unsigned)lcnt[F.tid], __ATOMIC_RELAXED, __HIP_MEMORY_SCOPE_AGENT);
            __syncthreads();
            if (F.tid < 256) { const int e = te[F.tid], pos = lcnt[8 + e] + tl[F.tid]; const int tok = item * 128 + (F.tid >> 1);
                tok_e[tok * 2 + (F.tid & 1)] = e; tok_p[tok * 2 + (F.tid & 1)] = pos; tok_g[tok * 2 + (F.tid & 1)] = tg[F.tid]; rowidx[(size_t)e * M + pos] = tok; }
            __syncthreads();
        }
    }
}
typedef float f32x16 __attribute__((ext_vector_type(16)));
#define MFMA32(a, b, c) __builtin_amdgcn_mfma_f32_32x32x16_bf16(a, b, c, 0, 0, 0)
__device__ __forceinline__ int crow16(int r, int hi) { return (r & 3) + 8 * (r >> 2) + 4 * hi; }
constexpr float KSCALE = 0.08838834764831845f;
__device__ __forceinline__ void chunk_gates(const float* gate, size_t t0, int h, int lane, float& bj, float& ig) {
    const float fpre = gate[(t0 + lane) * 8 + 4 + h]; ig = gate[(t0 + lane) * 8 + h];
    float lf = fminf(fpre, 0.f) - log1pf(__expf(-fabsf(fpre)));
#pragma unroll
    for (int o = 1; o < 64; o <<= 1) { const float t = __shfl_up(lf, o); if (lane >= o) lf += t; }
    bj = lf;
}
__device__ __forceinline__ void mlstm_pass1(Frame& F, const int l) {
    LAS unsigned short* KWT = (LAS unsigned short*)(F.lds);
    LAS unsigned short* VT = (LAS unsigned short*)(F.lds + 18432);
    LAS float* CW = (LAS float*)(F.lds + 36864);
    LAS float* WJ = (LAS float*)(F.lds + 41984);
    const float* gate = (const float*)(F.ws + WS_GATE);
    const bf16* PJ = (const bf16*)(F.ws + WS_R);
    bf16* QC = (bf16*)(F.ws + WS_H); bf16* KC = (bf16*)(F.ws + WS_H + 32 * MiB);
    float* UT = (float*)(F.ws + WS_R + 288 * MiB); float* UN = (float*)(F.ws + WS_UN);
    float* BL = (float*)(F.ws + WS_BL); float* ML = (float*)(F.ws + WS_BL + 8192);
    const int r32 = F.lane & 31, hi = F.lane >> 5;
    for (int unit = F.bx; unit < 16 * NCH; unit += F.G) {
        const int bh = unit / NCH, n = unit % NCH, b = bh >> 2, h = bh & 3; const size_t t0 = (size_t)b * SEQ + (size_t)n * 64;
        if (F.wave == 0) {
            float bj, ig; chunk_gates(gate, t0, h, F.lane, bj, ig);
            const float blast = __shfl(bj, 63), a = blast - bj + ig, mloc = wave_max(a);
            WJ[F.lane] = __expf(a - mloc);
            if (F.lane == 0) { BL[unit] = blast; ML[unit] = mloc; }
        }
        for (int i = F.tid; i < 1280; i += NWAVES * 64) {
            const int jj = i >> 8, cc = i & 255, ch = (cc < 128) ? (h * 128 + cc) : (512 + h * 128 + (cc - 128));
            CW[i] = (jj < 4) ? F.in(8)[((size_t)l * 4 + jj) * 1024 + ch] : F.in(9)[(size_t)l * 1024 + ch];
        }
        __syncthreads();
#pragma unroll 1
        for (int it = 0; it < 4; ++it) {
            const int task = F.tid + 512 * it, j = task & 63, c = (task >> 6) & 15, qk = task >> 10;
            const int colp = (qk ? PJ_MK : PJ_MQ) + h * 128 + 8 * c, cwc = qk * 128 + 8 * c;
            float acc[8];
#pragma unroll
            for (int i = 0; i < 8; ++i) acc[i] = CW[1024 + cwc + i];
#pragma unroll
            for (int jj = 0; jj < 4; ++jj) { const int rel = n * 64 + j - 3 + jj;
                if (rel >= 0) { const v4u w = *(const GAS v4u*)(PJ + (t0 + j - 3 + jj) * NPROJ + colp);
                    const float xs[8] = {bflo(w.x), bfhi(w.x), bflo(w.y), bfhi(w.y), bflo(w.z), bfhi(w.z), bflo(w.w), bfhi(w.w)};
#pragma unroll
                    for (int i = 0; i < 8; ++i) acc[i] += xs[i] * CW[jj * 256 + cwc + i]; } }
#pragma unroll
            for (int i = 0; i < 8; ++i) acc[i] = acc[i] / (1.0f + __expf(-acc[i]));
            v4u o; o.x = pk2(acc[0], acc[1]); o.y = pk2(acc[2], acc[3]); o.z = pk2(acc[4], acc[5]); o.w = pk2(acc[6], acc[7]);
            if (qk == 0) *(GAS v4u*)(QC + (t0 + j) * 512 + h * 128 + 8 * c) = o;
            else { *(GAS v4u*)(KC + (t0 + j) * 512 + h * 128 + 8 * c) = o; const float wj = WJ[j] * KSCALE;
#pragma unroll
                for (int i = 0; i < 8; ++i) KWT[(8 * c + i) * 72 + j] = (unsigned short)f2bf(acc[i] * wj); }
        }
#pragma unroll 1
        for (int it = 0; it < 2; ++it) {
            const int task = F.tid + 512 * it, j = task & 63, c = task >> 6;
            const v4u w = *(const GAS v4u*)(PJ + (t0 + j) * NPROJ + PJ_MV + h * 128 + 8 * c);
            const unsigned ws_[4] = {w.x, w.y, w.z, w.w};
#pragma unroll
            for (int i = 0; i < 4; ++i) { VT[(8 * c + 2 * i) * 72 + j] = (unsigned short)(ws_[i] & 0xffffu); VT[(8 * c + 2 * i + 1) * 72 + j] = (unsigned short)(ws_[i] >> 16); }
        }
        __syncthreads();
        { const int dvb = F.wave & 3, dkh = F.wave >> 2;
          f32x16 acc0 = {}, acc1 = {};
#pragma unroll
          for (int ks = 0; ks < 4; ++ks) {
              const bf16x8 a = *(const LAS bf16x8*)(VT + (dvb * 32 + r32) * 72 + 16 * ks + 8 * hi);
              const bf16x8 b0 = *(const LAS bf16x8*)(KWT + (dkh * 64 + r32) * 72 + 16 * ks + 8 * hi);
              const bf16x8 b1 = *(const LAS bf16x8*)(KWT + (dkh * 64 + 32 + r32) * 72 + 16 * ks + 8 * hi);
              acc0 = MFMA32(a, b0, acc0); acc1 = MFMA32(a, b1, acc1); }
          float* ut = UT + (size_t)unit * 16384;
#pragma unroll
          for (int r = 0; r < 16; ++r) { const int dv = dvb * 32 + crow16(r, hi);
              ut[dv * 128 + dkh * 64 + r32] = acc0[r]; ut[dv * 128 + dkh * 64 + 32 + r32] = acc1[r]; } }
        if (F.tid < 128) { float s = 0.f;
#pragma unroll
            for (int q = 0; q < 8; ++q) { const v4u w = *(const LAS v4u*)(KWT + F.tid * 72 + 8 * q); s += (bflo(w.x) + bfhi(w.x)) + (bflo(w.y) + bfhi(w.y)) + (bflo(w.z) + bfhi(w.z)) + (bflo(w.w) + bfhi(w.w)); }
            UN[(size_t)unit * 128 + F.tid] = s; }
        __syncthreads();
    }
}
__device__ __forceinline__ void mlstm_pass2(Frame& F) {
    LAS float* DEC = (LAS float*)(F.lds); LAS float* WN = (LAS float*)(F.lds + 512);
    const float* UT = (const float*)(F.ws + WS_R + 288 * MiB); const float* UN = (const float*)(F.ws + WS_UN);
    bf16* CP = (bf16*)(F.ws + WS_Y + 64 * MiB); float* NP = (float*)(F.ws + WS_NP);
    const float* BL = (const float*)(F.ws + WS_BL); const float* ML = (const float*)(F.ws + WS_BL + 8192); float* MP = (float*)(F.ws + WS_BL + 16384);
    for (int item = F.bx; item < 256; item += F.G) {
        const int bh = item >> 4, seg = item & 15;
        if (F.tid == 0) { float m = 0.f;
            for (int n = 0; n < NCH; ++n) { const float bl = BL[bh * NCH + n], ml = ML[bh * NCH + n], mn = fmaxf(bl + m, ml);
                DEC[n] = __expf(bl + m - mn); WN[n] = __expf(ml - mn); if (seg == 0) MP[bh * NCH + n] = m; m = mn; } }
        __syncthreads();
        { const size_t e0 = (size_t)seg * 1024 + 2 * F.tid; const float* u = UT + (size_t)bh * NCH * 16384 + e0; bf16* cp = CP + (size_t)bh * NCH * 16384 + e0;
          float c0 = 0.f, c1 = 0.f;
#pragma unroll 1
          for (int n0 = 0; n0 < NCH; n0 += 8) { v2f uv[8];
#pragma unroll
              for (int q = 0; q < 8; ++q) uv[q] = *(const GAS v2f*)(u + (size_t)(n0 + q) * 16384);
#pragma unroll
              for (int q = 0; q < 8; ++q) { *(GAS unsigned*)(cp + (size_t)(n0 + q) * 16384) = pk2(c0, c1);
                  const float d = DEC[n0 + q], w = WN[n0 + q]; c0 = d * c0 + w * uv[q].x; c1 = d * c1 + w * uv[q].y; } } }
        if (F.tid < 8) { const int dk = seg * 8 + F.tid; float nv = 0.f;
            for (int n = 0; n < NCH; ++n) { const size_t idx = ((size_t)bh * NCH + n) * 128 + dk; NP[idx] = nv; nv = DEC[n] * nv + WN[n] * UN[idx]; } }
        __syncthreads();
    }
}
__device__ __forceinline__ void mlstm_pass3(Frame& F, const int l) {
    LAS unsigned short* QS = (LAS unsigned short*)(F.lds);
    LAS unsigned short* KS = (LAS unsigned short*)(F.lds + 17408);
    LAS unsigned short* VT = (LAS unsigned short*)(F.lds + 34816);
    LAS unsigned short* CPS = (LAS unsigned short*)(F.lds + 53248);
    LAS float* HM = (LAS float*)(F.lds + 88064);
    LAS float* NPS = (LAS float*)(F.lds + 121856);
    LAS float* MROW = (LAS float*)(F.lds + 122368);
    LAS float* WSCR = (LAS float*)(F.lds + 123136) + F.wave * 64;
    const float* gate = (const float*)(F.ws + WS_GATE);
    const bf16* PJ = (const bf16*)(F.ws + WS_R);
    const bf16* QC = (const bf16*)(F.ws + WS_H); const bf16* KC = (const bf16*)(F.ws + WS_H + 32 * MiB);
    const bf16* CP = (const bf16*)(F.ws + WS_Y + 64 * MiB); const float* NP = (const float*)(F.ws + WS_NP);
    const float* MP = (const float*)(F.ws + WS_BL + 16384);
    bf16* MIXED = (bf16*)(F.ws + WS_R + 224 * MiB);
    const int r32 = F.lane & 31, hi = F.lane >> 5;
    for (int unit = F.bx; unit < 16 * NCH; unit += F.G) {
        const int bh = unit / NCH, n = unit % NCH, b = bh >> 2, h = bh & 3; const size_t t0 = (size_t)b * SEQ + (size_t)n * 64;
        const float mprev = MP[unit];
        if (F.wave == 0) {
            float bj, ig; chunk_gates(gate, t0, h, F.lane, bj, ig);
            const float g = ig - bj; float pm = g;
#pragma unroll
            for (int o = 1; o < 64; o <<= 1) { const float t = __shfl_up(pm, o); if (F.lane >= o) pm = fmaxf(pm, t); }
            MROW[F.lane] = fmaxf(mprev, pm); MROW[64 + F.lane] = g; MROW[128 + F.lane] = bj;
        }
        if (F.tid < 128) NPS[F.tid] = NP[(size_t)unit * 128 + F.tid];
#pragma unroll 1
        for (int it = 0; it < 2; ++it) { const int p = F.tid + 512 * it, j = p >> 4, c = p & 15;
            *(LAS v4u*)(QS + j * 136 + 8 * c) = *(const GAS v4u*)(QC + (t0 + j) * 512 + h * 128 + 8 * c);
            *(LAS v4u*)(KS + j * 136 + 8 * c) = *(const GAS v4u*)(KC + (t0 + j) * 512 + h * 128 + 8 * c); }
#pragma unroll 1
        for (int it = 0; it < 4; ++it) { const int p = F.tid + 512 * it, dv = p >> 4, c = p & 15;
            *(LAS v4u*)(CPS + dv * 136 + 8 * c) = *(const GAS v4u*)(CP + (size_t)unit * 16384 + dv * 128 + 8 * c); }
#pragma unroll 1
        for (int it = 0; it < 2; ++it) {
            const int task = F.tid + 512 * it, j = task & 63, c = task >> 6;
            const v4u w = *(const GAS v4u*)(PJ + (t0 + j) * NPROJ + PJ_MV + h * 128 + 8 * c);
            const unsigned ws_[4] = {w.x, w.y, w.z, w.w};
#pragma unroll
            for (int i = 0; i < 4; ++i) { VT[(8 * c + 2 * i) * 72 + j] = (unsigned short)(ws_[i] & 0xffffu); VT[(8 * c + 2 * i + 1) * 72 + j] = (unsigned short)(ws_[i] >> 16); }
        }
        __syncthreads();
        {
            const int lb = F.wave >> 2, dvb = F.wave & 3, lrow = lb * 32 + r32;
            f32x16 st0 = {}, st1 = {}, qc = {};
#pragma unroll
            for (int ks = 0; ks < 8; ++ks) {
                const bf16x8 qf = *(const LAS bf16x8*)(QS + lrow * 136 + 16 * ks + 8 * hi);
                const bf16x8 k0 = *(const LAS bf16x8*)(KS + r32 * 136 + 16 * ks + 8 * hi);
                st0 = MFMA32(k0, qf, st0);
                if (lb) { const bf16x8 k1 = *(const LAS bf16x8*)(KS + (32 + r32) * 136 + 16 * ks + 8 * hi); st1 = MFMA32(k1, qf, st1); }
                const bf16x8 cf = *(const LAS bf16x8*)(CPS + (dvb * 32 + r32) * 136 + 16 * ks + 8 * hi);
                qc = MFMA32(qf, cf, qc);
            }
            const float Ml = MROW[lrow];
            float rs = 0.f; f32x16 hacc = {};
            {
                float sw[16];
#pragma unroll
                for (int r = 0; r < 16; ++r) { const int s = crow16(r, hi); const float v = st0[r] * KSCALE * __expf(MROW[64 + s] - Ml); sw[r] = (s <= lrow) ? v : 0.f; rs += sw[r]; }
#pragma unroll
                for (int k2 = 0; k2 < 2; ++k2) {
                    v4u pa; pa.x = pk2(sw[8 * k2 + 0], sw[8 * k2 + 1]); pa.y = pk2(sw[8 * k2 + 2], sw[8 * k2 + 3]); pa.z = pk2(sw[8 * k2 + 4], sw[8 * k2 + 5]); pa.w = pk2(sw[8 * k2 + 6], sw[8 * k2 + 7]);
                    const v2u v0 = *(const LAS v2u*)(VT + (dvb * 32 + r32) * 72 + 16 * k2 + 4 * hi), v1 = *(const LAS v2u*)(VT + (dvb * 32 + r32) * 72 + 16 * k2 + 8 + 4 * hi);
                    v4u vb; vb.x = v0.x; vb.y = v0.y; vb.z = v1.x; vb.w = v1.y;
                    hacc = MFMA32(__builtin_bit_cast(bf16x8, pa), __builtin_bit_cast(bf16x8, vb), hacc); }
            }
            if (lb) {
                float sw[16];
#pragma unroll
                for (int r = 0; r < 16; ++r) { const int s = 32 + crow16(r, hi); const float v = st1[r] * KSCALE * __expf(MROW[64 + s] - Ml); sw[r] = (s <= lrow) ? v : 0.f; rs += sw[r]; }
#pragma unroll
                for (int k2 = 0; k2 < 2; ++k2) {
                    v4u pa; pa.x = pk2(sw[8 * k2 + 0], sw[8 * k2 + 1]); pa.y = pk2(sw[8 * k2 + 2], sw[8 * k2 + 3]); pa.z = pk2(sw[8 * k2 + 4], sw[8 * k2 + 5]); pa.w = pk2(sw[8 * k2 + 6], sw[8 * k2 + 7]);
                    const v2u v0 = *(const LAS v2u*)(VT + (dvb * 32 + r32) * 72 + 32 + 16 * k2 + 4 * hi), v1 = *(const LAS v2u*)(VT + (dvb * 32 + r32) * 72 + 32 + 16 * k2 + 8 + 4 * hi);
                    v4u vb; vb.x = v0.x; vb.y = v0.y; vb.z = v1.x; vb.w = v1.y;
                    hacc = MFMA32(__builtin_bit_cast(bf16x8, pa), __builtin_bit_cast(bf16x8, vb), hacc); }
            }
            rs += __shfl_xor(rs, 32);
            float qn = 0.f;
#pragma unroll
            for (int q8 = 0; q8 < 8; ++q8) { const v4u w = *(const LAS v4u*)(QS + lrow * 136 + 64 * hi + 8 * q8); const LAS float* np = NPS + 64 * hi + 8 * q8;
                qn += bflo(w.x) * np[0] + bfhi(w.x) * np[1] + bflo(w.y) * np[2] + bfhi(w.y) * np[3] + bflo(w.z) * np[4] + bfhi(w.z) * np[5] + bflo(w.w) * np[6] + bfhi(w.w) * np[7]; }
            qn += __shfl_xor(qn, 32);
            const float dec = __expf(mprev - Ml), den = dec * qn + rs, ml = MROW[128 + lrow] + Ml;
            const float inv = 1.0f / fmaxf(fabsf(den), __expf(-ml));
            if (hi == 0) { WSCR[r32] = dec; WSCR[32 + r32] = inv; }
            LDS_WAIT(); asm volatile("" ::: "memory");
#pragma unroll
            for (int r = 0; r < 16; ++r) { const int lr = crow16(r, hi); const float v = (WSCR[lr] * qc[r] + hacc[r]) * WSCR[32 + lr];
                HM[(lb * 32 + lr) * 132 + dvb * 32 + r32] = v; }
        }
        __syncthreads();
        {
            const int lr = F.tid >> 3, part = F.tid & 7;
            const v4u o0 = *(const GAS v4u*)(PJ + (t0 + lr) * NPROJ + PJ_MO + h * 128 + 16 * part), o1 = *(const GAS v4u*)(PJ + (t0 + lr) * NPROJ + PJ_MO + h * 128 + 16 * part + 8);
            const float ov[16] = {bflo(o0.x), bfhi(o0.x), bflo(o0.y), bfhi(o0.y), bflo(o0.z), bfhi(o0.z), bflo(o0.w), bfhi(o0.w), bflo(o1.x), bfhi(o1.x), bflo(o1.y), bfhi(o1.y), bflo(o1.z), bfhi(o1.z), bflo(o1.w), bfhi(o1.w)};
            float hv[16]; float ss = 0.f;
#pragma unroll
            for (int i = 0; i < 16; ++i) { hv[i] = HM[lr * 132 + 16 * part + i] / (1.0f + __expf(-ov[i])); ss += hv[i] * hv[i]; }
            ss += __shfl_xor(ss, 1); ss += __shfl_xor(ss, 2); ss += __shfl_xor(ss, 4);
            const float rstd = 1.0f / sqrtf(ss * (1.0f / 128.0f) + EPS);
            const float* gn = F.in(12) + (size_t)l * 512 + h * 128 + 16 * part;
            v4u w0, w1;
            w0.x = pk2(hv[0] * rstd * gn[0], hv[1] * rstd * gn[1]); w0.y = pk2(hv[2] * rstd * gn[2], hv[3] * rstd * gn[3]); w0.z = pk2(hv[4] * rstd * gn[4], hv[5] * rstd * gn[5]); w0.w = pk2(hv[6] * rstd * gn[6], hv[7] * rstd * gn[7]);
            w1.x = pk2(hv[8] * rstd * gn[8], hv[9] * rstd * gn[9]); w1.y = pk2(hv[10] * rstd * gn[10], hv[11] * rstd * gn[11]); w1.z = pk2(hv[12] * rstd * gn[12], hv[13] * rstd * gn[13]); w1.w = pk2(hv[14] * rstd * gn[14], hv[15] * rstd * gn[15]);
            bf16* mp = MIXED + (t0 + lr) * DM + 512 + h * 128 + 16 * part;
            *(GAS v4u*)mp = w0; *(GAS v4u*)(mp + 8) = w1;
        }
        __syncthreads();
    }
}
__device__ __forceinline__ void build_bias_table(Frame& F) {
    LAS float* tab = (LAS float*)(F.lds + BIAS_OFF);
    for (int i = F.tid; i < 4 * 512; i += NWAVES * 64) { const int h = i >> 9, j = i & 511, d = 383 - j;
        float v = 0.f; if (d >= 0 && d < 128) v = (F.in(2)[T5_BUCKET[d] * 4 + h] - F.in(2)[31 * 4 + h]) * 1.4426950408889634f;
        tab[i] = v; }
    __syncthreads();
}
__device__ __forceinline__ void attn_phase_diff(Frame& F, unsigned char* lds_generic) {
    const bf16* PJ = (const bf16*)(F.ws + WS_R); bf16* AO = (bf16*)(F.ws + WS_Y);
    const int s = F.vcu & 7, bhc = F.vcu >> 3, b = bhc >> 3, hc = bhc & 7, hh = hc >> 1, cc = hc & 1;
    if (bhc < 32) {
#pragma unroll 1
        for (int i = 0; i < 8; ++i) {
            const int vh = i >> 2, ii = i & 3, qb = (ii == 0) ? s : (ii == 1) ? 15 - s : (ii == 2) ? 16 + s : 31 - s;
            attn_body::attn_unit<8>(b, PJ_AQ + hc * 64, PJ_AK + hc * 64, PJ_AV + hh * 128 + vh * 64, cc * 512 + hh * 128 + vh * 64, qb,
                                    (const attn_body::bf16*)PJ, (attn_body::bf16*)AO, (char*)lds_generic + RING_OFF, (attn_body::lds_cfptr)(F.lds + BIAS_OFF) + hh * 512);
        }
    }
}
__device__ __forceinline__ void combine_phase(Frame& F, const int l) {
    const bf16* AO = (const bf16*)(F.ws + WS_Y); bf16* MIXED = (bf16*)(F.ws + WS_R + 224 * MiB);
    const float lam_init = 0.8f - 0.6f * expf(-0.3f * (float)l);
    const float* lv = F.in(10) + (size_t)l * 256;
    const float s01 = wave_sum(lv[F.lane] * lv[64 + F.lane]), s23 = wave_sum(lv[128 + F.lane] * lv[192 + F.lane]);
    const float lam = expf(s01) - expf(s23) + lam_init;
    const int gw = F.vcu * NWAVES + F.wave, NGW = F.G * NWAVES;
    float gn[8];
#pragma unroll
    for (int k = 0; k < 8; ++k) gn[k] = F.in(11)[(size_t)l * 128 + ((8 * F.lane + k) & 127)] * (1.0f - lam_init);
    for (int row = gw; row < M; row += NGW) {
        const v4u a0 = *(const GAS v4u*)(AO + (size_t)row * DM + 8 * F.lane), a1 = *(const GAS v4u*)(AO + (size_t)row * DM + 512 + 8 * F.lane);
        const float o0[8] = {bflo(a0.x), bfhi(a0.x), bflo(a0.y), bfhi(a0.y), bflo(a0.z), bfhi(a0.z), bflo(a0.w), bfhi(a0.w)};
        const float o1[8] = {bflo(a1.x), bfhi(a1.x), bflo(a1.y), bfhi(a1.y), bflo(a1.z), bfhi(a1.z), bflo(a1.w), bfhi(a1.w)};
        float a[8]; float ss = 0.f;
#pragma unroll
        for (int k = 0; k < 8; ++k) { a[k] = o0[k] - lam * o1[k]; ss += a[k] * a[k]; }
        ss += __shfl_xor(ss, 1); ss += __shfl_xor(ss, 2); ss += __shfl_xor(ss, 4); ss += __shfl_xor(ss, 8);
        const float rstd = 1.0f / sqrtf(ss * (1.0f / 128.0f) + EPS);
        v4u w; w.x = pk2(a[0] * rstd * gn[0], a[1] * rstd * gn[1]); w.y = pk2(a[2] * rstd * gn[2], a[3] * rstd * gn[3]); w.z = pk2(a[4] * rstd * gn[4], a[5] * rstd * gn[5]); w.w = pk2(a[6] * rstd * gn[6], a[7] * rstd * gn[7]);
        *(GAS v4u*)(MIXED + (size_t)row * DM + 8 * F.lane) = w;
    }
}
__device__ __forceinline__ void moe_gather(Frame& F, const int mj) {
    gu32* gcnt = F.ctl + CW_MOECNT + 64 * mj;
    const bf16* H = (const bf16*)(F.ws + WS_H); bf16* HS = (bf16*)(F.ws + WS_Y); const int* rowidx = (const int*)(F.ws + WS_ROWIDX);
    unsigned cn[8]; int pb[9]; pb[0] = 0;
#pragma unroll
    for (int e = 0; e < 8; ++e) { cn[e] = gcnt[e]; pb[e + 1] = pb[e] + (int)((cn[e] + 255u) >> 8) * 256; }
    const int gw = F.vcu * NWAVES + F.wave, NGW = F.G * NWAVES;
    for (int slot = gw; slot < pb[8]; slot += NGW) {
        int e = 0, base = 0; unsigned ce = cn[0];
#pragma unroll
        for (int k = 1; k < 8; ++k) if (slot >= pb[k]) { e = k; base = pb[k]; ce = cn[k]; }
        const int pos = slot - base;
        v4u v0 = (v4u){0u, 0u, 0u, 0u}, v1 = v0;
        if ((unsigned)pos < ce) { const int tok = rowidx[(size_t)e * M + pos]; v0 = *(const GAS v4u*)(H + (size_t)tok * DM + 8 * F.lane); v1 = *(const GAS v4u*)(H + (size_t)tok * DM + 512 + 8 * F.lane); }
        *(GAS v4u*)(HS + (size_t)slot * DM + 8 * F.lane) = v0; *(GAS v4u*)(HS + (size_t)slot * DM + 512 + 8 * F.lane) = v1;
    }
}
struct Args { const float* in[21]; float* out; unsigned char* ws; int ph_lo, ph_hi; };
__global__ void __launch_bounds__(NWAVES * 64, 2) hymba_fwd(Args args) {
    extern __shared__ __attribute__((aligned(16))) unsigned char lds[];
    Frame F;
    F.lds = (LAS unsigned char*)lds;
    F.MISC = (volatile LAS unsigned*)(F.lds + MISC_OFF);
    F.G = gridDim.x; PHASE_BEGIN();
    F.ws = args.ws; F.ctl = (gu32*)(args.ws + WS_CTL); F.out = args.out;
    for (int u = F.tid; u < (BIAS_OFF - LDSCTL_OFF) / 4; u += NWAVES * 64) ((LAS unsigned*)(F.lds + LDSCTL_OFF))[u] = 0u;
    __syncthreads();
    XcdBarrier bar; bar.bar = (unsigned*)(F.ctl + CW_BAR); bar.x = 0; bar.st = nullptr;
    if (MK_ONE_LAUNCH) bar = xcd_barrier_post((unsigned*)(F.ctl + CW_BAR), F.MISC + 8);
    const int lo = args.ph_lo, hi = args.ph_hi;
#define IN(k) (lo <= (k) && (k) < hi)
#define SEAM(k) do { if (MK_ONE_LAUNCH && IN(k) && IN((k) + 1)) xcd_barrier(bar); } while (0)
    bf16* const H = (bf16*)(F.ws + WS_H); bf16* const Y = (bf16*)(F.ws + WS_Y); bf16* const PROJ = (bf16*)(F.ws + WS_R); bf16* const MIXED = (bf16*)(F.ws + WS_R + 224 * MiB); bf16* const HID = (bf16*)(F.ws + WS_R);

    if (IN(0) && PHM(0)) { PHASE_BEGIN(); p_ada(F); p_convert_dense(F); } SEAM(0);
    if (IN(1) && PHM(1)) { PHASE_BEGIN(); row_phase(F, 0, 0); } SEAM(1);
#pragma unroll 1
    for (int l = 0; l < DEPTH; ++l) {
        const int pb = 2 + l * NPH; const bool moe = (l & 1) != 0; const int mj = l >> 1;
        if (IN(pb + 0) && PHM(2)) { PHASE_BEGIN();
            pg8::Gemm g{H, (const bf16*)(F.ws + WS_WIN) + (size_t)l * NPROJ * DM, M, NPROJ, DM}; pg8::StaticOrder S; S.init(M, NPROJ, F.G, (int)F.bx);
            pg8::EpiPlain E{PROJ, NPROJ, 512, attn_body::C2, 0};
            pg8::gemm_phase<pg8::EpiPlain, pg8::StaticOrder, PG8_ALIGN, PG8_SP2>(F.lds + RING_OFF, g, S, E, F.tid);
        } SEAM(pb + 0);
        if (IN(pb + 1) && PHM(3)) { PHASE_BEGIN(); mlstm_pass1(F, l); } SEAM(pb + 1);
        if (IN(pb + 2) && PHM(4)) { PHASE_BEGIN(); mlstm_pass2(F); } SEAM(pb + 2);
        if (IN(pb + 3)) { PHASE_BEGIN(); if (PHM(5)) { build_bias_table(F); attn_phase_diff(F, lds); __syncthreads(); } if (PHM(6)) mlstm_pass3(F, l); } SEAM(pb + 3);
        if (IN(pb + 4) && PHM(7)) { PHASE_BEGIN(); combine_phase(F, l); } SEAM(pb + 4);
        if (IN(pb + 5) && PHM(8)) { PHASE_BEGIN();
            pg8::Gemm g{MIXED, (const bf16*)(F.ws + WS_WOUT) + (size_t)l * DM * DM, M, DM, DM}; pg8::StaticOrder S; S.init(M, DM, F.G, (int)F.bx);
            pg8::EpiPlain E{Y, DM, 0, 1.f, 0};
            pg8::gemm_phase<pg8::EpiPlain, pg8::StaticOrder, PG8_ALIGN, PG8_SP2>(F.lds + RING_OFF, g, S, E, F.tid);
        } SEAM(pb + 5);
        if (IN(pb + 6)) { PHASE_BEGIN(); if (PHM(9)) row_phase(F, l, 1); if (moe && PHM(10)) p_convert_moe(F, mj); } SEAM(pb + 6);
        if (moe) { if (IN(pb + 7) && PHM(11)) { PHASE_BEGIN(); moe_gather(F, mj); } SEAM(pb + 7); }
        if (IN(pb + 8)) { PHASE_BEGIN();
            if (!moe) { if (PHM(12)) { pg8::Gemm g{H, (const bf16*)(F.ws + WS_WUP) + (size_t)mj * NUP * DM, M, NUP, DM}; pg8::StaticOrder S; S.init(M, NUP, F.G, (int)F.bx);
                pg8::EpiSwiglu E{HID, DFF, 0};
                pg8::gemm_phase<pg8::EpiSwiglu, pg8::StaticOrder, PG8_ALIGN, PG8_SP2>(F.lds + RING_OFF, g, S, E, F.tid); }
            } else if (PHM(13)) { pg8::Gemm g{Y  , (const bf16*)(F.ws + WS_WMUP), MPAD, NEXP * NUP, DM}; pg8::MoeOrder S; S.init((const unsigned*)(F.ctl + CW_MOECNT + 64 * mj), NUP / 256, F.G, (int)F.bx);
                pg8::EpiSwiglu E{HID, DFF, NUP / 256};
                pg8::gemm_phase<pg8::EpiSwiglu, pg8::MoeOrder, PG8_ALIGN, PG8_SP2>(F.lds + RING_OFF, g, S, E, F.tid);
            }
        } SEAM(pb + 8);
        if (IN(pb + 9)) { PHASE_BEGIN();
            if (!moe) { if (PHM(14)) { pg8::Gemm g{HID, (const bf16*)(F.ws + WS_WDN) + (size_t)mj * DM * DFF, M, DM, DFF}; pg8::StaticOrder S; S.init(M, DM, F.G, (int)F.bx);
                pg8::EpiPlain E{Y, DM, 0, 1.f, 0};
                pg8::gemm_phase<pg8::EpiPlain, pg8::StaticOrder, PG8_ALIGN, PG8_SP2>(F.lds + RING_OFF, g, S, E, F.tid); }
            } else if (PHM(15)) { pg8::Gemm g{HID, (const bf16*)(F.ws + WS_WMDN), MPAD, NEXP * DM, DFF}; pg8::MoeOrder S; S.init((const unsigned*)(F.ctl + CW_MOECNT + 64 * mj), DM / 256, F.G, (int)F.bx);
                pg8::EpiPlain E{Y  , DM, 0, 1.f, DM / 256};
                pg8::gemm_phase<pg8::EpiPlain, pg8::MoeOrder, PG8_ALIGN, PG8_SP2>(F.lds + RING_OFF, g, S, E, F.tid);
            }
        } SEAM(pb + 9);
        if (IN(pb + 10) && PHM(16)) { PHASE_BEGIN(); row_phase(F, l, 2); }
        if (l + 1 < DEPTH) SEAM(pb + 10);
    }
#undef IN
#undef SEAM
}

extern "C" void kernel_launch(void* const* d_in, const int* in_sizes, int n_in, void* d_out, int out_size, void* d_ws, size_t ws_size, hipStream_t stream) {
    static int grid = 0;
    if (grid == 0) {
        if (n_in != 21 || out_size != M * DM || ws_size < WS_END) { fprintf(stderr, "kernel_launch: unexpected shapes (n_in %d out %d ws %zu)\n", n_in, out_size, ws_size); grid = -1; return; }
        if (hipFuncSetAttribute((const void*)hymba_fwd, hipFuncAttributeMaxDynamicSharedMemorySize, LDS_BYTES) != hipSuccess) { fprintf(stderr, "kernel_launch: hipFuncSetAttribute failed\n"); grid = -1; return; }
        int dev = 0, cus = 0, per_cu = 0;
        (void)hipGetDevice(&dev); (void)hipDeviceGetAttribute(&cus, hipDeviceAttributeMultiprocessorCount, dev);
        (void)hipOccupancyMaxActiveBlocksPerMultiprocessor(&per_cu, (const void*)hymba_fwd, NWAVES * 64, LDS_BYTES);
        (void)hipGetLastError();
        if (MK_ONE_LAUNCH && (cus < 256 || per_cu < 1)) { fprintf(stderr, "kernel_launch: needs 256 CUs with one resident workgroup each (cus %d, per_cu %d)\n", cus, per_cu); grid = -1; return; }
        grid = 256;
    }
    if (grid < 0) return;
    (void)hipMemsetAsync((char*)d_ws + WS_CTL, 0, CTL_ZERO_BYTES, stream);
    Args a{};
    for (int i = 0; i < 21; ++i) a.in[i] = (const float*)d_in[i];
    a.out = (float*)d_out; a.ws = (unsigned char*)d_ws;
#if MK_ONE_LAUNCH
    a.ph_lo = 0; a.ph_hi = PH_TOTAL;
    hipLaunchKernelGGL(hymba_fwd, dim3(grid), dim3(NWAVES * 64), LDS_BYTES, stream, a);
#else
    for (int p = 0; p < PH_TOTAL; ++p) {
        const int rel = (p - 2) % NPH, l = (p - 2) / NPH;
        if (p >= 2 && rel == 7 && !(l & 1)) continue;
        a.ph_lo = p; a.ph_hi = p + 1;
        hipLaunchKernelGGL(hymba_fwd, dim3(grid), dim3(NWAVES * 64), LDS_BYTES, stream, a);
    }
#endif
}
```

```cpp
#include <hip/hip_runtime.h>
#include <cstdio>
#include <cstdint>
namespace pg8 {
#define PG8_LAS __attribute__((address_space(3)))
typedef unsigned short bf16_t;
typedef short bf16x8 __attribute__((ext_vector_type(8)));
typedef float f32x4 __attribute__((ext_vector_type(4)));
typedef unsigned u32x4 __attribute__((ext_vector_type(4)));
constexpr int BM = 256, BK = 64, HALF = 128, HTB = HALF * BK * 2  , STAGE_BYTES = 8 * HTB, NXCD = 8, WGM = 8;

__host__ __device__ __forceinline__ int lds_byte(int r, int c) { const int st = (r >> 4) * 2 + (c >> 5), rr = r & 15, cc = c & 31, ob = rr * 64 + cc * 2; return st * 1024 + (ob ^ (((ob >> 9) & 1) << 5)); }
__host__ __device__ __forceinline__ void stage_rc(int b, int& R, int& C) { const int st = b / 1024, sb = b % 1024, swz = sb ^ (((sb >> 9) & 1) << 5); R = (st >> 1) * 16 + swz / 64; C = (st & 1) * 32 + (swz % 64) / 2; }
__host__ __device__ __forceinline__ int perm32(int rho) { const int n = rho >> 4, i = rho & 15; return 8 * (i >> 2) + 4 * n + (i & 3); }

struct Unit { int pm, pn; };
typedef int v4i32_t __attribute__((ext_vector_type(4)));
struct Gemm { const bf16_t* A; const bf16_t* Bt; int M, N, K; int scale_a = 127, scale_b = 127; };

struct StaticOrder {
    int nM, nN, nwg, G, c;
    __host__ __device__ void init(int M, int N, int G_, int c_) { nM = M / BM; nN = N / BM; nwg = nM * nN; G = G_; c = c_; }
    __host__ __device__ bool next(int i, Unit& u) const {
        const long L = (long)i * G + c; if (L >= nwg) return false;
        int wgid = (int)L; { const int q = nwg / NXCD, r = nwg % NXCD, xcd = wgid % NXCD, off = wgid / NXCD; wgid = (xcd < r ? xcd * (q + 1) : r * (q + 1) + (xcd - r) * q) + off; }
        const int nig = WGM * nN, gid = wgid / nig, fm = gid * WGM, gsz = (nM - fm) < WGM ? (nM - fm) : WGM;
        u.pm = fm + ((wgid % nig) % gsz); u.pn = (wgid % nig) / gsz; return true;
    }
    __device__ __forceinline__ void a_ready(const Unit&) const {}
    __device__ __forceinline__ void done(const Unit&) const {}
};

__device__ __forceinline__ unsigned cvt_pk_bf16(float lo, float hi) { unsigned r; asm volatile("v_cvt_pk_bf16_f32 %0, %1, %2" : "=v"(r) : "v"(lo), "v"(hi)); return r; }
typedef float f32x2 __attribute__((ext_vector_type(2)));
__device__ __forceinline__ f32x2 gelu_pk(f32x2 v) {
    const f32x2 av = __builtin_elementwise_abs(v), d = av * 0.2316418882f + 1.0f;
    f32x2 t; t.x = __builtin_amdgcn_rcpf(d.x); t.y = __builtin_amdgcn_rcpf(d.y);
    f32x2 q = t * 0.5307027145f + (-0.7265760135f); q = q * t + 0.7107068705f; q = q * t + (-0.142248368f); q = q * t + 0.127414796f; q = q * t;
    const f32x2 s = (v * v) * (-0.72134752044f);
    f32x2 e; e.x = __builtin_amdgcn_exp2f(s.x); e.y = __builtin_amdgcn_exp2f(s.y);
    const f32x2 m = v * (q * e), r = v - m;
    f32x2 o; o.x = v.x < 0.f ? m.x : r.x; o.y = v.y < 0.f ? m.y : r.y; return o;
}

template <int ACT  > struct EpiBf16 {
    static constexpr bool PERM = true, AFTER_DRAIN = false; static_assert(ACT == 0 || ACT == 1, "EpiBf16: ACT is 0 (none) or 1 (gelu_pk)");
    bf16_t* O; int ldc; const float* bias; int split_cols; size_t split_stride; float scale0;
    __device__ __forceinline__ void operator()(const f32x4 (&acc)[2][2][4][2], const Unit& u, int wr, int wc, int fr, int fq) const {
        const int row0 = u.pm * BM + wr * 64 + fr; int colt = u.pn * BM; bf16_t* base = O;
        float sc = 1.f; if (split_cols) { const int t = colt / split_cols; base += (size_t)t * split_stride; colt -= t * split_cols; if (t == 0) sc = scale0; }
        const int col0 = colt + wc * 32 + 8 * fq, bcol0 = u.pn * BM + wc * 32 + 8 * fq;
        f32x4 bv[2][2];
#pragma unroll
        for (int bj = 0; bj < 2; ++bj)
#pragma unroll
            for (int n = 0; n < 2; ++n) bv[bj][n] = bias ? *(const f32x4*)(bias + bcol0 + bj * HALF + 4 * n) : (f32x4){0.f, 0.f, 0.f, 0.f};
#pragma unroll
        for (int ai = 0; ai < 2; ++ai)
#pragma unroll
            for (int m = 0; m < 4; ++m) { bf16_t* rowp = base + (size_t)(row0 + ai * HALF + m * 16) * ldc + col0;
#pragma unroll
                for (int bj = 0; bj < 2; ++bj) { f32x4 v0 = acc[ai][bj][m][0] + bv[bj][0], v1 = acc[ai][bj][m][1] + bv[bj][1];
                    if (ACT == 1) { f32x2 a = gelu_pk((f32x2){v0[0], v0[1]}), b = gelu_pk((f32x2){v0[2], v0[3]}), c = gelu_pk((f32x2){v1[0], v1[1]}), d = gelu_pk((f32x2){v1[2], v1[3]});
                        v0 = (f32x4){a.x, a.y, b.x, b.y}; v1 = (f32x4){c.x, c.y, d.x, d.y}; }
                    v0 = v0 * sc; v1 = v1 * sc; u32x4 w; w.x = cvt_pk_bf16(v0[0], v0[1]); w.y = cvt_pk_bf16(v0[2], v0[3]); w.z = cvt_pk_bf16(v1[0], v1[1]); w.w = cvt_pk_bf16(v1[2], v1[3]);
                    *(u32x4*)(rowp + bj * HALF) = w; } }
    }
};


template <class Epi, class Sched, bool ALIGN_EPI = false, bool SP2 = false, bool FP8 = false, bool I8 = false>
__device__ __forceinline__ void gemm_phase(PG8_LAS unsigned char* lds, const Gemm g, const Sched& S, const Epi& E, const int tid) {
    const int wid = __builtin_amdgcn_readfirstlane(tid >> 6), lane = tid & 63, wr = wid >> 2, wc = wid & 3, fr = lane & 15, fq = lane >> 4;
    const int K = g.K, nt = K / BK;
    unsigned voffA[2], voffB[2];
#pragma unroll
    for (int i = 0; i < 2; ++i) { int R, C; stage_rc(tid * 16 + i * 8192, R, C); const int Rb = Epi::PERM ? ((R & ~31) + perm32(R & 31)) : R;
        voffA[i] = (unsigned)(R * K + C) * 2u; voffB[i] = (unsigned)(Rb * K + C) * 2u; }
    const unsigned lds32 = (unsigned)(uintptr_t)lds; const size_t rstep64 = (size_t)64 * K * 2;
    const size_t kstep = (size_t)(BK * 2);
    const size_t hstep = (size_t)HALF * K * 2;
    const size_t tstep = 2 * hstep;
    const unsigned ldsw = (unsigned)wid * 1024u;
    const int aoff = lds_byte(wr * 64 + fr, fq * 8), boff = lds_byte(wc * 32 + fr, fq * 8);
#define PG8_SA(b, h) (((b) * 2 + (h)) * HTB)
#define PG8_SB(b, h) ((4 + (b) * 2 + (h)) * HTB)
#define PG8_GLDS(gptr, vo, ldsaddr) do { unsigned _keep; asm volatile("s_mov_b32 %0, m0\n\ts_mov_b32 m0, %3\n\ts_nop 0\n\tglobal_load_lds_dwordx4 %1, %2\n\ts_mov_b32 m0, %0" \
        : "=&s"(_keep) : "v"(vo), "s"(gptr), "s"(ldsaddr) : "memory"); } while (0)
#define PG8_STAGE(bufoff, gbase, voff) do { const unsigned _la = lds32 + (unsigned)(bufoff) + ldsw; \
        PG8_GLDS((const char*)(gbase), (voff)[0], _la); PG8_GLDS((const char*)(gbase) + rstep64, (voff)[0], _la + 8192u); } while (0)
#define PG8_LDA(dst, b, h) do { _Pragma("unroll") for (int m = 0; m < 4; ++m) _Pragma("unroll") for (int k = 0; k < 2; ++k) dst[m][k] = *(const PG8_LAS bf16x8*)(lds + PG8_SA(b, h) + aoff + m * 2048 + k * 1024); } while (0)
#define PG8_LDB(dst, b, h) do { _Pragma("unroll") for (int n = 0; n < 2; ++n) _Pragma("unroll") for (int k = 0; k < 2; ++k) dst[n][k] = *(const PG8_LAS bf16x8*)(lds + PG8_SB(b, h) + boff + n * 2048 + k * 1024); } while (0)
#define PG8_MMA(ai, bj, At, Bt) do { __builtin_amdgcn_s_setprio(1); \
        if constexpr (FP8) { _Pragma("unroll") for (int m = 0; m < 4; ++m) _Pragma("unroll") for (int n = 0; n < 2; ++n) \
            acc[ai][bj][m][n] = __builtin_amdgcn_mfma_scale_f32_16x16x128_f8f6f4(__builtin_shufflevector(__builtin_bit_cast(v4i32_t, Bt[n][0]), __builtin_bit_cast(v4i32_t, Bt[n][1]), 0, 1, 2, 3, 4, 5, 6, 7), \
                __builtin_shufflevector(__builtin_bit_cast(v4i32_t, At[m][0]), __builtin_bit_cast(v4i32_t, At[m][1]), 0, 1, 2, 3, 4, 5, 6, 7), acc[ai][bj][m][n], 0, 0, 0, g.scale_b, 0, g.scale_a); } \
        else if constexpr (I8) { _Pragma("unroll") for (int m = 0; m < 4; ++m) _Pragma("unroll") for (int n = 0; n < 2; ++n) _Pragma("unroll") for (int k = 0; k < 2; ++k)   \
            acc[ai][bj][m][n] = __builtin_bit_cast(f32x4, __builtin_amdgcn_mfma_i32_16x16x64_i8(__builtin_bit_cast(v4i32_t, Bt[n][k]), __builtin_bit_cast(v4i32_t, At[m][k]), __builtin_bit_cast(v4i32_t, acc[ai][bj][m][n]), 0, 0, 0)); } \
        else { _Pragma("unroll") for (int m = 0; m < 4; ++m) _Pragma("unroll") for (int n = 0; n < 2; ++n) _Pragma("unroll") for (int k = 0; k < 2; ++k) \
            acc[ai][bj][m][n] = __builtin_amdgcn_mfma_f32_16x16x32_bf16(Bt[n][k], At[m][k], acc[ai][bj][m][n], 0, 0, 0); } \
        __builtin_amdgcn_s_setprio(0); } while (0)
#define PG8_WAIT_V(n) asm volatile("s_waitcnt vmcnt(" #n ")" ::: "memory")
#define PG8_WAIT_L(n) asm volatile("s_waitcnt lgkmcnt(" #n ")" ::: "memory")
#define PG8_BAR __builtin_amdgcn_s_barrier()
#define PG8_SCHED __builtin_amdgcn_sched_barrier(0)
    Unit cur, nxt; int ui = 0;
    if (!S.next(0, cur)) return;
    f32x4 acc[2][2][4][2];
#pragma unroll
    for (int a = 0; a < 2; ++a)
#pragma unroll
        for (int b = 0; b < 2; ++b)
#pragma unroll
            for (int m = 0; m < 4; ++m)
#pragma unroll
                for (int n = 0; n < 2; ++n) acc[a][b][m][n] = (f32x4){0.f, 0.f, 0.f, 0.f};
    bf16x8 At[4][2], B0[2][2], B1[2][2];
    const char* cA = (const char*)g.A + (size_t)cur.pm * tstep; const char* cB = (const char*)g.Bt + (size_t)cur.pn * tstep;
    S.a_ready(cur);
    if constexpr (SP2) {
        PG8_STAGE(PG8_SB(0, 0), cB, voffB); PG8_STAGE(PG8_SB(0, 1), cB + hstep, voffB); PG8_STAGE(PG8_SA(0, 0), cA, voffA); PG8_STAGE(PG8_SA(0, 1), cA + hstep, voffA);
        if (wr == 1) PG8_BAR;
        PG8_WAIT_V(2); PG8_BAR;
        PG8_STAGE(PG8_SB(1, 0), cB + kstep, voffB); PG8_STAGE(PG8_SA(1, 0), cA + kstep, voffA); PG8_STAGE(PG8_SB(1, 1), cB + hstep + kstep, voffB);
        PG8_WAIT_V(6); PG8_BAR;
    } else {
        PG8_STAGE(PG8_SB(0, 0), cB, voffB); PG8_STAGE(PG8_SA(0, 0), cA, voffA); PG8_STAGE(PG8_SB(0, 1), cB + hstep, voffB); PG8_STAGE(PG8_SA(0, 1), cA + hstep, voffA);
        if (wr == 1) PG8_BAR;
        PG8_WAIT_V(4); PG8_BAR;
        PG8_STAGE(PG8_SB(1, 0), cB + kstep, voffB); PG8_STAGE(PG8_SA(1, 0), cA + kstep, voffA); PG8_STAGE(PG8_SB(1, 1), cB + hstep + kstep, voffB);
        PG8_WAIT_V(6); PG8_BAR;
    }
    for (;;) {
        const bool has_next = S.next(ui + 1, nxt);
        const char* nA = has_next ? (const char*)g.A + (size_t)nxt.pm * tstep : cA; const char* nB = has_next ? (const char*)g.Bt + (size_t)nxt.pn * tstep : cB;
#pragma unroll 1
        for (int t = 0; t < nt; t += 2) {
            const bool last = (t == nt - 2);
            const char* a1 = cA + (size_t)(t + 1) * kstep;
            const char* a2 = last ? nA : cA + (size_t)(t + 2) * kstep; const char* b2 = last ? nB : cB + (size_t)(t + 2) * kstep;
            const char* a3 = a2 + kstep; const char* b3 = b2 + kstep;
            if (last && has_next) S.a_ready(nxt);
            if constexpr (SP2) {
            PG8_LDB(B0, 0, 0); PG8_LDB(B1, 0, 1); PG8_SCHED; PG8_LDA(At, 0, 0); PG8_STAGE(PG8_SA(1, 1), a1 + hstep, voffA);
            PG8_WAIT_V(8); PG8_WAIT_L(0); PG8_BAR; PG8_MMA(0, 0, At, B0); PG8_MMA(0, 1, At, B1); PG8_BAR; PG8_SCHED;
            PG8_LDA(At, 0, 1); PG8_STAGE(PG8_SB(0, 0), b2, voffB); PG8_STAGE(PG8_SB(0, 1), b2 + hstep, voffB); PG8_STAGE(PG8_SA(0, 0), a2, voffA);
            PG8_WAIT_V(8); PG8_WAIT_L(0); PG8_BAR; PG8_MMA(1, 0, At, B0); PG8_MMA(1, 1, At, B1); PG8_BAR; PG8_SCHED;
            PG8_LDB(B0, 1, 0); PG8_LDB(B1, 1, 1); PG8_SCHED; PG8_LDA(At, 1, 0); PG8_STAGE(PG8_SA(0, 1), a2 + hstep, voffA);
            PG8_WAIT_V(8); PG8_WAIT_L(0); PG8_BAR; PG8_MMA(0, 0, At, B0); PG8_MMA(0, 1, At, B1); PG8_BAR; PG8_SCHED;
            PG8_LDA(At, 1, 1); PG8_STAGE(PG8_SB(1, 0), b3, voffB); PG8_STAGE(PG8_SB(1, 1), b3 + hstep, voffB); PG8_STAGE(PG8_SA(1, 0), a3, voffA);
            PG8_WAIT_V(8); PG8_WAIT_L(0); PG8_BAR; PG8_MMA(1, 0, At, B0); PG8_MMA(1, 1, At, B1); PG8_BAR; PG8_SCHED;
            } else {
            PG8_LDB(B0, 0, 0); PG8_SCHED; PG8_LDA(At, 0, 0); PG8_STAGE(PG8_SA(1, 1), a1 + hstep, voffA);
            PG8_WAIT_L(8); PG8_BAR; PG8_WAIT_L(0); PG8_MMA(0, 0, At, B0); PG8_BAR; PG8_SCHED;
            PG8_LDB(B1, 0, 1); PG8_STAGE(PG8_SB(0, 0), b2, voffB);
            PG8_BAR; PG8_WAIT_L(0); PG8_MMA(0, 1, At, B1); PG8_BAR;
            PG8_LDA(At, 0, 1); PG8_STAGE(PG8_SA(0, 0), a2, voffA);
            PG8_BAR; PG8_WAIT_L(0); PG8_MMA(1, 0, At, B0); PG8_BAR; PG8_SCHED;
            PG8_STAGE(PG8_SB(0, 1), b2 + hstep, voffB);
            PG8_WAIT_V(6); PG8_BAR; PG8_MMA(1, 1, At, B1); PG8_BAR;
            PG8_LDB(B0, 1, 0); PG8_SCHED; PG8_LDA(At, 1, 0); PG8_STAGE(PG8_SA(0, 1), a2 + hstep, voffA);
            PG8_WAIT_L(8); PG8_BAR; PG8_WAIT_L(0); PG8_MMA(0, 0, At, B0); PG8_BAR; PG8_SCHED;
            PG8_LDB(B1, 1, 1); PG8_STAGE(PG8_SB(1, 0), b3, voffB);
            PG8_BAR; PG8_WAIT_L(0); PG8_MMA(0, 1, At, B1); PG8_BAR;
            PG8_LDA(At, 1, 1); PG8_STAGE(PG8_SA(1, 0), a3, voffA);
            PG8_BAR; PG8_WAIT_L(0); PG8_MMA(1, 0, At, B0); PG8_BAR; PG8_SCHED;
            PG8_STAGE(PG8_SB(1, 1), b3 + hstep, voffB);
            PG8_WAIT_V(6); PG8_BAR; PG8_MMA(1, 1, At, B1); PG8_BAR;
            }
        }
        if constexpr (ALIGN_EPI) { if (wr == 0) PG8_BAR; }
        if constexpr (!Epi::AFTER_DRAIN) { unsigned o_ = ~0u; asm volatile("" : "+s"(o_)); const int le_ = (int)__builtin_amdgcn_mbcnt_hi(o_, __builtin_amdgcn_mbcnt_lo(o_, 0u));
            E(acc, cur, wr, wc, le_ & 15, le_ >> 4); S.done(cur); }
        if (!has_next) break;
#pragma unroll
        for (int a = 0; a < 2; ++a)
#pragma unroll
            for (int b = 0; b < 2; ++b)
#pragma unroll
                for (int m = 0; m < 4; ++m)
#pragma unroll
                    for (int n = 0; n < 2; ++n) acc[a][b][m][n] = (f32x4){0.f, 0.f, 0.f, 0.f};
        cur = nxt; cA = nA; cB = nB; ++ui;
        if constexpr (ALIGN_EPI) { if (wr == 1) PG8_BAR; }
    }
    PG8_WAIT_V(0);
    if constexpr (!ALIGN_EPI) { if (wr == 0) PG8_BAR; }
    PG8_BAR;
    if constexpr (Epi::AFTER_DRAIN) { E.fused(acc, cur, wr, wc, fr, fq, lds, wid, lane); S.done(cur); }
#undef PG8_SA
#undef PG8_SB
#undef PG8_STAGE
#undef PG8_GLDS
#undef PG8_LDA
#undef PG8_LDB
#undef PG8_MMA
#undef PG8_WAIT_V
#undef PG8_WAIT_L
#undef PG8_BAR
#undef PG8_SCHED
}
}

#ifndef PG8_SP2
#define PG8_SP2 true
#endif
#ifndef PG8_ALIGN
#define PG8_ALIGN true
#endif
namespace pg8 {
template <bool DQ = false> struct EpiPlainT {
    static constexpr bool PERM = true, AFTER_DRAIN = false;
    bf16_t* O; int ldc; int qcols; float scale0; int pn_mod; const float* sb = nullptr;
    __device__ __forceinline__ void operator()(const f32x4 (&acc)[2][2][4][2], const Unit& u, int wr, int wc, int fr, int fq) const {
        const int pn = pn_mod ? (u.pn % pn_mod) : u.pn;
        const int colt = pn * BM; const float sc = (colt < qcols) ? scale0 : 1.f;
        const int row0 = u.pm * BM + wr * 64 + fr, col0 = colt + wc * 32 + 8 * fq;
        f32x4 sbv[2][2];
        if constexpr (DQ) {
#pragma unroll
            for (int bj = 0; bj < 2; ++bj)
#pragma unroll
                for (int n = 0; n < 2; ++n) sbv[bj][n] = *(const __attribute__((address_space(1))) f32x4*)(sb + (size_t)u.pn * BM + bj * HALF + wc * 32 + 8 * fq + 4 * n); }
#pragma unroll
        for (int ai = 0; ai < 2; ++ai)
#pragma unroll
            for (int m = 0; m < 4; ++m) { bf16_t* rowp = O + (size_t)(row0 + ai * HALF + m * 16) * ldc + col0;
#pragma unroll
                for (int bj = 0; bj < 2; ++bj) { f32x4 v0, v1;
                    if constexpr (DQ) { v0 = __builtin_convertvector(__builtin_bit_cast(v4i32_t, acc[ai][bj][m][0]), f32x4) * sbv[bj][0]; v1 = __builtin_convertvector(__builtin_bit_cast(v4i32_t, acc[ai][bj][m][1]), f32x4) * sbv[bj][1]; }
                    else { v0 = acc[ai][bj][m][0] * sc; v1 = acc[ai][bj][m][1] * sc; }
                    u32x4 w; w.x = cvt_pk_bf16(v0[0], v0[1]); w.y = cvt_pk_bf16(v0[2], v0[3]); w.z = cvt_pk_bf16(v1[0], v1[1]); w.w = cvt_pk_bf16(v1[2], v1[3]);
                    *(u32x4*)(rowp + bj * HALF) = w; } }
    }
};
typedef EpiPlainT<false> EpiPlain;
__device__ __forceinline__ f32x4 dq4(const f32x4& a) { return __builtin_convertvector(__builtin_bit_cast(v4i32_t, a), f32x4); }
template <bool DQ = false> struct EpiProjHT {
    static constexpr bool PERM = true, AFTER_DRAIN = false;
    bf16_t* PJ; int MT; float scale0; const float* sa = nullptr; const float* sb = nullptr;
    __device__ __forceinline__ void operator()(const f32x4 (&acc)[2][2][4][2], const Unit& u, int wr, int wc, int fr, int fq) const {
        const int pn = u.pn; const float sc = (pn < 2) ? scale0 : 1.f;
        const size_t BLK = (size_t)MT * 512;
        f32x4 sbv[2][2];
        if constexpr (DQ) {
#pragma unroll
            for (int bj = 0; bj < 2; ++bj)
#pragma unroll
                for (int n = 0; n < 2; ++n) sbv[bj][n] = *(const __attribute__((address_space(1))) f32x4*)(sb + pn * BM + bj * HALF + wc * 32 + 8 * fq + 4 * n) * sc; }
        float sarv[2][4];
#pragma unroll
        for (int ai = 0; ai < 2; ++ai)
#pragma unroll
            for (int m = 0; m < 4; ++m) { sarv[ai][m] = 1.f; if constexpr (DQ) sarv[ai][m] = ((const __attribute__((address_space(1))) float*)sa)[u.pm * BM + wr * 64 + fr + ai * HALF + m * 16]; }
        size_t bo[2], SAe, SMe; const int rr = u.pm * BM + wr * 64 + fr;
        if (pn < 2) { const int hc0 = pn * 4 + (wc >> 1); SAe = 128 * 64; SMe = 16 * 64;
#pragma unroll
            for (int bj = 0; bj < 2; ++bj) bo[bj] = ((size_t)(hc0 + 2 * bj) * MT + rr) * 64 + (wc & 1) * 32 + 8 * fq; }
        else if (pn < 4) { const int hc0 = (pn - 2) * 4 + (wc >> 1), chunk = (wc & 1) * 4 + fq; SAe = 2 * 8 * 512; SMe = 16 * 8;
#pragma unroll
            for (int bj = 0; bj < 2; ++bj) bo[bj] = BLK + (((size_t)(hc0 + 2 * bj) * (MT / 64) + u.pm * 4 + wr) * 8 + chunk) * 512 + fr * 8; }
        else if (pn < 6) { const int h0 = (pn - 4) * 2; SAe = 2 * 4 * 2048; SMe = 16 * 32;
#pragma unroll
            for (int bj = 0; bj < 2; ++bj) bo[bj] = 2 * BLK + (((size_t)(h0 + bj) * (MT / 64) + u.pm * 4 + wr) * 4 + wc) * 2048 + fr * 32 + 8 * fq; }
        else { const int T = 3 + ((pn - 6) >> 1), h0 = ((pn - 6) & 1) * 2; SAe = 128 * 128; SMe = 16 * 128;
#pragma unroll
            for (int bj = 0; bj < 2; ++bj) bo[bj] = (size_t)T * BLK + ((size_t)(h0 + bj) * MT + rr) * 128 + wc * 32 + 8 * fq; }
#pragma unroll
        for (int ai = 0; ai < 2; ++ai)
#pragma unroll
            for (int m = 0; m < 4; ++m) {
                const float sar = sarv[ai][m];
#pragma unroll
                for (int bj = 0; bj < 2; ++bj) { f32x4 v0, v1;
                    if constexpr (DQ) { v0 = dq4(acc[ai][bj][m][0]) * sbv[bj][0] * sar; v1 = dq4(acc[ai][bj][m][1]) * sbv[bj][1] * sar; }
                    else { v0 = acc[ai][bj][m][0] * sc; v1 = acc[ai][bj][m][1] * sc; }
                    u32x4 w; w.x = cvt_pk_bf16(v0[0], v0[1]); w.y = cvt_pk_bf16(v0[2], v0[3]); w.z = cvt_pk_bf16(v1[0], v1[1]); w.w = cvt_pk_bf16(v1[2], v1[3]);
                    *(u32x4*)(PJ + bo[bj] + ai * SAe + m * SMe) = w; } }
    }
};
typedef EpiProjHT<false> EpiProjH;
__device__ __forceinline__ float silu_f(float x) { return x * __builtin_amdgcn_rcpf(1.0f + __builtin_amdgcn_exp2f(-1.4426950408889634f * x)); }
template <bool OUT8 = false, bool DQ = false> struct EpiSwigluT {
    static constexpr bool PERM = true, AFTER_DRAIN = false;
    bf16_t* O; int ldc; int pn_mod; float out_scale = 1.f; const float* sa = nullptr; const float* sb = nullptr;
    __device__ __forceinline__ void operator()(const f32x4 (&acc)[2][2][4][2], const Unit& u, int wr, int wc, int fr, int fq) const {
        const int pn = pn_mod ? (u.pn % pn_mod) : u.pn;
        const int row0 = u.pm * BM + wr * 64 + fr, col0 = pn * HALF + wc * 32 + 8 * fq;
        f32x4 sbv[2][2];
        if constexpr (DQ) {
#pragma unroll
            for (int bj = 0; bj < 2; ++bj)
#pragma unroll
                for (int n = 0; n < 2; ++n) sbv[bj][n] = *(const __attribute__((address_space(1))) f32x4*)(sb + (size_t)u.pn * BM + bj * HALF + wc * 32 + 8 * fq + 4 * n); }
        float sarv[2][4];
#pragma unroll
        for (int ai = 0; ai < 2; ++ai)
#pragma unroll
            for (int m = 0; m < 4; ++m) { sarv[ai][m] = 1.f; if constexpr (DQ) sarv[ai][m] = ((const __attribute__((address_space(1))) float*)sa)[row0 + ai * HALF + m * 16]; }
#pragma unroll
        for (int ai = 0; ai < 2; ++ai)
#pragma unroll
            for (int m = 0; m < 4; ++m) { bf16_t* rowp = O + (size_t)(row0 + ai * HALF + m * 16) * ldc + col0;
                if constexpr (DQ && OUT8) {
                    const float sar = sarv[ai][m], sau = sar * out_scale;
                    unsigned wq[2];
#pragma unroll
                    for (int n = 0; n < 2; ++n) {
                        const f32x4 t = dq4(acc[ai][0][m][n]) * (sbv[0][n] * sar), uu = dq4(acc[ai][1][m][n]) * (sbv[1][n] * sau);
                        const f32x4 x2 = t * (-1.4426950408889634f);
                        f32x4 e; e[0] = __builtin_amdgcn_exp2f(x2[0]); e[1] = __builtin_amdgcn_exp2f(x2[1]); e[2] = __builtin_amdgcn_exp2f(x2[2]); e[3] = __builtin_amdgcn_exp2f(x2[3]);
                        const f32x4 d = e + 1.0f;
                        f32x4 r; r[0] = __builtin_amdgcn_rcpf(d[0]); r[1] = __builtin_amdgcn_rcpf(d[1]); r[2] = __builtin_amdgcn_rcpf(d[2]); r[3] = __builtin_amdgcn_rcpf(d[3]);
                        const f32x4 hq = (t * r) * uu;
                        int w0 = __builtin_amdgcn_cvt_pk_fp8_f32(__builtin_amdgcn_fmed3f(hq[0], -448.f, 448.f), __builtin_amdgcn_fmed3f(hq[1], -448.f, 448.f), 0, false);
                        w0 = __builtin_amdgcn_cvt_pk_fp8_f32(__builtin_amdgcn_fmed3f(hq[2], -448.f, 448.f), __builtin_amdgcn_fmed3f(hq[3], -448.f, 448.f), w0, true);
                        wq[n] = (unsigned)w0; }
                    typedef unsigned u32x2_t __attribute__((ext_vector_type(2))); u32x2_t w8; w8.x = wq[0]; w8.y = wq[1];
                    *(u32x2_t*)((unsigned char*)O + (size_t)(row0 + ai * HALF + m * 16) * ldc + col0) = w8;
                    continue; }
                f32x4 g0, g1, u0, u1;
                if constexpr (DQ) { const float sar = sarv[ai][m];
                    g0 = dq4(acc[ai][0][m][0]) * sbv[0][0] * sar; g1 = dq4(acc[ai][0][m][1]) * sbv[0][1] * sar; u0 = dq4(acc[ai][1][m][0]) * sbv[1][0] * sar; u1 = dq4(acc[ai][1][m][1]) * sbv[1][1] * sar; }
                else { g0 = acc[ai][0][m][0]; g1 = acc[ai][0][m][1]; u0 = acc[ai][1][m][0]; u1 = acc[ai][1][m][1]; }
                float h[8];
#pragma unroll
                for (int i = 0; i < 4; ++i) { h[i] = silu_f(g0[i]) * u0[i]; h[4 + i] = silu_f(g1[i]) * u1[i]; }
                if constexpr (OUT8) { unsigned char* rp8 = (unsigned char*)O + (size_t)(row0 + ai * HALF + m * 16) * ldc + col0;
                    typedef unsigned u32x2_t __attribute__((ext_vector_type(2))); u32x2_t w8;
#pragma unroll
                    for (int i = 0; i < 8; ++i) h[i] = fminf(fmaxf(h[i] * out_scale, -448.f), 448.f);
                    int w0 = __builtin_amdgcn_cvt_pk_fp8_f32(h[0], h[1], 0, false); w0 = __builtin_amdgcn_cvt_pk_fp8_f32(h[2], h[3], w0, true);
                    int w1 = __builtin_amdgcn_cvt_pk_fp8_f32(h[4], h[5], 0, false); w1 = __builtin_amdgcn_cvt_pk_fp8_f32(h[6], h[7], w1, true);
                    w8.x = (unsigned)w0; w8.y = (unsigned)w1; *(u32x2_t*)rp8 = w8; }
                else { u32x4 w; w.x = cvt_pk_bf16(h[0], h[1]); w.y = cvt_pk_bf16(h[2], h[3]); w.z = cvt_pk_bf16(h[4], h[5]); w.w = cvt_pk_bf16(h[6], h[7]);
                    *(u32x4*)rowp = w; } }
    }
};
typedef EpiSwigluT<false, false> EpiSwiglu;
struct MoeOrder {
    int pt1, pt2, pt3, pt4, pt5, pt6, pt7, pt8; int NT, G, c, nwg;
    __device__ __forceinline__ void init(const unsigned* cnt, int NT_, int G_, int c_) {
        NT = NT_; G = G_; c = c_;
        pt1 = (int)((cnt[0] + 255u) >> 8); pt2 = pt1 + (int)((cnt[1] + 255u) >> 8); pt3 = pt2 + (int)((cnt[2] + 255u) >> 8); pt4 = pt3 + (int)((cnt[3] + 255u) >> 8);
        pt5 = pt4 + (int)((cnt[4] + 255u) >> 8); pt6 = pt5 + (int)((cnt[5] + 255u) >> 8); pt7 = pt6 + (int)((cnt[6] + 255u) >> 8); pt8 = pt7 + (int)((cnt[7] + 255u) >> 8);
        nwg = pt8 * NT;
    }
    __device__ __forceinline__ bool next(int i, Unit& u) const {
        const long L = (long)i * G + c; if (L >= nwg) return false;
        int wgid = (int)L; { const int q = nwg / NXCD, r = nwg % NXCD, xcd = wgid % NXCD, off = wgid / NXCD; wgid = (xcd < r ? xcd * (q + 1) : r * (q + 1) + (xcd - r) * q) + off; }
        int e = 0, lo = 0, hi = pt1;
        if (wgid >= pt1 * NT) { e = 1; lo = pt1; hi = pt2; }
        if (wgid >= pt2 * NT) { e = 2; lo = pt2; hi = pt3; }
        if (wgid >= pt3 * NT) { e = 3; lo = pt3; hi = pt4; }
        if (wgid >= pt4 * NT) { e = 4; lo = pt4; hi = pt5; }
        if (wgid >= pt5 * NT) { e = 5; lo = pt5; hi = pt6; }
        if (wgid >= pt6 * NT) { e = 6; lo = pt6; hi = pt7; }
        if (wgid >= pt7 * NT) { e = 7; lo = pt7; hi = pt8; }
        const int j = wgid - lo * NT, nM = hi - lo;
        const int nig = WGM * NT, gid = j / nig, fm = gid * WGM, gsz = (nM - fm) < WGM ? (nM - fm) : WGM;
        u.pm = lo + fm + ((j % nig) % gsz); u.pn = e * NT + (j % nig) / gsz; return true;
    }
    __device__ __forceinline__ void a_ready(const Unit&) const {}
    __device__ __forceinline__ void done(const Unit&) const {}
};
}
#include <hip/hip_bf16.h>
#include <cmath>
namespace attn_body {
using bf16=__hip_bfloat16;
using bf16x8=__attribute__((ext_vector_type(8)))short;
using s16x4=__attribute__((ext_vector_type(4)))short;
using f32x16=__attribute__((ext_vector_type(16)))float;
using u32x4=__attribute__((ext_vector_type(4)))unsigned;
constexpr int BATCH=4,SEQ=8192,D=64,DMQ=64,DMO=1024;
constexpr int NW=8,QBLK=32,QB=QBLK*NW,KVBLK=64,NQB=SEQ/QB;
constexpr int ATTN_UNIT_ROWS=QB;
__device__ __forceinline__ int crow(int r,int hi){return (r&3)+8*(r>>2)+4*hi;}
#define SBAR() __builtin_amdgcn_sched_barrier(0)
__device__ __forceinline__ void cmask(f32x16&p0,f32x16&p1,int jb,int qrel,int hi){
  const float NEG=-INFINITY; int kb=64*jb+4*hi;
  #pragma unroll
  for(int r=0;r<16;++r){int kv=kb+(r&3)+8*(r>>2); if(kv>qrel)p0[r]=NEG; if(kv+32>qrel)p1[r]=NEG;}
}

typedef const __attribute__((address_space(3))) float* lds_cfptr;
typedef float f32x4a __attribute__((ext_vector_type(4)));
__device__ __forceinline__ void bmask(f32x16&p0,f32x16&p1,int jb,int qrel,int hi,lds_cfptr tabR){
  int j0=383-(qrel-64*jb-4*hi); j0=j0>452?452:j0; const lds_cfptr tp=tabR+512*(j0&3)+(j0&~3);
  #pragma unroll
  for(int g=0;g<4;++g){ const f32x4a a=*(const __attribute__((address_space(3))) f32x4a*)(tp+8*g), b=*(const __attribute__((address_space(3))) f32x4a*)(tp+32+8*g);
    #pragma unroll
    for(int i=0;i<4;++i){ p0[4*g+i]+=a[i]; p1[4*g+i]+=b[i]; } }
  if(jb>=0)cmask(p0,p1,jb,qrel,hi);
}
constexpr int NSLOT=3, SLOTB=8192;
constexpr int VSLOTB=2*SLOTB;
constexpr int LDS_K=0, LDS_V=NSLOT*SLOTB, LDS_WS=LDS_V+NSLOT*VSLOTB, LDS_OST=LDS_WS+NW*64*4, LDS_BYTES=LDS_OST+NW*4096;
constexpr float C2=0.125f*1.4426950408889634f;
__device__ __forceinline__ void glds16(const void*gsrc,unsigned lds_dst){unsigned keep;
  asm volatile("s_mov_b32 %0, m0\n\ts_mov_b32 m0, %2\n\ts_nop 0\n\tglobal_load_lds_dwordx4 %1, off\n\ts_mov_b32 m0, %0":"=&s"(keep):"v"(gsrc),"s"(lds_dst):"memory");}
__device__ __forceinline__ float max3f(float a,float b,float c){float r;asm("v_max3_f32 %0, %1, %2, %3":"=v"(r):"v"(a),"v"(b),"v"(c));return r;}
__device__ __forceinline__ float max2f(float a,float b){float r;asm("v_max_f32_e32 %0, %1, %2":"=v"(r):"v"(a),"v"(b));return r;}
__device__ __forceinline__ float fadd_s(float a,float b){float r;asm("v_add_f32_e32 %0, %1, %2":"=v"(r):"v"(a),"v"(b));return r;}
__device__ __forceinline__ float fsub_s(float a,float b){float r;asm("v_sub_f32_e32 %0, %1, %2":"=v"(r):"v"(a),"v"(b));return r;}
typedef float f32x2_t __attribute__((ext_vector_type(2))); typedef __bf16 bf16x2_t __attribute__((ext_vector_type(2)));
__device__ __forceinline__ unsigned cvtpk_s(float lo,float hi){f32x2_t v={lo,hi};bf16x2_t b=__builtin_convertvector(v,bf16x2_t);return __builtin_bit_cast(unsigned,b);}
#define WAIT_BAR(N) asm volatile("s_waitcnt vmcnt(" #N ") lgkmcnt(0)\n\ts_barrier":::"memory")

__device__ __forceinline__ void qkt(f32x16&p0,f32x16&p1,const char*Kslot,const bf16x8*qr,const f32x16&negm,int r32,int hi){
  const char*kb=Kslot+hi*1024+r32*16;
  #pragma unroll
  for(int d0=0;d0<4;++d0){
    const bf16x8 b0=*reinterpret_cast<const bf16x8*>(kb+d0*2048);
    const bf16x8 b1=*reinterpret_cast<const bf16x8*>(kb+d0*2048+512);
    if(d0==0){p0=__builtin_amdgcn_mfma_f32_32x32x16_bf16(b0,qr[0],negm,0,0,0);p1=__builtin_amdgcn_mfma_f32_32x32x16_bf16(b1,qr[0],negm,0,0,0);}
    else{p0=__builtin_amdgcn_mfma_f32_32x32x16_bf16(b0,qr[d0],p0,0,0,0);p1=__builtin_amdgcn_mfma_f32_32x32x16_bf16(b1,qr[d0],p1,0,0,0);}}
}
typedef __attribute__((address_space(3))) const char* lds_cptr;
typedef short v4i16_t __attribute__((ext_vector_type(4)));
__device__ __forceinline__ void kload8(bf16x8*kf,lds_cptr kp){
  kf[0]=*(const __attribute__((address_space(3))) bf16x8*)(kp);      kf[1]=*(const __attribute__((address_space(3))) bf16x8*)(kp+512);
  kf[2]=*(const __attribute__((address_space(3))) bf16x8*)(kp+2048); kf[3]=*(const __attribute__((address_space(3))) bf16x8*)(kp+2560);
  kf[4]=*(const __attribute__((address_space(3))) bf16x8*)(kp+4096); kf[5]=*(const __attribute__((address_space(3))) bf16x8*)(kp+4608);
  kf[6]=*(const __attribute__((address_space(3))) bf16x8*)(kp+6144); kf[7]=*(const __attribute__((address_space(3))) bf16x8*)(kp+6656);
}
__device__ __forceinline__ void kload2(bf16x8*kf,lds_cptr kp,int j){ kf[2*j]=*(const __attribute__((address_space(3))) bf16x8*)(kp+j*2048); kf[2*j+1]=*(const __attribute__((address_space(3))) bf16x8*)(kp+j*2048+512); }
__device__ __forceinline__ s16x4 vtr(lds_cptr p){ return __builtin_bit_cast(s16x4,__builtin_amdgcn_ds_read_tr16_b64_v4i16((__attribute__((address_space(3))) v4i16_t*)p)); }
__device__ __forceinline__ float rowmax(const f32x16&p0,const f32x16&p1){
  float a=max3f(p0[0],p0[1],p1[0]),b=max3f(p0[2],p0[3],p1[1]);a=max3f(a,p1[2],p1[3]);
  #pragma unroll
  for(int r=4;r<16;r+=4){a=max3f(a,p0[r],p0[r+1]);b=max3f(b,p0[r+2],p0[r+3]);a=max3f(a,p1[r],p1[r+1]);b=max3f(b,p1[r+2],p1[r+3]);}
  const float m=max2f(a,b);
  auto rr=__builtin_amdgcn_permlane32_swap(__float_as_uint(m),__float_as_uint(m),false,false);
  return max2f(__uint_as_float(rr[0]),__uint_as_float(rr[1]));
}
__device__ __forceinline__ void pv(f32x16*o,int vb,bf16x8 pa0,bf16x8 pa1,bf16x8 pa2,bf16x8 pa3){
  #pragma unroll
  for(int d0=0;d0<4;++d0){s16x4 lo[4],hi[4];
    #pragma unroll
    for(int ks=0;ks<4;++ks){
      asm volatile("ds_read_b64_tr_b16 %0,%1 offset:%c2":"=&v"(lo[ks]):"v"(vb),"i"(d0*4096+ks*1024):"memory");
      asm volatile("ds_read_b64_tr_b16 %0,%1 offset:%c2":"=&v"(hi[ks]):"v"(vb),"i"(d0*4096+ks*1024+512):"memory");}
    asm volatile("s_waitcnt lgkmcnt(0)":::"memory");SBAR();
    #define PK(k) (bf16x8){lo[k][0],lo[k][1],lo[k][2],lo[k][3],hi[k][0],hi[k][1],hi[k][2],hi[k][3]}
    o[d0]=__builtin_amdgcn_mfma_f32_32x32x16_bf16(pa0,PK(0),o[d0],0,0,0);
    o[d0]=__builtin_amdgcn_mfma_f32_32x32x16_bf16(pa1,PK(1),o[d0],0,0,0);
    o[d0]=__builtin_amdgcn_mfma_f32_32x32x16_bf16(pa2,PK(2),o[d0],0,0,0);
    o[d0]=__builtin_amdgcn_mfma_f32_32x32x16_bf16(pa3,PK(3),o[d0],0,0,0);
    #undef PK
  }
}

#ifndef ATTN_STORE16
#define ATTN_STORE16(p,v) (*(u32x4*)(p)=(v))
#endif
template<int THRL> __device__ __forceinline__ void attn_unit(int b,const bf16*__restrict__ QHh  ,const bf16*__restrict__ KTh  ,const bf16*__restrict__ VTh  ,int ocol,int qb,bf16*O,char*shm,lds_cfptr tabR,const int tid_in,const bf16*nKT  ,const bf16*nVT,const bool pre  ){
  int tid_=tid_in; asm volatile("":"+v"(tid_)); const int tid=tid_,lane=tid&63,r32=lane&31,hi=lane>>5; const int wid=__builtin_amdgcn_readfirstlane(tid>>6);
  const long rowbase=(long)b*SEQ; const int q0=qb*QB;
  const bf16*Qw=QHh+(rowbase+q0+wid*QBLK)*DMQ;
  const bf16*Kh=KTh+(rowbase>>6)*4096,*Vh=VTh+(rowbase>>6)*8192;
  const unsigned lds0=(unsigned)(uintptr_t)shm;
  float*wsf=(float*)(shm+LDS_WS)+wid*64;
  const bf16*ksrc=Kh+wid*512+lane*8;
  const bf16*vsrc=Vh+wid*512+lane*8;
  const unsigned kdst=lds0+LDS_K+wid*1024, vdst=lds0+LDS_V+wid*1024;
  #define DMA_K(t,slot) glds16(ksrc+(long)(t)*4096,(unsigned)__builtin_amdgcn_readfirstlane(kdst+(slot)))
  #define DMA_V(t,slot) do{ glds16(vsrc+(long)(t)*8192,(unsigned)__builtin_amdgcn_readfirstlane(vdst+2*(slot))); glds16(vsrc+4096+(long)(t)*8192,(unsigned)__builtin_amdgcn_readfirstlane(vdst+2*(slot)+8192)); }while(0)
  const int vb0=(int)(lds0+LDS_V)+((lane>>4)&1)*32+(lane&3)*8+(4*hi+((lane&15)>>2))*64;
  const char*Kbase=shm+LDS_K; bf16x8 kf[8];
  const lds_cptr shm3=(lds_cptr)shm; const lds_cptr kp0=shm3+LDS_K+hi*1024+r32*16; const lds_cptr vp0=shm3+LDS_V+((lane>>4)&1)*32+(lane&3)*8+(4*hi+((lane&15)>>2))*64;
  const int NT=(q0+QB)/KVBLK;
  if(!pre){DMA_K(0,0);DMA_V(0,0);DMA_K(1,SLOTB);}
  bf16x8 qr[4];
  #pragma unroll
  for(int d0=0;d0<4;++d0)qr[d0]=*reinterpret_cast<const bf16x8*>(&Qw[(long)r32*DMQ+d0*16+hi*8]);
  float mhat=0.f,l_reg=0.f;f32x16 o[4];o[0]=f32x16{};o[1]=f32x16{};o[2]=f32x16{};o[3]=f32x16{};const f32x16 negm=f32x16{};
  const int qrel=wid*QBLK+r32;
  #define CMASK(P0,P1,t) do{int jb_=(t)-(NT-4); if(jb_>=-2)bmask(P0,P1,jb_,qrel,hi,tabR);}while(0)
  bool resc=false;
  #define START(P0,P1) do{ const float rm=rowmax(P0,P1); resc=false; \
    { const float dl=rm; mhat=fadd_s(mhat,dl); \
      _Pragma("unroll") for(int r=0;r<16;++r){P0[r]=fsub_s(P0[r],dl);P1[r]=fsub_s(P1[r],dl);} \
      } \
    _Pragma("unroll") for(int r=0;r<16;++r)P0[r]=__builtin_amdgcn_exp2f(P0[r]); }while(0)
  #define RESC() do{ if(resc){ asm volatile("s_waitcnt lgkmcnt(0)":::"memory"); \
      _Pragma("unroll") for(int d_=0;d_<4;++d_) _Pragma("unroll") for(int r=0;r<16;++r)o[d_][r]*=wsf[crow(r,hi)]; } }while(0)
  f32x16 pA0,pA1,pB0,pB1;
  int sl_prev=0,sl_cur=0,sl_next=SLOTB;
  #define ROT() do{sl_prev=sl_cur;sl_cur=sl_next;sl_next=(sl_next==(NSLOT-1)*SLOTB)?0:sl_next+SLOTB;}while(0)
  if(!pre)DMA_K(2,2*SLOTB);
  WAIT_BAR(4);
  qkt(pA0,pA1,Kbase,qr,negm,r32,hi);asm volatile("s_nop 15\n\ts_nop 7":"+v"(pA0),"+v"(pA1));CMASK(pA0,pA1,0);
  START(pA0,pA1);
  _Pragma("unroll") for(int r=0;r<16;++r)pA1[r]=__builtin_amdgcn_exp2f(pA1[r]);
  WAIT_BAR(0);
  DMA_K(3,0);DMA_V(1,SLOTB);
  ROT();
  kload8(kf,kp0+sl_cur);
  WAIT_BAR(3);
  s16x4 vlo[4],vhi[4]; u32x4 pw0,pw1,pw2,pw3;
  #define PKW(P,B) cvtpk_s(P[B],P[B+1])
  #define PAF(k) __builtin_bit_cast(bf16x8,pw##k)
  #define VFS(i) (bf16x8){vlo[i][0],vlo[i][1],vlo[i][2],vlo[i][3],vhi[i][0],vhi[i][1],vhi[i][2],vhi[i][3]}
  #define VRDF(st,f) do{ vlo[st]=vtr(vp_+(((f)>>2)*4096+((f)&3)*1024)); vhi[st]=vtr(vp_+(((f)>>2)*4096+((f)&3)*1024+512)); }while(0)
  #define PIN(x) asm volatile("":"+v"(x))
  #define MX3(a,b,c) __builtin_fmaxf(__builtin_fmaxf((a),(b)),(c))
  #define GAPA(MF,A0,A1,A2,A3,W0,W1,PW) do{ MF; sacc+=A0; sacc+=A1; sacc+=A2; sacc+=A3; PIN(sacc); W0; W1; PIN(PW); SBAR(); }while(0)
  #define EX(v) __builtin_amdgcn_exp2f(v)
  #define GAPB(MF,X,B) do{ MF; X[B]=EX(X[B]); X[B+1]=EX(X[B+1]); X[B+2]=EX(X[B+2]); X[B+3]=EX(X[B+3]); PIN(X); SBAR(); }while(0)
  #define VRD(i) do{ vlo[i]=vtr(vp_+(((i)>>2)*4096+((i)&3)*1024)); vhi[i]=vtr(vp_+(((i)>>2)*4096+((i)&3)*1024+512)); }while(0)
  #define VRD2(i) do{ vlo[i]=vtr(vp_+((((i)>>2)+2)*4096+((i)&3)*1024)); vhi[i]=vtr(vp_+((((i)>>2)+2)*4096+((i)&3)*1024+512)); }while(0)
  #define GAPB2(MF,X,B) do{ MF; X[B]=EX(X[B]-mhat); X[B+1]=EX(X[B+1]-mhat); PIN(X); SBAR(); }while(0)
  #define KRD(G,j) do{ if(G){ kload2(kf,kp0+sl_next,j); SBAR(); } }while(0)
  #define STEP(C0,C1,P0,P1,t,GK,GV,GL) do{ SBAR(); \
    const lds_cptr vp_=vp0+2*sl_prev; \
    float sacc=(P0[0]+P0[1]); \
    GAPA(C0=__builtin_amdgcn_mfma_f32_32x32x16_bf16(kf[0],qr[0],negm,0,0,0), P0[2],P0[3],P0[4],P0[5],     pw0[0]=PKW(P0,0), pw0[1]=PKW(P0,2), pw0); \
    GAPA(C1=__builtin_amdgcn_mfma_f32_32x32x16_bf16(kf[1],qr[0],negm,0,0,0), P0[6],P0[7],P0[8],P0[9],     pw0[2]=PKW(P0,4), pw0[3]=PKW(P0,6), pw0); \
    GAPA(C0=__builtin_amdgcn_mfma_f32_32x32x16_bf16(kf[2],qr[1],C0,0,0,0),   P0[10],P0[11],P0[12],P0[13], pw1[0]=PKW(P0,8), pw1[1]=PKW(P0,10), pw1); \
    GAPA(C1=__builtin_amdgcn_mfma_f32_32x32x16_bf16(kf[3],qr[1],C1,0,0,0),   P0[14],P0[15],P1[0],P1[1],   pw1[2]=PKW(P0,12),pw1[3]=PKW(P0,14), pw1); \
    VRDF(0,0); SBAR(); GAPA(C0=__builtin_amdgcn_mfma_f32_32x32x16_bf16(kf[4],qr[2],C0,0,0,0),   P1[2],P1[3],P1[4],P1[5],     pw2[0]=PKW(P1,0), pw2[1]=PKW(P1,2), pw2); \
    VRDF(1,4); SBAR(); GAPA(C1=__builtin_amdgcn_mfma_f32_32x32x16_bf16(kf[5],qr[2],C1,0,0,0),   P1[6],P1[7],P1[8],P1[9],     pw2[2]=PKW(P1,4), pw2[3]=PKW(P1,6), pw2); \
    VRDF(2,1); SBAR(); GAPA(C0=__builtin_amdgcn_mfma_f32_32x32x16_bf16(kf[6],qr[3],C0,0,0,0),   P1[10],P1[11],P1[12],P1[13], pw3[0]=PKW(P1,8), pw3[1]=PKW(P1,10), pw3); \
    VRDF(3,5); SBAR(); GAPA(C1=__builtin_amdgcn_mfma_f32_32x32x16_bf16(kf[7],qr[3],C1,0,0,0),   P1[14],P1[15],0.f,0.f,       pw3[2]=PKW(P1,12),pw3[3]=PKW(P1,14), pw3); \
    l_reg+=sacc; \
    if(GK){DMA_K((t)+3,sl_cur);} if(GV){DMA_V((t)+1,sl_next);} \
    CMASK(C0,C1,t); \
    { float a=MX3(C0[0],C0[1],C1[0]),b=MX3(C0[2],C0[3],C1[1]); a=MX3(a,C1[2],C1[3]); \
      _Pragma("unroll") for(int r=4;r<16;r+=4){a=MX3(a,C0[r],C0[r+1]);b=MX3(b,C0[r+2],C0[r+3]);a=MX3(a,C1[r],C1[r+1]);b=MX3(b,C1[r+2],C1[r+3]);} \
      float rm=__builtin_fmaxf(a,b); { auto rr=__builtin_amdgcn_permlane32_swap(__float_as_uint(rm),__float_as_uint(rm),false,false); rm=__builtin_fmaxf(__uint_as_float(rr[0]),__uint_as_float(rr[1])); } rm-=mhat;   \
      resc=false; \
      if(__builtin_expect(__any(rm>(float)THRL),0)){ const float dl=__builtin_fmaxf(rm,0.f); mhat+=dl; \
        const float f=__builtin_amdgcn_exp2f(-dl); l_reg*=f; if(hi==0)wsf[r32]=f; resc=true; } } \
    SBAR(); \
    GAPB2(o[0]=__builtin_amdgcn_mfma_f32_32x32x16_bf16(PAF(0),VFS(0),o[0],0,0,0), C0,0); VRDF(0,2); SBAR(); \
    GAPB2(o[1]=__builtin_amdgcn_mfma_f32_32x32x16_bf16(PAF(0),VFS(1),o[1],0,0,0), C0,2); VRDF(1,6); SBAR(); \
    GAPB2(o[0]=__builtin_amdgcn_mfma_f32_32x32x16_bf16(PAF(1),VFS(2),o[0],0,0,0), C0,4); VRDF(2,3); SBAR(); \
    GAPB2(o[1]=__builtin_amdgcn_mfma_f32_32x32x16_bf16(PAF(1),VFS(3),o[1],0,0,0), C0,6); VRDF(3,7); SBAR(); \
    GAPB2(o[0]=__builtin_amdgcn_mfma_f32_32x32x16_bf16(PAF(2),VFS(0),o[0],0,0,0), C0,8); VRDF(0,8); SBAR(); \
    GAPB2(o[1]=__builtin_amdgcn_mfma_f32_32x32x16_bf16(PAF(2),VFS(1),o[1],0,0,0), C0,10); VRDF(1,12); SBAR(); \
    GAPB2(o[0]=__builtin_amdgcn_mfma_f32_32x32x16_bf16(PAF(3),VFS(2),o[0],0,0,0), C0,12); VRDF(2,9); SBAR(); \
    GAPB2(o[1]=__builtin_amdgcn_mfma_f32_32x32x16_bf16(PAF(3),VFS(3),o[1],0,0,0), C0,14); VRDF(3,13); SBAR(); \
    GAPB2(o[2]=__builtin_amdgcn_mfma_f32_32x32x16_bf16(PAF(0),VFS(0),o[2],0,0,0), C1,0); VRDF(0,10); SBAR(); \
    GAPB2(o[3]=__builtin_amdgcn_mfma_f32_32x32x16_bf16(PAF(0),VFS(1),o[3],0,0,0), C1,2); VRDF(1,14); SBAR(); \
    GAPB2(o[2]=__builtin_amdgcn_mfma_f32_32x32x16_bf16(PAF(1),VFS(2),o[2],0,0,0), C1,4); VRDF(2,11); SBAR(); \
    GAPB2(o[3]=__builtin_amdgcn_mfma_f32_32x32x16_bf16(PAF(1),VFS(3),o[3],0,0,0), C1,6); VRDF(3,15); SBAR(); \
    KRD(GL,0); GAPB2(o[2]=__builtin_amdgcn_mfma_f32_32x32x16_bf16(PAF(2),VFS(0),o[2],0,0,0), C1,8); \
    KRD(GL,1); GAPB2(o[3]=__builtin_amdgcn_mfma_f32_32x32x16_bf16(PAF(2),VFS(1),o[3],0,0,0), C1,10); \
    KRD(GL,2); GAPB2(o[2]=__builtin_amdgcn_mfma_f32_32x32x16_bf16(PAF(3),VFS(2),o[2],0,0,0), C1,12); \
    KRD(GL,3); GAPB2(o[3]=__builtin_amdgcn_mfma_f32_32x32x16_bf16(PAF(3),VFS(3),o[3],0,0,0), C1,14); \
    }while(0)
  int t=1;
  #undef CMASK
  #define CMASK(P0,P1,t) do{}while(0)
  for(;t+7<NT;t+=2){
    STEP(pB0,pB1,pA0,pA1,t,true,true,true);     WAIT_BAR(3); RESC(); ROT();
    STEP(pA0,pA1,pB0,pB1,t+1,true,true,true);   WAIT_BAR(3); RESC(); ROT();
  }
  #undef CMASK
  #define CMASK(P0,P1,t) do{int jb_=(t)-(NT-4); if(jb_>=-2)bmask(P0,P1,jb_,qrel,hi,tabR);}while(0)
  #define ENDW(tt) do{ if((tt)+3<NT){WAIT_BAR(3);} else if((tt)+2<NT){WAIT_BAR(2);} else {WAIT_BAR(0);} }while(0)
  for(;t+1<NT;t+=2){
    STEP(pB0,pB1,pA0,pA1,t,(t+3<NT),(t+1<NT),(t+1<NT));       ENDW(t);   RESC(); ROT();
    STEP(pA0,pA1,pB0,pB1,t+1,(t+4<NT),(t+2<NT),(t+2<NT));     ENDW(t+1); RESC(); ROT();
  }
  STEP(pB0,pB1,pA0,pA1,NT-1,false,false,false); RESC();
  { float sacc=pB0[0]+pB0[1]; _Pragma("unroll") for(int r=2;r<16;++r)sacc+=pB0[r]; _Pragma("unroll") for(int r=0;r<16;++r)sacc+=pB1[r]; l_reg+=sacc;
    pw0=(u32x4){PKW(pB0,0),PKW(pB0,2),PKW(pB0,4),PKW(pB0,6)};pw1=(u32x4){PKW(pB0,8),PKW(pB0,10),PKW(pB0,12),PKW(pB0,14)};pw2=(u32x4){PKW(pB1,0),PKW(pB1,2),PKW(pB1,4),PKW(pB1,6)};pw3=(u32x4){PKW(pB1,8),PKW(pB1,10),PKW(pB1,12),PKW(pB1,14)};
    SBAR(); pv(o,vb0+2*sl_cur,PAF(0),PAF(1),PAF(2),PAF(3)); }
  asm volatile("s_waitcnt lgkmcnt(0)\n\ts_barrier":::"memory");
  if(nKT){ const bf16*nk_=nKT+(rowbase>>6)*4096+wid*512+lane*8; const bf16*nv_=nVT+(rowbase>>6)*8192+wid*512+lane*8;
    glds16(nk_,(unsigned)__builtin_amdgcn_readfirstlane(kdst)); glds16(nv_,(unsigned)__builtin_amdgcn_readfirstlane(vdst)); glds16(nv_+4096,(unsigned)__builtin_amdgcn_readfirstlane(vdst+8192));
    glds16(nk_+4096,(unsigned)__builtin_amdgcn_readfirstlane(kdst+SLOTB)); glds16(nk_+2*4096,(unsigned)__builtin_amdgcn_readfirstlane(kdst+2*SLOTB)); }
  #undef PKW
  #undef PAF
  #undef VFS
  #undef VRDF
  #undef PIN
  #undef MX3
  #undef GAPA
  #undef GAPB
  #undef EX
  #undef VRD
  #undef VRD2
  #undef GAPB2
  #undef KRD
  #undef STEP
  #undef ENDW
  {auto rr=__builtin_amdgcn_permlane32_swap(__float_as_uint(l_reg),__float_as_uint(l_reg),false,false);l_reg=__uint_as_float(rr[0])+__uint_as_float(rr[1]);}
  if(hi==0)wsf[32+r32]=l_reg;asm volatile("s_waitcnt lgkmcnt(0)":::"memory");
  float rli[16];
  { const lds_cfptr wl_=(lds_cfptr)(shm3+LDS_WS)+wid*64+32+4*hi;
    #pragma unroll
    for(int g=0;g<4;++g){ const f32x4a v_=*(const __attribute__((address_space(3))) f32x4a*)(wl_+8*g);
      #pragma unroll
      for(int i=0;i<4;++i)rli[4*g+i]=__builtin_amdgcn_rcpf(v_[i]); } }
  bf16*Ow=O+(rowbase+q0+wid*QBLK)*DMO+ocol;
  { bf16*stg=(bf16*)(shm+LDS_OST)+wid*2048;
    #pragma unroll
    for(int hf=0;hf<2;++hf){
      #pragma unroll
      for(int r=0;r<16;++r){const int orow=crow(r,hi);
        #pragma unroll
        for(int d0=0;d0<2;++d0)stg[orow*64+d0*32+r32]=__float2bfloat16(o[2*hf+d0][r]*rli[r]);}
      asm volatile("s_waitcnt lgkmcnt(0)":::"memory");
      #pragma unroll
      for(int i=0;i<4;++i){const int row=i*8+(lane>>3),ch=lane&7; const u32x4 v=*(const u32x4*)(stg+row*64+ch*8); ATTN_STORE16(Ow+(long)row*DMO+hf*64+ch*8,v);}
      asm volatile("s_waitcnt lgkmcnt(0)":::"memory"); } }
  asm volatile("s_waitcnt lgkmcnt(0)":::"memory");
  #undef DMA_K
  #undef DMA_V
  #undef CMASK
  #undef START
  #undef RESC
  #undef ROT
}
constexpr int ATTN_LDS_BYTES=LDS_BYTES;
#undef SBAR
#undef WAIT_BAR
}
#define GAS __attribute__((address_space(1)))
#define LAS __attribute__((address_space(3)))
typedef unsigned short bf16;
typedef unsigned v4u __attribute__((ext_vector_type(4)));
typedef float f32x4 __attribute__((ext_vector_type(4)));
typedef short bf16x8 __attribute__((ext_vector_type(8)));
typedef GAS unsigned gu32;
typedef GAS unsigned long long gu64;
#define RLX_AGENT __ATOMIC_RELAXED, __HIP_MEMORY_SCOPE_AGENT
#define LDS_WAIT() asm volatile("s_waitcnt lgkmcnt(0)" ::: "memory")
#define VM_WAIT() asm volatile("s_waitcnt vmcnt(0)" ::: "memory")
__device__ __forceinline__ unsigned long long rt() { return __builtin_amdgcn_s_memrealtime(); }
__device__ __forceinline__ unsigned f2bf(float f) { unsigned u = __builtin_bit_cast(unsigned, f); return (u + 0x7fffu + ((u >> 16) & 1u)) >> 16; }
typedef float pk_f32x2_t __attribute__((ext_vector_type(2))); typedef __bf16 pk_bf16x2_t __attribute__((ext_vector_type(2)));
__device__ __forceinline__ unsigned pk2(float lo, float hi) { pk_f32x2_t v = {lo, hi}; pk_bf16x2_t b = __builtin_convertvector(v, pk_bf16x2_t); return __builtin_bit_cast(unsigned, b); }

#define XB_TMO      128
#define XB_XCNT(j)  (256  + 64 * (j))
#define XB_XSUB(j)  (1280 + 64 * (j))
#define XB_XGEN(j)  (2304 + 64 * (j))
#define XB_TOP      3328
#define XB_TOPGEN   3392
#define XCD_BAR_WORDS 3456
#define XB_SPIN_CAP (1u << 18)

__device__ __forceinline__ unsigned xb_ld(unsigned* p)              { return __hip_atomic_load(p, __ATOMIC_RELAXED, __HIP_MEMORY_SCOPE_AGENT); }
__device__ __forceinline__ unsigned xb_add(unsigned* p, unsigned v) { return __hip_atomic_fetch_add(p, v, __ATOMIC_RELAXED, __HIP_MEMORY_SCOPE_AGENT); }
__device__ __forceinline__ unsigned xb_xcc_id() { return (unsigned)__builtin_amdgcn_s_getreg((3 << 11) | 20) & 0xFu; }
#define XB_SPIN(cond, bar) do { unsigned _sp = 0; while (cond) { __builtin_amdgcn_s_sleep(1); \
    if ((++_sp & 255u) == 0u) { if (xb_ld(&(bar)[XB_TMO])) break; if (_sp > XB_SPIN_CAP) { atomicAdd(&(bar)[XB_TMO], 1u); break; } } } } while (0)

struct XcdBarrier {
    unsigned* bar; unsigned x;
    volatile LAS unsigned* st;
};

__device__ __forceinline__ XcdBarrier xcd_barrier_post(unsigned* bar, volatile LAS unsigned* st, const int tid) {
    XcdBarrier b; b.bar = bar; b.x = xb_xcc_id(); b.st = st;
    if (tid == 0) (void)xb_add(&bar[XB_XCNT(b.x)], 1u);
    return b;
}
__device__ __forceinline__ void xcd_barrier_complete(unsigned* bar, unsigned x, unsigned& nloc, unsigned& nx) {
    const unsigned G = gridDim.x * gridDim.y * gridDim.z;
    unsigned sum, cnt, mine, sp = 0u;
    for (;;) {
        sum = 0u; cnt = 0u; mine = 0u;
#pragma unroll
        for (unsigned j = 0; j < 16; ++j) { const unsigned c = xb_ld(&bar[XB_XCNT(j)]); sum += c; cnt += (c > 0u) ? 1u : 0u; mine = (j == x) ? c : mine; }
        if (sum == G) break;
        __builtin_amdgcn_s_sleep(1);
        if ((++sp & 255u) == 0u) { if (xb_ld(&bar[XB_TMO])) break; if (sp > XB_SPIN_CAP) { atomicAdd(&bar[XB_TMO], 1u); break; } }
    }
    nloc = mine > 0u ? mine : 1u; nx = cnt > 0u ? cnt : 1u;
}

__device__ __forceinline__ void xcd_barrier(const XcdBarrier& b, const int tid) {
    asm volatile("s_waitcnt vmcnt(0)" ::: "memory");
    __syncthreads();
    if (tid == 0) {
        unsigned* bar = b.bar;
        __builtin_amdgcn_s_waitcnt(0);
        unsigned nloc = b.st[0], nx = b.st[1];
        if (nloc == 0u) { xcd_barrier_complete(bar, b.x, nloc, nx); b.st[0] = nloc; b.st[1] = nx; }
        const unsigned old = xb_add(&bar[XB_XSUB(b.x)], 1u);
        const unsigned gen = old / nloc;
        if (old + 1u == (gen + 1u) * nloc) {
            __builtin_amdgcn_fence(__ATOMIC_RELEASE, "agent");
            asm volatile("s_waitcnt vmcnt(0)" ::: "memory");
            const unsigned og = xb_add(&bar[XB_TOP], 1u);
            const unsigned tg = og / nx;
            if (og + 1u == (tg + 1u) * nx) xb_add(&bar[XB_TOPGEN], 1u);
            else XB_SPIN(xb_ld(&bar[XB_TOPGEN]) == tg, bar);
            __builtin_amdgcn_fence(__ATOMIC_ACQUIRE, "agent");
            xb_add(&bar[XB_XGEN(b.x)], 1u);
            asm volatile("s_waitcnt vmcnt(0)" ::: "memory");
        } else {
            XB_SPIN(xb_ld(&bar[XB_XGEN(b.x)]) == gen, bar);
            __builtin_amdgcn_fence(__ATOMIC_ACQUIRE, "agent");
            asm volatile("s_waitcnt vmcnt(0)" ::: "memory");
        }
    }
    __syncthreads();
}
constexpr int NWAVES = 8;
#ifndef MK_ONE_LAUNCH
#define MK_ONE_LAUNCH 1
#endif
constexpr int NB = 4, SEQ = 8192, DM = 1024, M = NB * SEQ, DEPTH = 4;
constexpr int NPROJ = 3584, INW = 3592, DFF = 3584, NUP = 2 * DFF, NEXP = 8;
constexpr int PJ_AQ = 0, PJ_AK = 512, PJ_AV = 1024, PJ_MQ = 1536, PJ_MK = 2048, PJ_MV = 2560, PJ_MO = 3072;
constexpr float EPS = 1e-6f;
constexpr size_t PJB = (size_t)NB * SEQ * 512;
constexpr int MPAD = 2 * M + NEXP * 256;
constexpr int NCH = SEQ / 64;
constexpr int NPH = 10;
constexpr int PH_TOTAL = 2 + DEPTH * NPH;

constexpr size_t MiB = 1u << 20;
constexpr size_t WS_CTL = 0, CTL_ZERO_BYTES = 1 * MiB;
constexpr size_t WS_MOD = 1 * MiB;
constexpr size_t WS_GATE = 2 * MiB;
constexpr size_t WS_BL = 3 * MiB;
constexpr size_t WS_UN = 4 * MiB;
constexpr size_t WS_NP = 5 * MiB;
constexpr size_t WS_TOK = 6 * MiB;
constexpr size_t WS_ROWIDX = 7 * MiB;
constexpr size_t WS_SA = 8 * MiB;
constexpr size_t WS_SB = 9 * MiB;
constexpr size_t WS_WIN = 16 * MiB;
constexpr size_t WS_WOUT = 44 * MiB;
constexpr size_t WS_WUP = 52 * MiB;
constexpr size_t WS_WDN = 80 * MiB;
constexpr size_t WS_WMUP = 94 * MiB;
constexpr size_t WS_WMDN = 206 * MiB;
constexpr size_t WS_H = 262 * MiB;
constexpr size_t WS_Y = 326 * MiB;
constexpr size_t WS_R = 458 * MiB;
constexpr size_t WS_X16 = 920 * MiB;
constexpr size_t WS_END = 984 * MiB;
static_assert(WS_Y + (size_t)MPAD * 1024 * 2 <= WS_R && WS_R + (size_t)MPAD * 3584 * 2 <= WS_END, "d_ws map");
constexpr int CW_TMO = 0, CW_CODE = 1, CW_BAR = 4096, CW_MOECNT = 8192;

constexpr int RING_OFF = 0, RING_BYTES = 131072;
constexpr int LDSCTL_OFF = RING_BYTES, MISC_OFF = LDSCTL_OFF + 320;
constexpr int BIAS_OFF = 132096;
constexpr int LDS_BYTES = 163840;
static_assert(MISC_OFF + 128 <= BIAS_OFF && BIAS_OFF + 8192 <= LDS_BYTES, "LDS map");

__device__ const int T5_BUCKET[128] = {0, 1, 2, 3, 4, 5, 6, 7, 8, 9, 10, 11, 12, 13, 14, 15, 16, 16, 16, 17, 17, 18, 18, 18, 19, 19, 19, 20, 20, 20, 20, 21, 21, 21, 21, 22, 22, 22, 22, 22, 23, 23, 23, 23, 23, 23, 24, 24, 24, 24, 24, 24, 25, 25, 25, 25, 25, 25, 25, 26, 26, 26, 26, 26, 26, 26, 26, 27, 27, 27, 27, 27, 27, 27, 27, 27, 27, 28, 28, 28, 28, 28, 28, 28, 28, 28, 28, 29, 29, 29, 29, 29, 29, 29, 29, 29, 29, 29, 29, 30, 30, 30, 30, 30, 30, 30, 30, 30, 30, 30, 30, 30, 30, 31, 31, 31, 31, 31, 31, 31, 31, 31, 31, 31, 31, 31, 31, 31};

typedef unsigned v2u __attribute__((ext_vector_type(2)));
typedef float v2f __attribute__((ext_vector_type(2)));
#ifndef PROBE_TIMER
#define PROBE_TIMER 0
#endif
#ifndef PROBE_SEL_A
#define PROBE_SEL_A 0
#endif
#ifndef PROBE_SEL_D
#define PROBE_SEL_D 0
#endif
#ifndef PROBE_US_PER_UNIT
#define PROBE_US_PER_UNIT 25.0f
#endif
constexpr float W8D_SCALE = 32.0f, H8_SCALE = 2.0f; constexpr int W8D_EXP = 127 - 3;
#ifndef PH_MASK
#define PH_MASK 0xFFFFFFu
#endif
#define PHM(b) ((PH_MASK >> (b)) & 1u)
struct Frame {
    LAS unsigned char* lds;
    volatile LAS unsigned* MISC;
    gu32* ctl;
    int tid, lane, wave, wave0, vcu, bx, G;
    unsigned char* ws;
    const __attribute__((address_space(4))) void* karg;
    float* out;
    __device__ __forceinline__ const float* in(int i) const { return (const float*)(const GAS float*)(((const float* const __attribute__((address_space(4)))*)karg)[i]); }
};
#define PHASE_BEGIN() do { unsigned o_ = ~0u; asm volatile("" : "+s"(o_)); int t_ = (int)__builtin_amdgcn_mbcnt_hi(o_, __builtin_amdgcn_mbcnt_lo(o_, 0u)) + 64 * F.wave0; asm volatile("" : "+v"(t_));   \
    F.tid = t_; F.lane = t_ & 63; F.wave = __builtin_amdgcn_readfirstlane(t_ >> 6); ws_ = (GAS unsigned char*)args.ws; asm volatile("" : "+s"(ws_)); F.ws = (unsigned char*)ws_; F.ctl = (gu32*)(ws_ + WS_CTL); \
    int b_ = blockIdx.x; asm volatile("" : "+s"(b_)); F.bx = b_; F.vcu = (F.G % 8 == 0) ? (b_ % 8) * (F.G / 8) + b_ / 8 : b_; \
    const __attribute__((address_space(4))) void* k_ = (const __attribute__((address_space(4))) void*)__builtin_amdgcn_kernarg_segment_ptr(); asm volatile("" : "+s"(k_)); F.karg = k_; } while (0)
__device__ __forceinline__ float lx_xor(float v, int o, int lane) { return __int_as_float(__builtin_amdgcn_ds_bpermute((lane ^ o) << 2, __float_as_int(v))); }
__device__ __forceinline__ float lx_up(float v, int o, int lane) { return __int_as_float(__builtin_amdgcn_ds_bpermute((lane - o) << 2, __float_as_int(v))); }
__device__ __forceinline__ float lx_get(float v, int src  ) { return __int_as_float(__builtin_amdgcn_readlane(__float_as_int(v), src)); }
__device__ __forceinline__ float wave_sum(float v, int lane) {
#pragma unroll
    for (int o = 1; o < 64; o <<= 1) v += lx_xor(v, o, lane);
    return v;
}
__device__ __forceinline__ float wave_sum_dpp(float v) {
    v += __int_as_float(__builtin_amdgcn_update_dpp(0, __float_as_int(v), 0xB1, 0xF, 0xF, true));
    v += __int_as_float(__builtin_amdgcn_update_dpp(0, __float_as_int(v), 0x4E, 0xF, 0xF, true));
    v += __int_as_float(__builtin_amdgcn_update_dpp(0, __float_as_int(v), 0x141, 0xF, 0xF, true));
    v += __int_as_float(__builtin_amdgcn_update_dpp(0, __float_as_int(v), 0x140, 0xF, 0xF, true));
    v += __int_as_float(__builtin_amdgcn_update_dpp(0, __float_as_int(v), 0x142, 0xA, 0xF, false));
    v += __int_as_float(__builtin_amdgcn_update_dpp(0, __float_as_int(v), 0x143, 0xC, 0xF, false));
    return __int_as_float(__builtin_amdgcn_readlane(__float_as_int(v), 63));
}
__device__ __forceinline__ float wave_max_dpp(float v) {
    v = fmaxf(v, __int_as_float(__builtin_amdgcn_update_dpp(0, __float_as_int(v), 0xB1, 0xF, 0xF, true)));
    v = fmaxf(v, __int_as_float(__builtin_amdgcn_update_dpp(0, __float_as_int(v), 0x4E, 0xF, 0xF, true)));
    v = fmaxf(v, __int_as_float(__builtin_amdgcn_update_dpp(0, __float_as_int(v), 0x141, 0xF, 0xF, true)));
    v = fmaxf(v, __int_as_float(__builtin_amdgcn_update_dpp(0, __float_as_int(v), 0x140, 0xF, 0xF, true)));
    v = fmaxf(v, __int_as_float(__builtin_amdgcn_update_dpp(0, __float_as_int(v), 0x142, 0xA, 0xF, false)));
    v = fmaxf(v, __int_as_float(__builtin_amdgcn_update_dpp(0, __float_as_int(v), 0x143, 0xC, 0xF, false)));
    return __int_as_float(__builtin_amdgcn_readlane(__float_as_int(v), 63));
}
#define DPPF(old_, v_, ctrl_, rm_, bc_) __int_as_float(__builtin_amdgcn_update_dpp((old_), __float_as_int(v_), (ctrl_), (rm_), 0xF, (bc_)))
__device__ __forceinline__ float wave_max_dpp_any(float v) {
    const int NI = (int)0xff800000;
    v = fmaxf(v, DPPF(NI, v, 0xB1, 0xF, false)); v = fmaxf(v, DPPF(NI, v, 0x4E, 0xF, false)); v = fmaxf(v, DPPF(NI, v, 0x141, 0xF, false)); v = fmaxf(v, DPPF(NI, v, 0x140, 0xF, false));
    v = fmaxf(v, DPPF(NI, v, 0x142, 0xA, false)); v = fmaxf(v, DPPF(NI, v, 0x143, 0xC, false));
    return __int_as_float(__builtin_amdgcn_readlane(__float_as_int(v), 63));
}
__device__ __forceinline__ float wave_scan_sum_dpp(float v) {
    v += DPPF(0, v, 0x111, 0xF, true); v += DPPF(0, v, 0x112, 0xF, true); v += DPPF(0, v, 0x114, 0xF, true); v += DPPF(0, v, 0x118, 0xF, true);
    v += DPPF(0, v, 0x142, 0xA, false); v += DPPF(0, v, 0x143, 0xC, false);
    return v;
}
__device__ __forceinline__ float wave_scan_max_dpp(float v) {
    const int NI = (int)0xff800000;
    v = fmaxf(v, DPPF(NI, v, 0x111, 0xF, false)); v = fmaxf(v, DPPF(NI, v, 0x112, 0xF, false)); v = fmaxf(v, DPPF(NI, v, 0x114, 0xF, false)); v = fmaxf(v, DPPF(NI, v, 0x118, 0xF, false));
    v = fmaxf(v, DPPF(NI, v, 0x142, 0xA, false)); v = fmaxf(v, DPPF(NI, v, 0x143, 0xC, false));
    return v;
}
__device__ __forceinline__ float sum8_dpp(float v) { v += DPPF(0, v, 0xB1, 0xF, true); v += DPPF(0, v, 0x4E, 0xF, true); v += DPPF(0, v, 0x141, 0xF, true); return v; }
__device__ __forceinline__ float sum16_dpp(float v) { v += DPPF(0, v, 0xB1, 0xF, true); v += DPPF(0, v, 0x4E, 0xF, true); v += DPPF(0, v, 0x141, 0xF, true); v += DPPF(0, v, 0x140, 0xF, true); return v; }
__device__ __forceinline__ float sum_halves(float v) { auto r_ = __builtin_amdgcn_permlane32_swap(__float_as_uint(v), __float_as_uint(v), false, false); return __uint_as_float(r_[0]) + __uint_as_float(r_[1]); }
__device__ __forceinline__ unsigned pk4_i8(float a, float b, float c, float d) {
    const float MG = 12582912.0f;
    const unsigned ua = __float_as_uint(a + MG), ub = __float_as_uint(b + MG), uc = __float_as_uint(c + MG), ud = __float_as_uint(d + MG);
    return __builtin_amdgcn_perm(ub, ua, 0x0c0c0400u) | __builtin_amdgcn_perm(ud, uc, 0x04000c0cu);
}
__device__ __forceinline__ float wave_max(float v, int lane) {
#pragma unroll
    for (int o = 1; o < 64; o <<= 1) v = fmaxf(v, lx_xor(v, o, lane));
    return v;
}
__device__ __forceinline__ float bf2f(unsigned short b) { return __uint_as_float((unsigned)b << 16); }
__device__ __forceinline__ float bflo(unsigned w) { return __uint_as_float(w << 16); }
__device__ __forceinline__ float bfhi(unsigned w) { return __uint_as_float(w & 0xffff0000u); }

__device__ __forceinline__ void p_ada(Frame& F) {
    LAS float* cact = (LAS float*)(F.lds);
    LAS float* red = (LAS float*)(F.lds + 16384);
    for (int i = F.tid; i < NB * DM; i += NWAVES * 64) { const float v = F.in(1)[i]; cact[i] = v / (1.0f + __expf(-v)); }
    __syncthreads();
    float* mod = (float*)(F.ws + WS_MOD);
    for (int item = F.bx; item < DEPTH * 48; item += F.G) {
        const int l = item / 48, col0 = (item % 48) * 128, q = F.tid & 31, kg = F.tid >> 5;
        const float* w = F.in(3) + ((size_t)l * DM + kg * 64) * (6 * DM) + col0 + 4 * q;
        f32x4 acc[4];
#pragma unroll
        for (int b = 0; b < 4; ++b) acc[b] = (f32x4){0.f, 0.f, 0.f, 0.f};
#pragma unroll 8
        for (int k = 0; k < 64; ++k) { const f32x4 wv = *(const GAS f32x4*)(w + (size_t)k * (6 * DM));
#pragma unroll
            for (int b = 0; b < 4; ++b) acc[b] += cact[b * DM + kg * 64 + k] * wv; }
#pragma unroll
        for (int b = 0; b < 4; ++b) *(LAS f32x4*)&red[(kg * 4 + b) * 128 + 4 * q] = acc[b];
        __syncthreads();
        { const int b = F.tid >> 7, ci = F.tid & 127; float s = 0.f;
#pragma unroll
          for (int g = 0; g < 16; ++g) s += red[(g * 4 + b) * 128 + ci];
          mod[(size_t)(l * NB + b) * (6 * DM) + col0 + ci] = s + F.in(4)[l * (6 * DM) + col0 + ci]; }
        __syncthreads();
    }
}
__device__ __forceinline__ void tr_item(const float* W, int ldw, int N, int K, bf16* WT, int rstride, int roff, LAS float* scr, int item, int lane) {
    const int nblk = N / 32, kb = item / nblk, nb = item % nblk, k0 = 64 * kb, n0 = 32 * nb;
    float wv[32];
#pragma unroll
    for (int i = 0; i < 32; ++i) wv[i] = W[(size_t)(k0 + 2 * i + (lane >> 5)) * ldw + n0 + (lane & 31)];
#pragma unroll
    for (int i = 0; i < 32; ++i) scr[(2 * i + (lane >> 5)) * 33 + (lane & 31)] = wv[i];
    LDS_WAIT(); asm volatile("" ::: "memory");
    const int c = lane & 7;
#pragma unroll
    for (int j = 0; j < 4; ++j) { const int n = (lane >> 3) + 8 * j; const LAS float* s = scr + (8 * c) * 33 + n;
        v4u o; o.x = pk2(s[0 * 33], s[1 * 33]); o.y = pk2(s[2 * 33], s[3 * 33]); o.z = pk2(s[4 * 33], s[5 * 33]); o.w = pk2(s[6 * 33], s[7 * 33]);
        const int nn = n0 + n, orow = (nn >> 7) * rstride + roff + (nn & 127);
        *(GAS v4u*)(WT + (size_t)orow * K + k0 + 8 * c) = o; }
    LDS_WAIT(); asm volatile("" ::: "memory");
}
__device__ __forceinline__ unsigned pk4_fp8(float a, float b, float c, float d) {
    a = fminf(fmaxf(a, -448.f), 448.f); b = fminf(fmaxf(b, -448.f), 448.f); c = fminf(fmaxf(c, -448.f), 448.f); d = fminf(fmaxf(d, -448.f), 448.f);
    int w = __builtin_amdgcn_cvt_pk_fp8_f32(a, b, 0, false); w = __builtin_amdgcn_cvt_pk_fp8_f32(c, d, w, true); return (unsigned)w;
}
__device__ __forceinline__ void tr_item_fp8(const float* W, int ldw, int N, int K, unsigned char* WT, int rstride, int roff, LAS float* scr, int item, int lane, float sc) {
    const int nblk = N / 32, kb = item / nblk, nb = item % nblk, k0 = 64 * kb, n0 = 32 * nb;
    float wv[32];
#pragma unroll
    for (int i = 0; i < 32; ++i) wv[i] = W[(size_t)(k0 + 2 * i + (lane >> 5)) * ldw + n0 + (lane & 31)];
#pragma unroll
    for (int i = 0; i < 32; ++i) scr[(2 * i + (lane >> 5)) * 33 + (lane & 31)] = wv[i];
    LDS_WAIT(); asm volatile("" ::: "memory");
    const int n = lane & 31, half = lane >> 5; const LAS float* s = scr + (32 * half) * 33 + n;
    const int nn = n0 + n, orow = (nn >> 7) * rstride + roff + (nn & 127);
#pragma unroll
    for (int q = 0; q < 2; ++q) { v4u o;
        o.x = pk4_fp8(s[(16 * q + 0) * 33] * sc, s[(16 * q + 1) * 33] * sc, s[(16 * q + 2) * 33] * sc, s[(16 * q + 3) * 33] * sc);
        o.y = pk4_fp8(s[(16 * q + 4) * 33] * sc, s[(16 * q + 5) * 33] * sc, s[(16 * q + 6) * 33] * sc, s[(16 * q + 7) * 33] * sc);
        o.z = pk4_fp8(s[(16 * q + 8) * 33] * sc, s[(16 * q + 9) * 33] * sc, s[(16 * q + 10) * 33] * sc, s[(16 * q + 11) * 33] * sc);
        o.w = pk4_fp8(s[(16 * q + 12) * 33] * sc, s[(16 * q + 13) * 33] * sc, s[(16 * q + 14) * 33] * sc, s[(16 * q + 15) * 33] * sc);
        *(GAS v4u*)(WT + (size_t)orow * K + k0 + 32 * half + 16 * q) = o; }
    LDS_WAIT(); asm volatile("" ::: "memory");
}
__device__ __forceinline__ void q8_item(Frame& F, const float* W, int ldw, unsigned char* WT, float* SB, int orow0, int n0, const LAS float* KM = nullptr  ) {
    LAS float* T = (LAS float*)(F.lds); LAS float* PM = (LAS float*)(F.lds + 145920);
    const int n = F.tid & 31, t = F.tid >> 5;
    float mx = 0.f;
#pragma unroll 1
    for (int i0 = 0; i0 < 64; i0 += 32) { float wv[32];
#pragma unroll
        for (int i = 0; i < 32; ++i) wv[i] = ((const GAS float*)W)[(size_t)(t + 16 * (i0 + i)) * ldw + n0 + n];
#pragma unroll
        for (int i = 0; i < 32; ++i) { const int k = t + 16 * (i0 + i); const float v = KM ? wv[i] * KM[k] : wv[i]; T[k * 32 + (n ^ (k & 31))] = v; mx = fmaxf(mx, fabsf(v)); } }
    PM[t * 32 + n] = mx;
    __syncthreads();
    float cm = 0.f;
#pragma unroll
    for (int g = 0; g < 16; ++g) cm = fmaxf(cm, PM[g * 32 + n]);
    const float inv = cm > 0.f ? 127.0f / cm : 0.f;
    unsigned char* dst = WT + (size_t)(orow0 + n) * 1024 + 64 * t;
#pragma unroll
    for (int q = 0; q < 4; ++q) { v4u o; unsigned w_[4];
#pragma unroll
        for (int d = 0; d < 4; ++d) { const int k = 64 * t + 16 * q + 4 * d;
            w_[d] = pk4_i8(T[k * 32 + (n ^ (k & 31))] * inv, T[(k + 1) * 32 + (n ^ ((k + 1) & 31))] * inv, T[(k + 2) * 32 + (n ^ ((k + 2) & 31))] * inv, T[(k + 3) * 32 + (n ^ ((k + 3) & 31))] * inv); }
        o.x = w_[0]; o.y = w_[1]; o.z = w_[2]; o.w = w_[3];
        *(GAS v4u*)(dst + 16 * q) = o; }
    if (t == 0) SB[orow0 + n] = cm * (1.0f / 127.0f);
    __syncthreads();
}
constexpr int TRI = 1792;
__device__ __forceinline__ void p_convert_dense(Frame& F) {
    {
        LAS float* scr = (LAS float*)(F.lds + RING_OFF + F.wave * 16384);
        const int gw = F.vcu * NWAVES + F.wave, NGW = F.G * NWAVES;
        constexpr int N1 = DEPTH * 512, N2 = 2 * TRI;
        for (int it = gw; it < N1 + N2; it += NGW) {
            if (it < N1) { }
            else { const int r0 = it - N1, j = r0 / TRI, rr = r0 % TRI; tr_item_fp8(F.in(16) + (size_t)j * DFF * DM, DM, DM, DFF, (unsigned char*)(F.ws + WS_WDN) + (size_t)j * DM * DFF, 128, 0, scr, rr, F.lane, W8D_SCALE); }
        }
    }
    __syncthreads();
    {   LAS float* KM = (LAS float*)(F.lds + 145920 + 2048); LAS float* BS = (LAS float*)(F.lds + 145920 + 2048 + 4096);
        for (int it = F.bx; it < DEPTH * 32; it += F.G) { const int l = it / 32, nb = it % 32;
            { const int blk = F.wave;
              const float li = 0.8f - 0.6f * expf(-0.3f * (float)l);
              const float g0 = (blk < 4) ? F.in(11)[(size_t)l * 128 + F.lane] * (1.0f - li) : F.in(12)[(size_t)l * 512 + (blk - 4) * 128 + F.lane];
              const float g1 = (blk < 4) ? F.in(11)[(size_t)l * 128 + 64 + F.lane] * (1.0f - li) : F.in(12)[(size_t)l * 512 + (blk - 4) * 128 + 64 + F.lane];
              const float bs = wave_max_dpp(fmaxf(fabsf(g0), fabsf(g1))) * (8.0f / 127.0f);
              if (F.lane == 0) { BS[blk] = bs; if (nb == 0) ((float*)(F.ws + WS_SB + 409600))[l * 8 + blk] = bs; } }
            __syncthreads();
            for (int k = F.tid; k < DM; k += NWAVES * 64) KM[k] = BS[k >> 7];
            __syncthreads();
            q8_item(F, F.in(13) + (size_t)l * DM * DM, DM, (unsigned char*)(F.ws + WS_WOUT) + (size_t)l * DM * DM, (float*)(F.ws + WS_SB + 393216) + l * DM, 32 * nb, 32 * nb, KM);
        }
    }
    for (int it = F.bx; it < DEPTH * 112 + 2 * 224; it += F.G) {
        if (it < DEPTH * 112) { const int l = it / 112, nb = it % 112;
            q8_item(F, F.in(6) + (size_t)l * DM * INW, INW, (unsigned char*)(F.ws + WS_WIN) + (size_t)l * NPROJ * DM, (float*)(F.ws + WS_SB) + l * NPROJ, 32 * nb, 32 * nb); }
        else { const int r = it - DEPTH * 112, j = r / 224, which = (r % 224) / 112, nb = r % 112, nn = 32 * nb;
            q8_item(F, (which ? F.in(15) : F.in(14)) + (size_t)j * DM * DFF, DFF, (unsigned char*)(F.ws + WS_WUP) + (size_t)j * NUP * DM, (float*)(F.ws + WS_SB + 65536) + j * NUP, (nn >> 7) * 256 + which * 128 + (nn & 127), nn); }
    }
}
__device__ __forceinline__ void p_convert_moe(Frame& F, int j) {
    {   LAS float* scr = (LAS float*)(F.lds + RING_OFF + 40960 + F.wave * 8448);
        const int gw = F.vcu * NWAVES + F.wave, NGW = F.G * NWAVES;
        for (int it = gw; it < NEXP * TRI; it += NGW) { const int e = it / TRI, rr = it % TRI; const size_t we = (size_t)(j * NEXP + e);
            tr_item_fp8(F.in(20) + we * DFF * DM, DM, DM, DFF, (unsigned char*)(F.ws + WS_WMDN) + (size_t)e * DM * DFF, 128, 0, scr, rr, F.lane, W8D_SCALE); } }
    __syncthreads();
    for (int it = F.bx; it < NEXP * 224; it += F.G) { const int e = it / 224, which = (it % 224) / 112, nb = it % 112, nn = 32 * nb; const size_t we = (size_t)(j * NEXP + e);
        q8_item(F, (which ? F.in(19) : F.in(18)) + we * DM * DFF, DFF, (unsigned char*)(F.ws + WS_WMUP) + (size_t)e * NUP * DM, (float*)(F.ws + WS_SB + 131072) + e * NUP, (nn >> 7) * 256 + which * 128 + (nn & 127), nn); }
}

__device__ __forceinline__ void row_phase(Frame& F, const int l, const int mode) {
    const bool has_res = mode != 0;
    const bool moe = (l & 1) != 0;
    const int ln = (mode == 2) ? l + 1 : l;
    const bool do_norm = (mode != 2) || (l + 1 < DEPTH);
    const bool do_gates = do_norm && (mode != 1);
    const bool do_router = (mode == 1) && moe;
    const bool y_moe = (mode == 2) && moe;
    const bool x_in_f32 = (mode == 0);
    const bool x_out_f32 = (mode == 2 && l == DEPTH - 1);
    const float* xsrc = F.in(0); bf16* X16 = (bf16*)(F.ws + WS_X16);
    const float* mod = (const float*)(F.ws + WS_MOD);
    LAS float* W8 = (LAS float*)(F.lds);
    LAS int* te = (LAS int*)(F.lds + 32768);
    LAS float* tg = (LAS float*)(F.lds + 32768 + 1024);
    LAS int* tl = (LAS int*)(F.lds + 32768 + 2048);
    LAS int* lcnt = (LAS int*)(F.lds + 32768 + 3072);
    float* gate = (float*)(F.ws + WS_GATE);
    bf16* H = (bf16*)(F.ws + WS_H);
    const bf16* Y = (const bf16*)(F.ws + WS_Y);
    const int mj = l >> 1;
    gu32* gcnt = F.ctl + CW_MOECNT + 64 * mj;
    int* tok_e = (int*)(F.ws + WS_TOK); int* tok_p = (int*)(F.ws + WS_TOK + 262144); float* tok_g = (float*)(F.ws + WS_TOK + 524288);
    int* rowidx = (int*)(F.ws + WS_ROWIDX);
    if (do_gates) { for (int i = F.tid; i < DM * 8; i += NWAVES * 64) W8[i] = F.in(6)[((size_t)ln * DM + (i >> 3)) * INW + NPROJ + (i & 7)]; }
    if (do_router) { for (int i = F.tid; i < DM * 8; i += NWAVES * 64) W8[i] = F.in(17)[(size_t)mj * DM * 8 + i]; }
    if (y_moe && F.tid == 0) { int pb = 0; for (int e = 0; e < NEXP; ++e) { lcnt[16 + e] = pb; pb += (int)((gcnt[e] + 255u) >> 8) * 256; } }
    __syncthreads();
    for (int item = F.bx; item < M / 128; item += F.G) {
        const int b = item / (SEQ / 128);
        if (do_router && F.tid < 8) lcnt[F.tid] = 0;
        float ms0 = 0.f, ms1 = 0.f, mg0 = 0.f, mg1 = 0.f;
        if (y_moe && F.lane < 16) { const size_t r_ = (size_t)item * 128 + F.wave * 16 + F.lane;
            ms0 = __int_as_float(lcnt[16 + tok_e[r_ * 2]] + tok_p[r_ * 2]); ms1 = __int_as_float(lcnt[16 + tok_e[r_ * 2 + 1]] + tok_p[r_ * 2 + 1]); mg0 = tok_g[r_ * 2]; mg1 = tok_g[r_ * 2 + 1]; }
        struct RowSet { f32x4 fx[4]; v2u bx[4], y0[4], y1[4]; float g0, g1; };
#define ROW_LOAD(ii, S) do { const size_t r_ = (size_t)item * 128 + F.wave * 16 + (ii); \
            if (x_in_f32) { _Pragma("unroll") for (int j = 0; j < 4; ++j) S.fx[j] = *(const GAS f32x4*)(xsrc + r_ * DM + 4 * F.lane + 256 * j); } \
            else { _Pragma("unroll") for (int j = 0; j < 4; ++j) S.bx[j] = *(const GAS v2u*)(X16 + r_ * DM + 4 * F.lane + 256 * j); } \
            if (has_res) { if (!y_moe) { _Pragma("unroll") for (int j = 0; j < 4; ++j) S.y0[j] = *(const GAS v2u*)(Y + r_ * DM + 4 * F.lane + 256 * j); } \
                else { const size_t s0_ = (size_t)__builtin_amdgcn_readlane(__float_as_int(ms0), (ii)), s1_ = (size_t)__builtin_amdgcn_readlane(__float_as_int(ms1), (ii)); \
                    S.g0 = __int_as_float(__builtin_amdgcn_readlane(__float_as_int(mg0), (ii))); S.g1 = __int_as_float(__builtin_amdgcn_readlane(__float_as_int(mg1), (ii))); \
                    _Pragma("unroll") for (int j = 0; j < 4; ++j) { S.y0[j] = *(const GAS v2u*)(Y + s0_ * DM + 4 * F.lane + 256 * j); S.y1[j] = *(const GAS v2u*)(Y + s1_ * DM + 4 * F.lane + 256 * j); } } } } while (0)
        const float gbias_ = (do_gates && F.lane < 8) ? ((const GAS float*)F.in(7))[ln * 8 + F.lane] : 0.f;
        RowSet SA_, SB_; SA_.g0 = SA_.g1 = SB_.g0 = SB_.g1 = 0.f;
        ROW_LOAD(0, SA_); if (!x_in_f32) ROW_LOAD(1, SB_);
        f32x4 cy[4], ca[4], cb[4];
#pragma unroll
        for (int j = 0; j < 4; ++j) { const int col = 4 * F.lane + 256 * j;
            if (has_res) { const f32x4 g = *(const GAS f32x4*)(mod + (size_t)(l * NB + b) * (6 * DM) + (mode == 1 ? 2 : 5) * DM + col);
                           const f32x4 ng = *(const GAS f32x4*)(F.in(5) + (size_t)(l * 4 + (mode == 1 ? 1 : 3)) * DM + col); cy[j] = g * ng; }
            if (do_norm) { const int sub = (mode == 1) ? 1 : 0;
                           const f32x4 sc = *(const GAS f32x4*)(mod + (size_t)(ln * NB + b) * (6 * DM) + (sub ? 4 : 1) * DM + col);
                           const f32x4 sh = *(const GAS f32x4*)(mod + (size_t)(ln * NB + b) * (6 * DM) + (sub ? 3 : 0) * DM + col);
                           const f32x4 ng = *(const GAS f32x4*)(F.in(5) + (size_t)(ln * 4 + (sub ? 2 : 0)) * DM + col);
                           ca[j] = ng * (sc + 1.0f); cb[j] = sh; } }
        auto row_body = [&](const int i, RowSet& S, const int pd) __attribute__((always_inline)) {
            const int rl = F.wave * 16 + i; const size_t row = (size_t)item * 128 + rl;
            f32x4 xv[4]; v2u cy0[4], cy1[4]; const float g0 = S.g0, g1 = S.g1;
#pragma unroll
            for (int j = 0; j < 4; ++j) { if (x_in_f32) xv[j] = S.fx[j]; else { const v2u w_ = S.bx[j]; xv[j] = (f32x4){bflo(w_.x), bfhi(w_.x), bflo(w_.y), bfhi(w_.y)}; } cy0[j] = S.y0[j]; cy1[j] = S.y1[j]; }
            { const int in_ = (i + pd < 16) ? i + pd : 15; ROW_LOAD(in_, S); }
            if (has_res) {
                f32x4 yv[4];
                if (!y_moe) {
#pragma unroll
                    for (int j = 0; j < 4; ++j) { const v2u w = cy0[j]; yv[j] = (f32x4){bflo(w.x), bfhi(w.x), bflo(w.y), bfhi(w.y)}; }
                } else {
#pragma unroll
                    for (int j = 0; j < 4; ++j) { const v2u w0 = cy0[j], w1 = cy1[j];
                        yv[j] = (f32x4){g0 * bflo(w0.x) + g1 * bflo(w1.x), g0 * bfhi(w0.x) + g1 * bfhi(w1.x), g0 * bflo(w0.y) + g1 * bflo(w1.y), g0 * bfhi(w0.y) + g1 * bfhi(w1.y)}; }
                }
                float ss = 0.f;
#pragma unroll
                for (int j = 0; j < 4; ++j) ss += (yv[j].x * yv[j].x + yv[j].y * yv[j].y) + (yv[j].z * yv[j].z + yv[j].w * yv[j].w);
                const float rstd = __builtin_amdgcn_rsqf(wave_sum_dpp(ss) * (1.0f / DM) + EPS);
#pragma unroll
                for (int j = 0; j < 4; ++j) xv[j] += cy[j] * (yv[j] * rstd);
                if (x_out_f32) {
#pragma unroll
                    for (int j = 0; j < 4; ++j) *(GAS f32x4*)(F.out + row * DM + 4 * F.lane + 256 * j) = xv[j];
                } else {
#pragma unroll
                    for (int j = 0; j < 4; ++j) { v2u w; w.x = pk2(xv[j].x, xv[j].y); w.y = pk2(xv[j].z, xv[j].w); *(GAS v2u*)(X16 + row * DM + 4 * F.lane + 256 * j) = w; } }
            }
            if (!has_res) {
#pragma unroll
                for (int j = 0; j < 4; ++j) { v2u w; w.x = pk2(xv[j].x, xv[j].y); w.y = pk2(xv[j].z, xv[j].w); *(GAS v2u*)(X16 + row * DM + 4 * F.lane + 256 * j) = w; } }
            if (do_norm) {
                float ss = 0.f;
#pragma unroll
                for (int j = 0; j < 4; ++j) ss += (xv[j].x * xv[j].x + xv[j].y * xv[j].y) + (xv[j].z * xv[j].z + xv[j].w * xv[j].w);
                const float rstd = __builtin_amdgcn_rsqf(wave_sum_dpp(ss) * (1.0f / DM) + EPS);
                f32x4 hv[4];
                float am = 0.f;
#pragma unroll
                for (int j = 0; j < 4; ++j) { hv[j] = (xv[j] * rstd) * ca[j] + cb[j]; am = fmaxf(fmaxf(am, fmaxf(fabsf(hv[j].x), fabsf(hv[j].y))), fmaxf(fabsf(hv[j].z), fabsf(hv[j].w))); }
                am = wave_max_dpp(am); const float qinv = am > 0.f ? 127.0f * __builtin_amdgcn_rcpf(am) : 0.f;
#pragma unroll
                for (int j = 0; j < 4; ++j) *(GAS unsigned*)((unsigned char*)H + row * DM + 4 * F.lane + 256 * j) = pk4_i8(hv[j].x * qinv, hv[j].y * qinv, hv[j].z * qinv, hv[j].w * qinv);
                if (F.lane == 0) ((float*)(F.ws + WS_SA))[row] = am * (1.0f / 127.0f);
                if (do_gates || do_router) {
                    float a8[8];
#pragma unroll
                    for (int o = 0; o < 8; ++o) a8[o] = 0.f;
#pragma unroll
                    for (int j = 0; j < 4; ++j)
#pragma unroll
                        for (int cc = 0; cc < 4; ++cc) { const int k = 4 * F.lane + 256 * j + cc; const f32x4 w0 = *(const LAS f32x4*)&W8[k * 8], w1 = *(const LAS f32x4*)&W8[k * 8 + 4]; const float hk = hv[j][cc];
                            a8[0] += hk * w0.x; a8[1] += hk * w0.y; a8[2] += hk * w0.z; a8[3] += hk * w0.w; a8[4] += hk * w1.x; a8[5] += hk * w1.y; a8[6] += hk * w1.z; a8[7] += hk * w1.w; }
#pragma unroll
                    for (int o = 0; o < 8; ++o) a8[o] = wave_sum_dpp(a8[o]);
                    if (do_gates) {
                        float v = a8[0];
#pragma unroll
                        for (int o = 1; o < 8; ++o) v = (F.lane == o) ? a8[o] : v;
                        if (F.lane < 8) gate[row * 8 + F.lane] = v + gbias_;
                    } else {
                        int e0 = 0; float v0 = a8[0];
#pragma unroll
                        for (int o = 1; o < 8; ++o) if (a8[o] > v0) { v0 = a8[o]; e0 = o; }
                        int e1 = -1; float v1 = -INFINITY;
#pragma unroll
                        for (int o = 0; o < 8; ++o) if (o != e0 && a8[o] > v1) { v1 = a8[o]; e1 = o; }
                        const float g0 = __builtin_amdgcn_rcpf(1.0f + __expf(v1 - v0));
                        if (F.lane == 0) { te[rl * 2] = e0; te[rl * 2 + 1] = e1; tg[rl * 2] = g0; tg[rl * 2 + 1] = 1.0f - g0; }
                    }
                }
            }
        };
        if (x_in_f32) {
#pragma unroll 1
            for (int i = 0; i < 16; ++i) row_body(i, SA_, 1);
        } else {
#pragma unroll 1
            for (int i = 0; i < 16; i += 2) { row_body(i, SA_, 2); row_body(i + 1, SB_, 2); }
        }
#undef ROW_LOAD
        if (do_router) {
            __syncthreads();
            if (F.tid < 256) tl[F.tid] = __hip_atomic_fetch_add(&lcnt[te[F.tid]], 1, __ATOMIC_RELAXED, __HIP_MEMORY_SCOPE_WORKGROUP);
            __syncthreads();
            if (F.tid < 8) lcnt[8 + F.tid] = (int)__hip_atomic_fetch_add(gcnt + F.tid, (unsigned)lcnt[F.tid], __ATOMIC_RELAXED, __HIP_MEMORY_SCOPE_AGENT);
            __syncthreads();
            if (F.tid < 256) { const int e = te[F.tid], pos = lcnt[8 + e] + tl[F.tid]; const int tok = item * 128 + (F.tid >> 1);
                tok_e[tok * 2 + (F.tid & 1)] = e; tok_p[tok * 2 + (F.tid & 1)] = pos; tok_g[tok * 2 + (F.tid & 1)] = tg[F.tid]; rowidx[(size_t)e * M + pos] = tok; }
            __syncthreads();
        }
    }
}
typedef float f32x16 __attribute__((ext_vector_type(16)));
typedef short v4i16_t __attribute__((ext_vector_type(4)));
#define MFMA32(a, b, c) __builtin_amdgcn_mfma_f32_32x32x16_bf16(a, b, c, 0, 0, 0)
__device__ __forceinline__ int crow16(int r, int hi) { return (r & 3) + 8 * (r >> 2) + 4 * hi; }
constexpr float KSCALE = 0.08838834764831845f;
constexpr int ML_CW_OFF = 140288;
static_assert(ML_CW_OFF >= BIAS_OFF + 8192 && ML_CW_OFF + 5120 <= LDS_BYTES, "LDS map (conv taps)");
__device__ __forceinline__ int opq(int v) { asm volatile("" : "+v"(v)); return v; }
__device__ __forceinline__ void chunk_gates(const float fpre, int lane, float& bj) {
    float lf = fminf(fpre, 0.f) - __logf(1.0f + __expf(-fabsf(fpre)));
    bj = wave_scan_sum_dpp(lf);
}
__device__ __forceinline__ bf16x8 tr_frag(const LAS unsigned short* panel, int row0, int lane) {
    const LAS unsigned short* p = panel + (row0 + 4 * (lane >> 5) + ((lane & 15) >> 2)) * 32 + ((lane >> 4) & 1) * 16 + (lane & 3) * 4;
    const v4i16_t lo = __builtin_amdgcn_ds_read_tr16_b64_v4i16((LAS v4i16_t*)p), hi = __builtin_amdgcn_ds_read_tr16_b64_v4i16((LAS v4i16_t*)(p + 8 * 32));
    return (bf16x8){lo[0], lo[1], lo[2], lo[3], hi[0], hi[1], hi[2], hi[3]};
}
__device__ __forceinline__ void load_conv_taps(Frame& F, int l, int h) {
    LAS float* CW = (LAS float*)(F.lds + ML_CW_OFF);
    for (int i = F.tid; i < 1280; i += NWAVES * 64) {
        const int jj = i >> 8, cc = i & 255, ch = (cc < 128) ? (h * 128 + cc) : (512 + h * 128 + (cc - 128));
        CW[i] = (jj < 4) ? F.in(8)[((size_t)l * 4 + jj) * 1024 + ch] : F.in(9)[(size_t)l * 1024 + ch];
    }
}
__device__ __forceinline__ void conv8(const LAS unsigned short* XR, const LAS float* CW, int cwc, int j, int c, float (&acc)[8]) {
    { const f32x4 b0 = *(const LAS f32x4*)(CW + 1024 + cwc), b1 = *(const LAS f32x4*)(CW + 1024 + cwc + 4);
      acc[0] = b0.x; acc[1] = b0.y; acc[2] = b0.z; acc[3] = b0.w; acc[4] = b1.x; acc[5] = b1.y; acc[6] = b1.z; acc[7] = b1.w; }
#pragma unroll
    for (int jj = 0; jj < 4; ++jj) { const v4u w = *(const LAS v4u*)(XR + (j + jj) * 136 + 8 * c);
        const f32x4 t0 = *(const LAS f32x4*)(CW + jj * 256 + cwc), t1 = *(const LAS f32x4*)(CW + jj * 256 + cwc + 4);
        acc[0] += bflo(w.x) * t0.x; acc[1] += bfhi(w.x) * t0.y; acc[2] += bflo(w.y) * t0.z; acc[3] += bfhi(w.y) * t0.w;
        acc[4] += bflo(w.z) * t1.x; acc[5] += bfhi(w.z) * t1.y; acc[6] += bflo(w.w) * t1.z; acc[7] += bfhi(w.w) * t1.w; }
#pragma unroll
    for (int i = 0; i < 8; ++i) acc[i] = acc[i] * __builtin_amdgcn_rcpf(1.0f + __expf(-acc[i]));
}
struct Taps8 { float t[5][8]; };
__device__ __forceinline__ void load_taps8(Frame& F, int l, int ch0  , Taps8& T) {
#pragma unroll
    for (int jj = 0; jj < 5; ++jj) { const float* src = (jj < 4) ? F.in(8) + ((size_t)l * 4 + jj) * 1024 + ch0 : F.in(9) + (size_t)l * 1024 + ch0;
        const f32x4 a = *(const GAS f32x4*)src, b = *(const GAS f32x4*)(src + 4);
        T.t[jj][0] = a.x; T.t[jj][1] = a.y; T.t[jj][2] = a.z; T.t[jj][3] = a.w; T.t[jj][4] = b.x; T.t[jj][5] = b.y; T.t[jj][6] = b.z; T.t[jj][7] = b.w; }
}
template <int NR> __device__ __forceinline__ void conv_rows(const LAS unsigned short* XR, const Taps8& T, int j0, int c, float (&out)[NR][8]) {
    float x[NR + 3][8];
#pragma unroll
    for (int r = 0; r < NR + 3; ++r) { const v4u w = *(const LAS v4u*)(XR + (j0 + r) * 136 + 8 * c);
        x[r][0] = bflo(w.x); x[r][1] = bfhi(w.x); x[r][2] = bflo(w.y); x[r][3] = bfhi(w.y); x[r][4] = bflo(w.z); x[r][5] = bfhi(w.z); x[r][6] = bflo(w.w); x[r][7] = bfhi(w.w); }
#pragma unroll
    for (int i = 0; i < NR; ++i)
#pragma unroll
        for (int e = 0; e < 8; ++e) { float a = T.t[4][e];
#pragma unroll
            for (int jj = 0; jj < 4; ++jj) a += x[i + jj][e] * T.t[jj][e];
            out[i][e] = a * __builtin_amdgcn_rcpf(1.0f + __expf(-a)); }
}
constexpr int ML_KW_OFF = 145920;
static_assert(ML_KW_OFF >= ML_CW_OFF + 5120 + 512 && ML_KW_OFF + 16384 <= LDS_BYTES, "LDS map (mLSTM panels)");
constexpr size_t WS_GST = WS_R + 288 * MiB;
__device__ __forceinline__ void mlstm_pass1(Frame& F, const int l) {
    LAS unsigned short* KR = (LAS unsigned short*)(F.lds);
    LAS unsigned short* KW = (LAS unsigned short*)(F.lds + 18432);
    LAS unsigned short* VP = (LAS unsigned short*)(F.lds + 34816);
    LAS float* WJ = (LAS float*)(F.lds + 51200);
    const float* gate = (const float*)(F.ws + WS_GATE);
    const bf16* PJ = (const bf16*)(F.ws + WS_R);
    float* GST = (float*)(F.ws + WS_GST); float* GN = (float*)(F.ws + WS_UN);
    float* GB = (float*)(F.ws + WS_BL); float* GM = (float*)(F.ws + WS_BL + 8192);
    const int r32 = F.lane & 31, hi = F.lane >> 5;
    for (int blk = F.bx; blk < 256; blk += F.G) {
        const int bh = blk >> 4, b = bh >> 2, h = bh & 3, n0 = (blk & 15) * 8;
        __syncthreads();
        Taps8 TK; load_taps8(F, l, 512 + h * 128 + 8 * (F.tid & 15), TK);
        v4u pk[3], pv[2]; float pgf = 0.f, pgi = 0.f;
        f32x16 acc0 = {}, acc1 = {}, gna = {}; float mg = -1e30f, bsum = 0.f;
        const bf16x8 ones8 = (bf16x8){(short)0x3F80, (short)0x3F80, (short)0x3F80, (short)0x3F80, (short)0x3F80, (short)0x3F80, (short)0x3F80, (short)0x3F80};
#define LDG(basep, off) (*(const GAS v4u*)((const GAS char*)(basep) + (off)))
        const unsigned lo_lin = (unsigned)F.tid * 16u;
#define P1_LOAD(nn) do { const int n_ = (nn); const long t0_ = (long)b * SEQ + (long)n_ * 64; \
            const char* bk_ = (const char*)PJ + (4 * PJB + ((long)h * M + t0_ - 3) * 128) * 2; const char* bv_ = (const char*)PJ + (5 * PJB + ((long)h * M + t0_) * 128) * 2; \
            _Pragma("unroll") for (int s = 0; s < 3; ++s) { const int jr = (F.tid >> 4) + 32 * s; pk[s] = (v4u){0u, 0u, 0u, 0u}; \
                if ((s < 2 || F.tid < 48) && n_ * 64 + jr - 3 >= 0) pk[s] = LDG(bk_ + s * 8192, lo_lin); } \
            _Pragma("unroll") for (int s = 0; s < 2; ++s) pv[s] = LDG(bv_ + s * 8192, lo_lin); \
            if (F.wave == 0) { pgf = ((const GAS float*)gate)[(t0_ + F.lane) * 8 + 4 + h]; pgi = ((const GAS float*)gate)[(t0_ + F.lane) * 8 + h]; } } while (0)
        P1_LOAD(n0);
#pragma unroll 1
        for (int k = 0; k < 8; ++k) {
            const int n = n0 + k;
#pragma unroll
            for (int s = 0; s < 3; ++s) { const int p = F.tid + 512 * s; if (p < 1072) *(LAS v4u*)(KR + (p >> 4) * 136 + 8 * (p & 15)) = pk[s]; }
#pragma unroll
            for (int s = 0; s < 2; ++s) { const int p = F.tid + 512 * s, j = p >> 4, c = p & 15; *(LAS v4u*)(VP + (c >> 2) * 2048 + j * 32 + (c & 3) * 8) = pv[s]; }
            if (F.wave == 0) {
                float bj; const float ig = pgi; chunk_gates(pgf, F.lane, bj);
                const float blast = lx_get(bj, 63), a = blast - bj + ig, mloc = wave_max_dpp_any(a);
                const float mnew = fmaxf(blast + mg, mloc);
                WJ[F.lane] = __expf(a - mnew) * KSCALE;
                if (F.lane == 0) WJ[64] = __expf(blast + mg - mnew);
                mg = mnew; bsum += blast;
            }
            __syncthreads();
            if (k + 1 < 8) P1_LOAD(n + 1);
            { const int c = F.tid & 15, j0 = 2 * (F.tid >> 4); float kc[2][8]; conv_rows<2>(KR, TK, j0, c, kc);
#pragma unroll
              for (int i = 0; i < 2; ++i) { const float wj = WJ[j0 + i];
#pragma unroll
                for (int e = 0; e < 8; ++e) kc[i][e] *= wj;
                v4u o; o.x = pk2(kc[i][0], kc[i][1]); o.y = pk2(kc[i][2], kc[i][3]); o.z = pk2(kc[i][4], kc[i][5]); o.w = pk2(kc[i][6], kc[i][7]);
                *(LAS v4u*)(KW + (c >> 2) * 2048 + (j0 + i) * 32 + (c & 3) * 8) = o; }
            }
            __syncthreads();
            { const int dkb = F.wave & 3, dvh = F.wave >> 2; const float dec = WJ[64];
              acc0 *= dec; acc1 *= dec; gna *= dec;
#pragma unroll
              for (int ks = 0; ks < 4; ++ks) {
                  const bf16x8 a = tr_frag(KW + dkb * 2048, 16 * ks, F.lane);
                  const bf16x8 b0 = tr_frag(VP + (dvh * 2) * 2048, 16 * ks, F.lane), b1 = tr_frag(VP + (dvh * 2 + 1) * 2048, 16 * ks, F.lane);
                  acc0 = MFMA32(a, b0, acc0); acc1 = MFMA32(a, b1, acc1); gna = MFMA32(a, ones8, gna); } }
            __syncthreads();
        }
        { const int dkb = F.wave & 3, dvh = F.wave >> 2; float* g = GST + (size_t)blk * 16384;
#pragma unroll
          for (int r = 0; r < 16; ++r) { const int dk = dkb * 32 + crow16(r, hi); g[dk * 128 + dvh * 64 + r32] = acc0[r]; g[dk * 128 + dvh * 64 + 32 + r32] = acc1[r]; }
          if (dvh == 0 && r32 == 0) {
#pragma unroll
              for (int r = 0; r < 16; ++r) GN[(size_t)blk * 128 + dkb * 32 + crow16(r, hi)] = gna[r]; }
          if (F.tid == 0) { GB[blk] = bsum; GM[blk] = mg; } }
#undef P1_LOAD
#undef LDG
    }
}
__device__ __forceinline__ void mlstm_pass2(Frame& F) {
    LAS float* DEC = (LAS float*)(F.lds); LAS float* WN = (LAS float*)(F.lds + 512);
    const float* GST = (const float*)(F.ws + WS_GST); float* CST = (float*)(F.ws + WS_GST + 16 * MiB);
    const float* GN = (const float*)(F.ws + WS_UN); float* CN = (float*)(F.ws + WS_NP);
    const float* GB = (const float*)(F.ws + WS_BL); const float* GM = (const float*)(F.ws + WS_BL + 8192); float* CM = (float*)(F.ws + WS_BL + 16384);
    for (int item = F.bx; item < 256; item += F.G) {
        const int bh = item >> 4, seg = item & 15;
        __syncthreads();
        if (F.wave == 0) {
            const int l16 = F.lane & 15;
            const float blv = ((const GAS float*)GB)[bh * 16 + l16], mlv = ((const GAS float*)GM)[bh * 16 + l16];
            float m = 0.f, decv = 0.f, wnv = 0.f, cmv = 0.f;
#pragma unroll
            for (int g = 0; g < 16; ++g) { const float bl = lx_get(blv, g), ml = lx_get(mlv, g), mn = fmaxf(bl + m, ml);
                const float d_ = __expf(bl + m - mn), w_ = __expf(ml - mn);
                if (F.lane == g) { decv = d_; wnv = w_; cmv = m; }
                m = mn; }
            if (F.lane < 16) { DEC[F.lane] = decv; WN[F.lane] = wnv; if (seg == 0) CM[bh * 16 + F.lane] = cmv; } }
        __syncthreads();
        { const size_t e0 = (size_t)seg * 1024 + 2 * F.tid; const float* u = GST + (size_t)bh * 16 * 16384 + e0; float* cp = CST + (size_t)bh * 16 * 16384 + e0;
          v2f uv[16];
#pragma unroll
          for (int g = 0; g < 16; ++g) uv[g] = *(const GAS v2f*)(u + (size_t)g * 16384);
          float c0 = 0.f; asm volatile("" : "+v"(c0)); float c1 = c0;
#pragma unroll
          for (int g = 0; g < 16; ++g) { *(GAS v2f*)(cp + (size_t)g * 16384) = (v2f){c0, c1}; const float d = DEC[g], w = WN[g]; c0 = c0 * d + uv[g].x * w; c1 = c1 * d + uv[g].y * w; } }
        if (F.tid < 8) { const int dk = seg * 8 + F.tid; float nv = 0.f; float gv[16];
#pragma unroll
            for (int g = 0; g < 16; ++g) gv[g] = ((const GAS float*)GN)[((size_t)bh * 16 + g) * 128 + dk];
#pragma unroll
            for (int g = 0; g < 16; ++g) { const size_t idx = ((size_t)bh * 16 + g) * 128 + dk; ((GAS float*)CN)[idx] = nv; nv = DEC[g] * nv + WN[g] * gv[g]; } }
    }
}
#if PROBE_TIMER
#define TSTF(cat) do { if (threadIdx.x == 0) { volatile LAS unsigned* TA_ = (volatile LAS unsigned*)(F.lds + LDSCTL_OFF + 64); const unsigned t_ = (unsigned)__builtin_amdgcn_s_memrealtime(); TA_[cat] += t_ - TA_[32]; TA_[32] = t_; } } while (0)
#else
#define TSTF(cat) do { } while (0)
#endif
__device__ __forceinline__ void mlstm_pass3(Frame& F, const int l) {
    LAS unsigned short* QR = (LAS unsigned short*)(F.lds);
    LAS unsigned short* KR = (LAS unsigned short*)(F.lds + 18432);
    LAS float* HM = (LAS float*)(F.lds);
    LAS unsigned short* QS = (LAS unsigned short*)(F.lds + 36864);
    LAS unsigned short* KS = (LAS unsigned short*)(F.lds + 54272);
    LAS unsigned short* VP = (LAS unsigned short*)(F.lds + 71680);
    LAS unsigned short* CPS = (LAS unsigned short*)(F.lds + 88064);
    LAS float* NPS = (LAS float*)(F.lds + 122880);
    LAS float* MROW = (LAS float*)(F.lds + 123392);
    LAS float* WJ = (LAS float*)(F.lds + 124416);
    LAS float* WSCR = (LAS float*)(F.lds + 124672) + F.wave * 64;
    LAS unsigned short* KW = (LAS unsigned short*)(F.lds + ML_KW_OFF);
    const LAS float* CW = (const LAS float*)(F.lds + ML_CW_OFF);
    const float* gate = (const float*)(F.ws + WS_GATE);
    const bf16* PJ = (const bf16*)(F.ws + WS_R);
    const float* CST = (const float*)(F.ws + WS_GST + 16 * MiB); const float* CN = (const float*)(F.ws + WS_NP);
    const float* CM = (const float*)(F.ws + WS_BL + 16384);
    bf16* MIXED = (bf16*)(F.ws + WS_R + 224 * MiB);
    for (int blk = F.bx; blk < 256; blk += F.G) {
        const int bh = blk >> 4, b = bh >> 2, h = bh & 3, n0 = (blk & 15) * 8;
        __syncthreads();
        load_conv_taps(F, l, h);
        v4u pq[3], pk[3], pv[2], po[2]; float pgf = 0.f, pgi = 0.f;
        f32x16 acc0, acc1, gna; float mst = 0.f;
        const bf16x8 ones8 = (bf16x8){(short)0x3F80, (short)0x3F80, (short)0x3F80, (short)0x3F80, (short)0x3F80, (short)0x3F80, (short)0x3F80, (short)0x3F80};
        { const int lane = opq(F.tid) & 63, r32 = lane & 31, hi = lane >> 5, dkb = F.wave & 3, dvh = F.wave >> 2; const float* g = CST + (size_t)blk * 16384;
#pragma unroll
          for (int r = 0; r < 16; ++r) { const int dk = dkb * 32 + crow16(r, hi); acc0[r] = ((const GAS float*)g)[dk * 128 + dvh * 64 + r32]; acc1[r] = ((const GAS float*)g)[dk * 128 + dvh * 64 + 32 + r32]; }
#pragma unroll
          for (int r = 0; r < 16; ++r) gna[r] = ((const GAS float*)CN)[(size_t)blk * 128 + dkb * 32 + crow16(r, hi)];
          mst = ((const GAS float*)CM)[blk]; }
        LAS float* GN = (LAS float*)(F.lds + ML_CW_OFF + 5120);
        if (F.tid < 128) GN[F.tid] = F.in(12)[(size_t)l * 512 + h * 128 + F.tid];
#define LDG(basep, off) (*(const GAS v4u*)((const GAS char*)(basep) + (off)))
#define P3_LOAD(nn) do { const int n_ = (nn); const long t0_ = (long)b * SEQ + (long)n_ * 64; const int tq_ = opq(F.tid); const unsigned lo_lin = (unsigned)tq_ * 16u; \
            const char* bq_ = (const char*)PJ + (3 * PJB + ((long)h * M + t0_ - 3) * 128) * 2; const char* bv_ = (const char*)PJ + (5 * PJB + ((long)h * M + t0_) * 128) * 2; \
            _Pragma("unroll") for (int s = 0; s < 3; ++s) { const int jr = (tq_ >> 4) + 32 * s; pq[s] = (v4u){0u, 0u, 0u, 0u}; pk[s] = (v4u){0u, 0u, 0u, 0u}; \
                if ((s < 2 || tq_ < 48) && n_ * 64 + jr - 3 >= 0) { pq[s] = LDG(bq_ + s * 8192, lo_lin); pk[s] = LDG(bq_ + PJB * 2 + s * 8192, lo_lin); } } \
            _Pragma("unroll") for (int s = 0; s < 2; ++s) pv[s] = LDG(bv_ + s * 8192, lo_lin); } while (0)
#define P3_LOAD2(nn) do { const int n_ = (nn); const long t0_ = (long)b * SEQ + (long)n_ * 64; const int tq_ = opq(F.tid); const unsigned lo_lin = (unsigned)tq_ * 16u; \
            { const char* bo_ = (const char*)PJ + (6 * PJB + ((long)h * M + t0_) * 128) * 2; po[0] = LDG(bo_, 2u * lo_lin); po[1] = LDG(bo_ + 16, 2u * lo_lin); } \
            if (F.wave == 0) { pgf = ((const GAS float*)gate)[(t0_ + tq_) * 8 + 4 + h]; pgi = ((const GAS float*)gate)[(t0_ + tq_) * 8 + h]; } } while (0)
        P3_LOAD(n0); P3_LOAD2(n0);
        float rbs_; { const float bs_ = ((const GAS float*)(F.ws + WS_SB + 409600))[l * 8 + 4 + h]; rbs_ = bs_ > 0.f ? 1.0f / bs_ : 0.f; }
#pragma unroll 1
        for (int k = 0; k < 8; ++k) {
            const int n = n0 + k; const size_t t0 = (size_t)b * SEQ + (size_t)n * 64;
            { const int tf = opq(F.tid);
#pragma unroll
            for (int s = 0; s < 3; ++s) { const int p = tf + 512 * s; if (p < 1072) { *(LAS v4u*)(QR + (p >> 4) * 136 + 8 * (p & 15)) = pq[s]; *(LAS v4u*)(KR + (p >> 4) * 136 + 8 * (p & 15)) = pk[s]; } }
#pragma unroll
            for (int s = 0; s < 2; ++s) { const int p = tf + 512 * s, j = p >> 4, c = p & 15; *(LAS v4u*)(VP + (c >> 2) * 2048 + j * 32 + (c & 3) * 8) = pv[s]; }
            { const int lane = tf & 63, r32 = lane & 31, hi = lane >> 5, dkb = F.wave & 3, dvh = F.wave >> 2;
#pragma unroll
              for (int g = 0; g < 4; ++g) { v2u w0, w1; w0.x = pk2(acc0[4 * g], acc0[4 * g + 1]); w0.y = pk2(acc0[4 * g + 2], acc0[4 * g + 3]); w1.x = pk2(acc1[4 * g], acc1[4 * g + 1]); w1.y = pk2(acc1[4 * g + 2], acc1[4 * g + 3]);
                  *(LAS v2u*)(CPS + (dvh * 64 + r32) * 136 + dkb * 32 + 8 * g + 4 * hi) = w0; *(LAS v2u*)(CPS + (dvh * 64 + 32 + r32) * 136 + dkb * 32 + 8 * g + 4 * hi) = w1; } }
            { const int lane = tf & 63, hi = lane >> 5, dkb = F.wave & 3;
              if ((F.wave >> 2) == 0 && (lane & 31) == 0) {
#pragma unroll
                  for (int r = 0; r < 16; ++r) NPS[dkb * 32 + crow16(r, hi)] = gna[r]; } } }
            const v4u o0 = po[0], o1 = po[1];
            if (F.wave == 0) { const int ln = opq(F.tid) & 63;
                float bj; const float ig = pgi; chunk_gates(pgf, ln, bj);
                const float g = ig - bj; float pm = g;
                pm = wave_scan_max_dpp(pm);
                MROW[ln] = fmaxf(mst, pm); MROW[64 + ln] = g; MROW[128 + ln] = bj;
                const float blast = lx_get(bj, 63), a = blast - bj + ig, mloc = wave_max_dpp_any(a), mnew = fmaxf(blast + mst, mloc);
                WJ[ln] = __expf(a - mnew) * KSCALE;
                if (ln == 0) { MROW[192] = mst; MROW[193] = __expf(blast + mst - mnew); }
                mst = mnew;
            }
            __syncthreads();
            if (k + 1 < 8) { P3_LOAD(n + 1); P3_LOAD2(n + 1); }
            { const int tq = opq(F.tid), qk = tq >> 8, c = tq & 15, j0 = 4 * ((tq >> 4) & 15); float oc[4][8];
              Taps8 TQK;
#pragma unroll
              for (int jj = 0; jj < 5; ++jj) { const f32x4 a = *(const LAS f32x4*)(CW + jj * 256 + qk * 128 + 8 * c), b2 = *(const LAS f32x4*)(CW + jj * 256 + qk * 128 + 8 * c + 4);
                  TQK.t[jj][0] = a.x; TQK.t[jj][1] = a.y; TQK.t[jj][2] = a.z; TQK.t[jj][3] = a.w; TQK.t[jj][4] = b2.x; TQK.t[jj][5] = b2.y; TQK.t[jj][6] = b2.z; TQK.t[jj][7] = b2.w; }
              conv_rows<4>(qk ? KR : QR, TQK, j0, c, oc);
#pragma unroll
              for (int i = 0; i < 4; ++i) { v4u o; o.x = pk2(oc[i][0], oc[i][1]); o.y = pk2(oc[i][2], oc[i][3]); o.z = pk2(oc[i][4], oc[i][5]); o.w = pk2(oc[i][6], oc[i][7]);
                *(LAS v4u*)((qk ? KS : QS) + (j0 + i) * 136 + 8 * c) = o;
                if (qk) { const float wj = WJ[j0 + i];
#pragma unroll
                    for (int e = 0; e < 8; ++e) oc[i][e] *= wj;
                    v4u ow; ow.x = pk2(oc[i][0], oc[i][1]); ow.y = pk2(oc[i][2], oc[i][3]); ow.z = pk2(oc[i][4], oc[i][5]); ow.w = pk2(oc[i][6], oc[i][7]);
                    *(LAS v4u*)(KW + (c >> 2) * 2048 + (j0 + i) * 32 + (c & 3) * 8) = ow; } }
            }
            __syncthreads();
            {
                const int lane = opq(F.tid) & 63, r32 = lane & 31, hi = lane >> 5;
                const int lb = F.wave >> 2, dvb = F.wave & 3, lrow = lb * 32 + r32;
                f32x16 st0 = {}, st1 = {}, qc = {};
                {   const LAS unsigned short* qp = QS + lrow * 136 + 8 * hi; const LAS unsigned short* kp0 = KS + r32 * 136 + 8 * hi; const LAS unsigned short* kp1 = KS + (32 + r32) * 136 + 8 * hi;
                    const LAS unsigned short* cp = CPS + (dvb * 32 + r32) * 136 + 8 * hi;
                    bf16x8 qf = *(const LAS bf16x8*)qp, k0 = *(const LAS bf16x8*)kp0, k1 = *(const LAS bf16x8*)kp1, cf = *(const LAS bf16x8*)cp;
#pragma unroll
                    for (int ks = 0; ks < 8; ++ks) {
                        bf16x8 qf2 = qf, k02 = k0, k12 = k1, cf2 = cf;
                        if (ks < 7) { qf2 = *(const LAS bf16x8*)(qp + 16 * (ks + 1)); k02 = *(const LAS bf16x8*)(kp0 + 16 * (ks + 1)); k12 = *(const LAS bf16x8*)(kp1 + 16 * (ks + 1)); cf2 = *(const LAS bf16x8*)(cp + 16 * (ks + 1)); }
                        st0 = MFMA32(k0, qf, st0);
                        st1 = MFMA32(k1, qf, st1);
                        qc = MFMA32(qf, cf, qc);
                        qf = qf2; k0 = k02; k1 = k12; cf = cf2;
                    }
                }
                const bf16x8 vf0 = tr_frag(VP + dvb * 2048, 0, lane), vf1 = tr_frag(VP + dvb * 2048, 16, lane);
                f32x4 gk[4], gk2[4];
#pragma unroll
                for (int q4 = 0; q4 < 4; ++q4) { gk[q4] = *(const LAS f32x4*)(MROW + 64 + 8 * q4 + 4 * hi); gk2[q4] = *(const LAS f32x4*)(MROW + 96 + 8 * q4 + 4 * hi); }
                const float Ml = MROW[lrow], mprev = MROW[192];
                float rs = 0.f; f32x16 hacc = {};
                {   float sw[16];
#pragma unroll
                    for (int r = 0; r < 16; ++r) { const int s = crow16(r, hi); const float v = st0[r] * KSCALE * __expf(gk[r >> 2][r & 3] - Ml); sw[r] = (s <= lrow) ? v : 0.f; rs += sw[r]; }
                    v4u pa; pa.x = pk2(sw[0], sw[1]); pa.y = pk2(sw[2], sw[3]); pa.z = pk2(sw[4], sw[5]); pa.w = pk2(sw[6], sw[7]);
                    hacc = MFMA32(__builtin_bit_cast(bf16x8, pa), vf0, hacc);
                    pa.x = pk2(sw[8], sw[9]); pa.y = pk2(sw[10], sw[11]); pa.z = pk2(sw[12], sw[13]); pa.w = pk2(sw[14], sw[15]);
                    hacc = MFMA32(__builtin_bit_cast(bf16x8, pa), vf1, hacc);
                }
                if (lb) { float sw[16];
                    const bf16x8 vf2 = tr_frag(VP + dvb * 2048, 32, lane), vf3 = tr_frag(VP + dvb * 2048, 48, lane);
#pragma unroll
                    for (int r = 0; r < 16; ++r) { const int s = 32 + crow16(r, hi); const float v = st1[r] * KSCALE * __expf(gk2[r >> 2][r & 3] - Ml); sw[r] = (s <= lrow) ? v : 0.f; rs += sw[r]; }
                    v4u pa; pa.x = pk2(sw[0], sw[1]); pa.y = pk2(sw[2], sw[3]); pa.z = pk2(sw[4], sw[5]); pa.w = pk2(sw[6], sw[7]);
                    hacc = MFMA32(__builtin_bit_cast(bf16x8, pa), vf2, hacc);
                    pa.x = pk2(sw[8], sw[9]); pa.y = pk2(sw[10], sw[11]); pa.z = pk2(sw[12], sw[13]); pa.w = pk2(sw[14], sw[15]);
                    hacc = MFMA32(__builtin_bit_cast(bf16x8, pa), vf3, hacc);
                }
                rs = sum_halves(rs);
                float qn = 0.f;
#pragma unroll
                for (int q8 = 0; q8 < 8; ++q8) { const v4u w = *(const LAS v4u*)(QS + lrow * 136 + 64 * hi + 8 * q8); const LAS float* np = NPS + 64 * hi + 8 * q8;
                    qn += bflo(w.x) * np[0] + bfhi(w.x) * np[1] + bflo(w.y) * np[2] + bfhi(w.y) * np[3] + bflo(w.z) * np[4] + bfhi(w.z) * np[5] + bflo(w.w) * np[6] + bfhi(w.w) * np[7]; }
                qn = sum_halves(qn);
                const float dec = __expf(mprev - Ml), den = dec * qn + rs, ml = MROW[128 + lrow] + Ml;
                const float inv = __builtin_amdgcn_rcpf(fmaxf(fabsf(den), __expf(-ml)));
                if (hi == 0) { WSCR[r32] = dec; WSCR[32 + r32] = inv; }
                LDS_WAIT(); asm volatile("" ::: "memory");
                f32x4 dc4[4], iv4[4];
#pragma unroll
                for (int q4 = 0; q4 < 4; ++q4) { dc4[q4] = *(const LAS f32x4*)(WSCR + 8 * q4 + 4 * hi); iv4[q4] = *(const LAS f32x4*)(WSCR + 32 + 8 * q4 + 4 * hi); }
#pragma unroll
                for (int r = 0; r < 16; ++r) { const int lr = crow16(r, hi); HM[(lb * 32 + lr) * 132 + dvb * 32 + r32] = (dc4[r >> 2][r & 3] * qc[r] + hacc[r]) * iv4[r >> 2][r & 3]; }
            }
            {
                const int lane = opq(F.tid) & 63, dkb = F.wave & 3, dvh = F.wave >> 2; const float dec = MROW[193];
                acc0 *= dec; acc1 *= dec; gna *= dec;
#pragma unroll
                for (int ks = 0; ks < 4; ++ks) {
                    const bf16x8 a = tr_frag(KW + dkb * 2048, 16 * ks, lane);
                    const bf16x8 b0 = tr_frag(VP + (dvh * 2) * 2048, 16 * ks, lane), b1 = tr_frag(VP + (dvh * 2 + 1) * 2048, 16 * ks, lane);
                    acc0 = MFMA32(a, b0, acc0); acc1 = MFMA32(a, b1, acc1); gna = MFMA32(a, ones8, gna); }
            }
            __syncthreads();
            {   const int te = opq(F.tid), lr = te >> 3, part = te & 7;
                const float ov[16] = {bflo(o0.x), bfhi(o0.x), bflo(o0.y), bfhi(o0.y), bflo(o0.z), bfhi(o0.z), bflo(o0.w), bfhi(o0.w), bflo(o1.x), bfhi(o1.x), bflo(o1.y), bfhi(o1.y), bflo(o1.z), bfhi(o1.z), bflo(o1.w), bfhi(o1.w)};
                float hv[16]; float ss = 0.f;
#pragma unroll
                for (int i = 0; i < 16; ++i) { hv[i] = HM[lr * 132 + 16 * part + i] * __builtin_amdgcn_rcpf(1.0f + __expf(-ov[i])); ss += hv[i] * hv[i]; }
                ss = sum8_dpp(ss);
                const float rstd = __builtin_amdgcn_rsqf(ss * (1.0f / 128.0f) + EPS);
                const LAS float* gn = GN + 16 * part;
                const float r2 = rstd * rbs_;
                float q[16];
#pragma unroll
                for (int i = 0; i < 16; ++i) q[i] = __builtin_amdgcn_fmed3f(hv[i] * r2 * gn[i], -127.f, 127.f);
                v4u w0; w0.x = pk4_i8(q[0], q[1], q[2], q[3]); w0.y = pk4_i8(q[4], q[5], q[6], q[7]); w0.z = pk4_i8(q[8], q[9], q[10], q[11]); w0.w = pk4_i8(q[12], q[13], q[14], q[15]);
                *(GAS v4u*)((unsigned char*)MIXED + (t0 + lr) * DM + 512 + h * 128 + 16 * part) = w0;
            }
            __syncthreads();
        }
#undef P3_LOAD
#undef P3_LOAD2
#undef LDG
    }
}
__device__ __forceinline__ void build_bias_table(Frame& F) {
    LAS float* tab = (LAS float*)(F.lds + BIAS_OFF);
    const int h = (F.vcu >> 4) & 3;
    for (int i = F.tid; i < 4 * 512; i += NWAVES * 64) { const int sft = i >> 9, j = (i & 511) + sft, d = 383 - j;
        float v = 0.f; if (j < 512 && d >= 0 && d < 128) v = (F.in(2)[T5_BUCKET[d] * 4 + h] - F.in(2)[31 * 4 + h]) * 1.4426950408889634f;
        tab[i] = v; }
    __syncthreads();
}
__device__ __forceinline__ void attn_phase_diff(Frame& F, unsigned char* lds_generic, const int l) {
    const bf16* PJ = (const bf16*)(F.ws + WS_R); bf16* AO = (bf16*)(F.ws + WS_Y); bf16* MIXED = (bf16*)(F.ws + WS_R + 224 * MiB);
    const int s = F.vcu & 15, bh = F.vcu >> 4, b = bh >> 2, hh = bh & 3;
    if (bh >= 16) return;
#pragma unroll 1
    for (int u4 = 0; u4 < 4; ++u4) {
        const int cc = u4 >> 1, qb = (u4 & 1) ? 31 - s : s, hc = hh * 2 + cc;
        const int hcn = hh * 2 + ((u4 + 1) >> 1);
        attn_body::attn_unit<8>(b, (const attn_body::bf16*)(PJ + (size_t)hc * M * 64), (const attn_body::bf16*)(PJ + PJB + (size_t)hc * M * 64), (const attn_body::bf16*)(PJ + 2 * PJB + (size_t)hh * M * 128), cc * 512 + hh * 128, qb,
                                (attn_body::bf16*)AO, (char*)lds_generic + RING_OFF, (attn_body::lds_cfptr)(F.lds + BIAS_OFF), F.tid,
                                (u4 < 3) ? (const attn_body::bf16*)(PJ + PJB + (size_t)hcn * M * 64) : (const attn_body::bf16*)nullptr, (const attn_body::bf16*)(PJ + 2 * PJB + (size_t)hh * M * 128), u4 > 0);
    }
    asm volatile("s_waitcnt vmcnt(0)" ::: "memory"); __syncthreads();
    const float lam_init = 0.8f - 0.6f * expf(-0.3f * (float)l);
    const float* lv = F.in(10) + (size_t)l * 256; const int ll = opq(F.tid) & 63;
    const float s01 = wave_sum_dpp(lv[ll] * lv[64 + ll]), s23 = wave_sum_dpp(lv[128 + ll] * lv[192 + ll]);
    const float lam = expf(s01) - expf(s23) + lam_init;
#pragma unroll 1
    for (int qi = 0; qi < 2; ++qi) {
        const int qb = qi ? 31 - s : s;
        {   const int ln = opq(F.tid) & 63, sub = ln >> 4, i16 = ln & 15;
            float gn[8];
#pragma unroll
            for (int k = 0; k < 8; ++k) gn[k] = F.in(11)[(size_t)l * 128 + 8 * i16 + k] * (1.0f - lam_init);
            const float bs_ = ((const GAS float*)(F.ws + WS_SB + 409600))[l * 8 + hh], qs = bs_ > 0.f ? 1.0f / bs_ : 0.f;
            v4u a0v[8], a1v[8];
#pragma unroll
            for (int it = 0; it < 8; ++it) { const size_t row = (size_t)b * SEQ + (size_t)qb * 256 + it * 32 + F.wave * 4 + sub;
                a0v[it] = *(const GAS v4u*)(AO + row * DM + hh * 128 + 8 * i16); a1v[it] = *(const GAS v4u*)(AO + row * DM + 512 + hh * 128 + 8 * i16); }
#pragma unroll
            for (int it = 0; it < 8; ++it) {
                const size_t row = (size_t)b * SEQ + (size_t)qb * 256 + it * 32 + F.wave * 4 + sub;
                const v4u a0 = a0v[it], a1 = a1v[it];
                const float o0[8] = {bflo(a0.x), bfhi(a0.x), bflo(a0.y), bfhi(a0.y), bflo(a0.z), bfhi(a0.z), bflo(a0.w), bfhi(a0.w)};
                const float o1[8] = {bflo(a1.x), bfhi(a1.x), bflo(a1.y), bfhi(a1.y), bflo(a1.z), bfhi(a1.z), bflo(a1.w), bfhi(a1.w)};
                float a[8]; float ss = 0.f;
#pragma unroll
                for (int k = 0; k < 8; ++k) { a[k] = o0[k] - lam * o1[k]; ss += a[k] * a[k]; }
                ss = sum16_dpp(ss);
                const float rstd = __builtin_amdgcn_rsqf(ss * (1.0f / 128.0f) + EPS);
                const float r2 = rstd * qs;
                float q[8];
#pragma unroll
                for (int k = 0; k < 8; ++k) q[k] = __builtin_amdgcn_fmed3f(a[k] * r2 * gn[k], -127.f, 127.f);
                v2u w; w.x = pk4_i8(q[0], q[1], q[2], q[3]); w.y = pk4_i8(q[4], q[5], q[6], q[7]);
                *(GAS v2u*)((unsigned char*)MIXED + row * DM + hh * 128 + 8 * i16) = w;
            }
        }
    }
}
__device__ __forceinline__ void moe_gather(Frame& F, const int mj) {
    gu32* gcnt = F.ctl + CW_MOECNT + 64 * mj;
    const bf16* H = (const bf16*)(F.ws + WS_H); bf16* HS = (bf16*)(F.ws + WS_Y); const int* rowidx = (const int*)(F.ws + WS_ROWIDX);
    unsigned cn[8]; int pb[9]; pb[0] = 0;
#pragma unroll
    for (int e = 0; e < 8; ++e) { cn[e] = gcnt[e]; pb[e + 1] = pb[e] + (int)((cn[e] + 255u) >> 8) * 256; }
    const int gw = F.vcu * NWAVES + F.wave, NGW = F.G * NWAVES;
    for (int slot0 = gw; slot0 < pb[8]; slot0 += 4 * NGW) {
        int tok[4]; bool ok[4];
#pragma unroll
        for (int u = 0; u < 4; ++u) { const int slot = slot0 + u * NGW; int e = 0, base = 0; unsigned ce = cn[0];
#pragma unroll
            for (int k = 1; k < 8; ++k) if (slot >= pb[k]) { e = k; base = pb[k]; ce = cn[k]; }
            const int pos = slot - base; ok[u] = slot < pb[8] && (unsigned)pos < ce; tok[u] = ok[u] ? ((const GAS int*)rowidx)[(size_t)e * M + pos] : 0; }
        v4u v0[4]; float sa_[4];
#pragma unroll
        for (int u = 0; u < 4; ++u) { v0[u] = (v4u){0u, 0u, 0u, 0u}; sa_[u] = 0.f;
            if (ok[u]) { v0[u] = *(const GAS v4u*)((const unsigned char*)H + (size_t)tok[u] * DM + 16 * F.lane); sa_[u] = ((const GAS float*)(F.ws + WS_SA))[tok[u]]; } }
#pragma unroll
        for (int u = 0; u < 4; ++u) { const int slot = slot0 + u * NGW; if (slot < pb[8]) {
            *(GAS v4u*)((unsigned char*)HS + (size_t)slot * DM + 16 * F.lane) = v0[u];
            if (F.lane == 0) ((GAS float*)(F.ws + WS_SA + 262144))[slot] = sa_[u]; } }
    }
}
struct Args { const float* in[21]; float* out; unsigned char* ws; int ph_lo, ph_hi; };
__global__ void __launch_bounds__(NWAVES * 64, 2) hymba_fwd(Args args) {
    extern __shared__ __attribute__((aligned(16))) unsigned char lds[];
    Frame F;
    F.lds = (LAS unsigned char*)lds;
    F.MISC = (volatile LAS unsigned*)(F.lds + MISC_OFF);
    GAS unsigned char* ws_;
    F.G = gridDim.x; F.wave0 = __builtin_amdgcn_readfirstlane((int)threadIdx.x >> 6); PHASE_BEGIN();
    F.out = (float*)(GAS float*)args.out;
    for (int u = F.tid; u < (BIAS_OFF - LDSCTL_OFF) / 4; u += NWAVES * 64) ((LAS unsigned*)(F.lds + LDSCTL_OFF))[u] = 0u;
    __syncthreads();
    XcdBarrier bar; bar.bar = (unsigned*)(F.ctl + CW_BAR); bar.x = 0; bar.st = nullptr;
    if (MK_ONE_LAUNCH) bar = xcd_barrier_post((unsigned*)(F.ctl + CW_BAR), F.MISC + 8, F.tid);
    const int lo = args.ph_lo, hi = args.ph_hi;
#if PROBE_TIMER
    volatile LAS unsigned* TACC = (volatile LAS unsigned*)(F.lds + LDSCTL_OFF + 64);
    if (threadIdx.x == 0) TACC[32] = (unsigned)__builtin_amdgcn_s_memrealtime();
#define TST(cat) do { if (threadIdx.x == 0) { const unsigned t_ = (unsigned)__builtin_amdgcn_s_memrealtime(); TACC[cat] += t_ - TACC[32]; TACC[32] = t_; } } while (0)
#else
#define TST(cat) do { } while (0)
#endif
#define IN(k) (lo <= (k) && (k) < hi)
#define SEAM(k) do { if (MK_ONE_LAUNCH && IN(k) && IN((k) + 1)) { XcdBarrier b2_ = bar; asm volatile("" : "+s"(b2_.bar)); unsigned o2_ = ~0u; asm volatile("" : "+s"(o2_)); xcd_barrier(b2_, (int)__builtin_amdgcn_mbcnt_hi(o2_, __builtin_amdgcn_mbcnt_lo(o2_, 0u)) + 64 * F.wave0); } TST(15); } while (0)
#define H ((bf16*)(F.ws + WS_H))
#define Y ((bf16*)(F.ws + WS_Y))
#define PROJ ((bf16*)(F.ws + WS_R))
#define MIXED ((bf16*)(F.ws + WS_R + 224 * MiB))
#define HID ((bf16*)(F.ws + WS_R))

    if (IN(0) && PHM(0)) { PHASE_BEGIN(); p_ada(F); p_convert_dense(F); } TST(0); SEAM(0);
    if (IN(1) && PHM(1)) { PHASE_BEGIN(); row_phase(F, 0, 0); } TST(0); SEAM(1);
#pragma unroll 1
    for (int l = 0; l < DEPTH; ++l) {
        const int pb = 2 + l * NPH; const bool moe = (l & 1) != 0; const int mj = l >> 1;
        if (IN(pb + 0) && PHM(2)) { PHASE_BEGIN();
            pg8::Gemm g{H  , (const bf16*)((const unsigned char*)(F.ws + WS_WIN) + (size_t)l * NPROJ * DM), M, NPROJ, DM / 2}; pg8::StaticOrder S; S.init(M, NPROJ, F.G, (int)F.bx);
            pg8::EpiProjHT<true> E{PROJ, M, attn_body::C2, (const float*)(F.ws + WS_SA), (const float*)(F.ws + WS_SB) + l * NPROJ};
            pg8::gemm_phase<pg8::EpiProjHT<true>, pg8::StaticOrder, PG8_ALIGN, PG8_SP2, false, true>(F.lds + RING_OFF, g, S, E, F.tid);
        } TST(1); SEAM(pb + 0);
        if (IN(pb + 1) && PHM(3)) { PHASE_BEGIN(); mlstm_pass1(F, l); } TST(2); SEAM(pb + 1);
        if (IN(pb + 2) && PHM(4)) { PHASE_BEGIN(); mlstm_pass2(F); } TST(3); SEAM(pb + 2);
        if (IN(pb + 3)) { PHASE_BEGIN(); if (PHM(5)) { if (l == 0 || !MK_ONE_LAUNCH) build_bias_table(F);        attn_phase_diff(F, lds, l); __syncthreads(); } TST(4); if (PHM(6)) mlstm_pass3(F, l); } TST(16); SEAM(pb + 3);
        if (IN(pb + 4) && PHM(8)) { PHASE_BEGIN();
            pg8::Gemm g{MIXED  , (const bf16*)((const unsigned char*)(F.ws + WS_WOUT) + (size_t)l * DM * DM), M, DM, DM / 2}; pg8::StaticOrder S; S.init(M, DM, F.G, (int)F.bx);
            pg8::EpiPlainT<true> E{Y, DM, 0, 1.f, 0, (const float*)(F.ws + WS_SB + 393216) + l * DM};
            pg8::gemm_phase<pg8::EpiPlainT<true>, pg8::StaticOrder, PG8_ALIGN, PG8_SP2, false, true>(F.lds + RING_OFF, g, S, E, F.tid);
        } TST(6); SEAM(pb + 4);
        if (IN(pb + 5)) { PHASE_BEGIN(); if (PHM(9)) row_phase(F, l, 1); TST(7); if (moe && PHM(10)) p_convert_moe(F, mj); } TST(8); SEAM(pb + 5);
        if (moe) { if (IN(pb + 6) && PHM(11)) { PHASE_BEGIN(); moe_gather(F, mj); } TST(9); SEAM(pb + 6); }
        if (IN(pb + 7)) {
            if (!moe) { if (PHM(12)) { PHASE_BEGIN();
                pg8::Gemm g{H  , (const bf16*)((const unsigned char*)(F.ws + WS_WUP) + (size_t)mj * NUP * DM), M, NUP, DM / 2}; pg8::StaticOrder S; S.init(M, NUP, F.G, (int)F.bx);
                pg8::EpiSwigluT<true, true> E{HID, DFF, 0, H8_SCALE, (const float*)(F.ws + WS_SA), (const float*)(F.ws + WS_SB + 65536) + mj * NUP};
                pg8::gemm_phase<pg8::EpiSwigluT<true, true>, pg8::StaticOrder, PG8_ALIGN, PG8_SP2, false, true>(F.lds + RING_OFF, g, S, E, F.tid);
                }
            } else if (PHM(13)) { PHASE_BEGIN(); pg8::MoeOrder S; S.init((const unsigned*)(F.ctl + CW_MOECNT + 64 * mj), NUP / 256, F.G, (int)F.bx);
                pg8::Gemm g{Y  , (const bf16*)(F.ws + WS_WMUP), MPAD, NEXP * NUP, DM / 2};
                pg8::EpiSwigluT<true, true> E8{HID, DFF, NUP / 256, H8_SCALE, (const float*)(F.ws + WS_SA + 262144), (const float*)(F.ws + WS_SB + 131072)};
                pg8::gemm_phase<pg8::EpiSwigluT<true, true>, pg8::MoeOrder, PG8_ALIGN, PG8_SP2, false, true>(F.lds + RING_OFF, g, S, E8, F.tid);
            }
        } TST(moe ? 11 : 10); SEAM(pb + 7);
        if (IN(pb + 8)) {
            if (!moe) { if (PHM(14)) { PHASE_BEGIN(); pg8::StaticOrder S; S.init(M, DM, F.G, (int)F.bx);
                pg8::EpiPlain E{Y, DM, 0, 1.f, 0};
                pg8::Gemm g{HID  , (const bf16*)((const unsigned char*)(F.ws + WS_WDN) + (size_t)mj * DM * DFF), M, DM, DFF / 2, W8D_EXP, W8D_EXP};
                pg8::gemm_phase<pg8::EpiPlain, pg8::StaticOrder, PG8_ALIGN, PG8_SP2, true>(F.lds + RING_OFF, g, S, E, F.tid);
                }
            } else if (PHM(15)) { PHASE_BEGIN(); pg8::MoeOrder S; S.init((const unsigned*)(F.ctl + CW_MOECNT + 64 * mj), DM / 256, F.G, (int)F.bx);
                pg8::EpiPlain E{Y  , DM, 0, 1.f, DM / 256};
                pg8::Gemm g{HID  , (const bf16*)(F.ws + WS_WMDN), MPAD, NEXP * DM, DFF / 2, W8D_EXP, W8D_EXP};
                pg8::gemm_phase<pg8::EpiPlain, pg8::MoeOrder, PG8_ALIGN, PG8_SP2, true>(F.lds + RING_OFF, g, S, E, F.tid);
            }
        } TST(moe ? 13 : 12); SEAM(pb + 8);
        if (IN(pb + 9) && PHM(16)) { PHASE_BEGIN(); row_phase(F, l, 2); } TST(14);
        if (l + 1 < DEPTH) SEAM(pb + 9);
    }
#if PROBE_TIMER
    if (blockIdx.x == 0) {
        __syncthreads();
        if (threadIdx.x == 0) {
            asm volatile("s_waitcnt vmcnt(0)" ::: "memory");
            unsigned sa = 0u, sd = 0u;
#pragma unroll
            for (int c = 0; c < 24; ++c) { if ((PROBE_SEL_A >> c) & 1) sa += TACC[c]; if ((PROBE_SEL_D >> c) & 1) sd += TACC[c]; }
            args.out[0] += 5.0f + (float)sa * (0.01f / PROBE_US_PER_UNIT);
            const unsigned long long t0 = __builtin_amdgcn_s_memrealtime();
            while ((unsigned)(__builtin_amdgcn_s_memrealtime() - t0) < sd) __builtin_amdgcn_s_sleep(8);
        }
    }
#endif
#undef IN
#undef SEAM
#undef H
#undef Y
#undef PROJ
#undef MIXED
#undef HID
}

extern "C" void kernel_launch(void* const* d_in, const int* in_sizes, int n_in, void* d_out, int out_size, void* d_ws, size_t ws_size, hipStream_t stream) {
    static int grid = 0;
    if (grid == 0) {
        if (n_in != 21 || out_size != M * DM || ws_size < WS_END) { fprintf(stderr, "kernel_launch: unexpected shapes (n_in %d out %d ws %zu)\n", n_in, out_size, ws_size); grid = -1; return; }
        if (hipFuncSetAttribute((const void*)hymba_fwd, hipFuncAttributeMaxDynamicSharedMemorySize, LDS_BYTES) != hipSuccess) { fprintf(stderr, "kernel_launch: hipFuncSetAttribute failed\n"); grid = -1; return; }
        int dev = 0, cus = 0, per_cu = 0;
        (void)hipGetDevice(&dev); (void)hipDeviceGetAttribute(&cus, hipDeviceAttributeMultiprocessorCount, dev);
        (void)hipOccupancyMaxActiveBlocksPerMultiprocessor(&per_cu, (const void*)hymba_fwd, NWAVES * 64, LDS_BYTES);
        (void)hipGetLastError();
        if (MK_ONE_LAUNCH && (cus < 256 || per_cu < 1)) { fprintf(stderr, "kernel_launch: needs 256 CUs with one resident workgroup each (cus %d, per_cu %d)\n", cus, per_cu); grid = -1; return; }
        grid = 256;
    }
    if (grid < 0) return;
    (void)hipMemsetAsync((char*)d_ws + WS_CTL, 0, CTL_ZERO_BYTES, stream);
    Args a{};
    for (int i = 0; i < 21; ++i) a.in[i] = (const float*)d_in[i];
    a.out = (float*)d_out; a.ws = (unsigned char*)d_ws;
#if MK_ONE_LAUNCH
    a.ph_lo = 0; a.ph_hi = PH_TOTAL;
    hipLaunchKernelGGL(hymba_fwd, dim3(grid), dim3(NWAVES * 64), LDS_BYTES, stream, a);
#else
    for (int p = 0; p < PH_TOTAL; ++p) {
        const int rel = (p - 2) % NPH, l = (p - 2) / NPH;
        if (p >= 2 && rel == 6 && !(l & 1)) continue;
        a.ph_lo = p; a.ph_hi = p + 1;
        hipLaunchKernelGGL(hymba_fwd, dim3(grid), dim3(NWAVES * 64), LDS_BYTES, stream, a);
    }
#endif
}
```

```cpp
#include <hip/hip_runtime.h>
#include <cstdio>
#include <cstdint>
namespace pg8 {
#define PG8_LAS __attribute__((address_space(3)))
typedef unsigned short bf16_t;
typedef short bf16x8 __attribute__((ext_vector_type(8)));
typedef float f32x4 __attribute__((ext_vector_type(4)));
typedef unsigned u32x4 __attribute__((ext_vector_type(4)));
constexpr int BM = 256, BK = 64, HALF = 128, HTB = HALF * BK * 2  , STAGE_BYTES = 8 * HTB, NXCD = 8, WGM = 8;

__host__ __device__ __forceinline__ int lds_byte(int r, int c) { const int st = (r >> 4) * 2 + (c >> 5), rr = r & 15, cc = c & 31, ob = rr * 64 + cc * 2; return st * 1024 + (ob ^ (((ob >> 9) & 1) << 5)); }
__host__ __device__ __forceinline__ void stage_rc(int b, int& R, int& C) { const int st = b / 1024, sb = b % 1024, swz = sb ^ (((sb >> 9) & 1) << 5); R = (st >> 1) * 16 + swz / 64; C = (st & 1) * 32 + (swz % 64) / 2; }
__host__ __device__ __forceinline__ int perm32(int rho) { const int n = rho >> 4, i = rho & 15; return 8 * (i >> 2) + 4 * n + (i & 3); }

struct Unit { int pm, pn; };
typedef int v4i32_t __attribute__((ext_vector_type(4)));
struct Gemm { const bf16_t* A; const bf16_t* Bt; int M, N, K; int scale_a = 127, scale_b = 127; };

struct StaticOrder {
    int nM, nN, nwg, G, c;
    __host__ __device__ void init(int M, int N, int G_, int c_) { nM = M / BM; nN = N / BM; nwg = nM * nN; G = G_; c = c_; }
    __host__ __device__ bool next(int i, Unit& u) const {
        const long L = (long)i * G + c; if (L >= nwg) return false;
        int wgid = (int)L; { const int q = nwg / NXCD, r = nwg % NXCD, xcd = wgid % NXCD, off = wgid / NXCD; wgid = (xcd < r ? xcd * (q + 1) : r * (q + 1) + (xcd - r) * q) + off; }
        const int nig = WGM * nN, gid = wgid / nig, fm = gid * WGM, gsz = (nM - fm) < WGM ? (nM - fm) : WGM;
        u.pm = fm + ((wgid % nig) % gsz); u.pn = (wgid % nig) / gsz; return true;
    }
    __device__ __forceinline__ void a_ready(const Unit&) const {}
    __device__ __forceinline__ void done(const Unit&) const {}
};

__device__ __forceinline__ unsigned cvt_pk_bf16(float lo, float hi) { unsigned r; asm volatile("v_cvt_pk_bf16_f32 %0, %1, %2" : "=v"(r) : "v"(lo), "v"(hi)); return r; }
typedef float f32x2 __attribute__((ext_vector_type(2)));
__device__ __forceinline__ f32x2 gelu_pk(f32x2 v) {
    const f32x2 av = __builtin_elementwise_abs(v), d = av * 0.2316418882f + 1.0f;
    f32x2 t; t.x = __builtin_amdgcn_rcpf(d.x); t.y = __builtin_amdgcn_rcpf(d.y);
    f32x2 q = t * 0.5307027145f + (-0.7265760135f); q = q * t + 0.7107068705f; q = q * t + (-0.142248368f); q = q * t + 0.127414796f; q = q * t;
    const f32x2 s = (v * v) * (-0.72134752044f);
    f32x2 e; e.x = __builtin_amdgcn_exp2f(s.x); e.y = __builtin_amdgcn_exp2f(s.y);
    const f32x2 m = v * (q * e), r = v - m;
    f32x2 o; o.x = v.x < 0.f ? m.x : r.x; o.y = v.y < 0.f ? m.y : r.y; return o;
}

template <int ACT  > struct EpiBf16 {
    static constexpr bool PERM = true, AFTER_DRAIN = false; static_assert(ACT == 0 || ACT == 1, "EpiBf16: ACT is 0 (none) or 1 (gelu_pk)");
    bf16_t* O; int ldc; const float* bias; int split_cols; size_t split_stride; float scale0;
    __device__ __forceinline__ void operator()(const f32x4 (&acc)[2][2][4][2], const Unit& u, int wr, int wc, int fr, int fq) const {
        const int row0 = u.pm * BM + wr * 64 + fr; int colt = u.pn * BM; bf16_t* base = O;
        float sc = 1.f; if (split_cols) { const int t = colt / split_cols; base += (size_t)t * split_stride; colt -= t * split_cols; if (t == 0) sc = scale0; }
        const int col0 = colt + wc * 32 + 8 * fq, bcol0 = u.pn * BM + wc * 32 + 8 * fq;
        f32x4 bv[2][2];
#pragma unroll
        for (int bj = 0; bj < 2; ++bj)
#pragma unroll
            for (int n = 0; n < 2; ++n) bv[bj][n] = bias ? *(const f32x4*)(bias + bcol0 + bj * HALF + 4 * n) : (f32x4){0.f, 0.f, 0.f, 0.f};
#pragma unroll
        for (int ai = 0; ai < 2; ++ai)
#pragma unroll
            for (int m = 0; m < 4; ++m) { bf16_t* rowp = base + (size_t)(row0 + ai * HALF + m * 16) * ldc + col0;
#pragma unroll
                for (int bj = 0; bj < 2; ++bj) { f32x4 v0 = acc[ai][bj][m][0] + bv[bj][0], v1 = acc[ai][bj][m][1] + bv[bj][1];
                    if (ACT == 1) { f32x2 a = gelu_pk((f32x2){v0[0], v0[1]}), b = gelu_pk((f32x2){v0[2], v0[3]}), c = gelu_pk((f32x2){v1[0], v1[1]}), d = gelu_pk((f32x2){v1[2], v1[3]});
                        v0 = (f32x4){a.x, a.y, b.x, b.y}; v1 = (f32x4){c.x, c.y, d.x, d.y}; }
                    v0 = v0 * sc; v1 = v1 * sc; u32x4 w; w.x = cvt_pk_bf16(v0[0], v0[1]); w.y = cvt_pk_bf16(v0[2], v0[3]); w.z = cvt_pk_bf16(v1[0], v1[1]); w.w = cvt_pk_bf16(v1[2], v1[3]);
                    *(u32x4*)(rowp + bj * HALF) = w; } }
    }
};


template <class Epi, class Sched, bool ALIGN_EPI = false, bool SP2 = false, bool FP8 = false, bool I8 = false>
__device__ __forceinline__ void gemm_phase(PG8_LAS unsigned char* lds, const Gemm g, const Sched& S, const Epi& E, const int tid) {
    const int wid = __builtin_amdgcn_readfirstlane(tid >> 6), lane = tid & 63, wr = wid >> 2, wc = wid & 3, fr = lane & 15, fq = lane >> 4;
    const int K = g.K, nt = K / BK;
    unsigned voffA[2], voffB[2];
#pragma unroll
    for (int i = 0; i < 2; ++i) { int R, C; stage_rc(tid * 16 + i * 8192, R, C); const int Rb = Epi::PERM ? ((R & ~31) + perm32(R & 31)) : R;
        voffA[i] = (unsigned)(R * K + C) * 2u; voffB[i] = (unsigned)(Rb * K + C) * 2u; }
    const unsigned lds32 = (unsigned)(uintptr_t)lds; const size_t rstep64 = (size_t)64 * K * 2;
    const size_t kstep = (size_t)(BK * 2);
    const size_t hstep = (size_t)HALF * K * 2;
    const size_t tstep = 2 * hstep;
    const unsigned ldsw = (unsigned)wid * 1024u;
    const int aoff = lds_byte(wr * 64 + fr, fq * 8), boff = lds_byte(wc * 32 + fr, fq * 8);
#define PG8_SA(b, h) (((b) * 2 + (h)) * HTB)
#define PG8_SB(b, h) ((4 + (b) * 2 + (h)) * HTB)
#define PG8_GLDS(gptr, vo, ldsaddr) do { unsigned _keep; asm volatile("s_mov_b32 %0, m0\n\ts_mov_b32 m0, %3\n\ts_nop 0\n\tglobal_load_lds_dwordx4 %1, %2\n\ts_mov_b32 m0, %0" \
        : "=&s"(_keep) : "v"(vo), "s"(gptr), "s"(ldsaddr) : "memory"); } while (0)
#define PG8_STAGE(bufoff, gbase, voff) do { const unsigned _la = lds32 + (unsigned)(bufoff) + ldsw; \
        PG8_GLDS((const char*)(gbase), (voff)[0], _la); PG8_GLDS((const char*)(gbase) + rstep64, (voff)[0], _la + 8192u); } while (0)
#define PG8_LDA(dst, b, h) do { _Pragma("unroll") for (int m = 0; m < 4; ++m) _Pragma("unroll") for (int k = 0; k < 2; ++k) dst[m][k] = *(const PG8_LAS bf16x8*)(lds + PG8_SA(b, h) + aoff + m * 2048 + k * 1024); } while (0)
#define PG8_LDB(dst, b, h) do { _Pragma("unroll") for (int n = 0; n < 2; ++n) _Pragma("unroll") for (int k = 0; k < 2; ++k) dst[n][k] = *(const PG8_LAS bf16x8*)(lds + PG8_SB(b, h) + boff + n * 2048 + k * 1024); } while (0)
#define PG8_MMA(ai, bj, At, Bt) do { __builtin_amdgcn_s_setprio(1); \
        if constexpr (FP8) { _Pragma("unroll") for (int m = 0; m < 4; ++m) _Pragma("unroll") for (int n = 0; n < 2; ++n) \
            acc[ai][bj][m][n] = __builtin_amdgcn_mfma_scale_f32_16x16x128_f8f6f4(__builtin_shufflevector(__builtin_bit_cast(v4i32_t, Bt[n][0]), __builtin_bit_cast(v4i32_t, Bt[n][1]), 0, 1, 2, 3, 4, 5, 6, 7), \
                __builtin_shufflevector(__builtin_bit_cast(v4i32_t, At[m][0]), __builtin_bit_cast(v4i32_t, At[m][1]), 0, 1, 2, 3, 4, 5, 6, 7), acc[ai][bj][m][n], 0, 0, 0, g.scale_b, 0, g.scale_a); } \
        else if constexpr (I8) { _Pragma("unroll") for (int m = 0; m < 4; ++m) _Pragma("unroll") for (int n = 0; n < 2; ++n) _Pragma("unroll") for (int k = 0; k < 2; ++k)   \
            acc[ai][bj][m][n] = __builtin_bit_cast(f32x4, __builtin_amdgcn_mfma_i32_16x16x64_i8(__builtin_bit_cast(v4i32_t, Bt[n][k]), __builtin_bit_cast(v4i32_t, At[m][k]), __builtin_bit_cast(v4i32_t, acc[ai][bj][m][n]), 0, 0, 0)); } \
        else { _Pragma("unroll") for (int m = 0; m < 4; ++m) _Pragma("unroll") for (int n = 0; n < 2; ++n) _Pragma("unroll") for (int k = 0; k < 2; ++k) \
            acc[ai][bj][m][n] = __builtin_amdgcn_mfma_f32_16x16x32_bf16(Bt[n][k], At[m][k], acc[ai][bj][m][n], 0, 0, 0); } \
        __builtin_amdgcn_s_setprio(0); } while (0)
#define PG8_WAIT_V(n) asm volatile("s_waitcnt vmcnt(" #n ")" ::: "memory")
#define PG8_WAIT_L(n) asm volatile("s_waitcnt lgkmcnt(" #n ")" ::: "memory")
#define PG8_BAR __builtin_amdgcn_s_barrier()
#define PG8_SCHED __builtin_amdgcn_sched_barrier(0)
    Unit cur, nxt; int ui = 0;
    if (!S.next(0, cur)) return;
    f32x4 acc[2][2][4][2];
#pragma unroll
    for (int a = 0; a < 2; ++a)
#pragma unroll
        for (int b = 0; b < 2; ++b)
#pragma unroll
            for (int m = 0; m < 4; ++m)
#pragma unroll
                for (int n = 0; n < 2; ++n) acc[a][b][m][n] = (f32x4){0.f, 0.f, 0.f, 0.f};
    bf16x8 At[4][2], B0[2][2], B1[2][2];
    const char* cA = (const char*)g.A + (size_t)cur.pm * tstep; const char* cB = (const char*)g.Bt + (size_t)cur.pn * tstep;
    S.a_ready(cur);
    if constexpr (SP2) {
        PG8_STAGE(PG8_SB(0, 0), cB, voffB); PG8_STAGE(PG8_SB(0, 1), cB + hstep, voffB); PG8_STAGE(PG8_SA(0, 0), cA, voffA); PG8_STAGE(PG8_SA(0, 1), cA + hstep, voffA);
        if (wr == 1) PG8_BAR;
        PG8_WAIT_V(2); PG8_BAR;
        PG8_STAGE(PG8_SB(1, 0), cB + kstep, voffB); PG8_STAGE(PG8_SA(1, 0), cA + kstep, voffA); PG8_STAGE(PG8_SB(1, 1), cB + hstep + kstep, voffB);
        PG8_WAIT_V(6); PG8_BAR;
    } else {
        PG8_STAGE(PG8_SB(0, 0), cB, voffB); PG8_STAGE(PG8_SA(0, 0), cA, voffA); PG8_STAGE(PG8_SB(0, 1), cB + hstep, voffB); PG8_STAGE(PG8_SA(0, 1), cA + hstep, voffA);
        if (wr == 1) PG8_BAR;
        PG8_WAIT_V(4); PG8_BAR;
        PG8_STAGE(PG8_SB(1, 0), cB + kstep, voffB); PG8_STAGE(PG8_SA(1, 0), cA + kstep, voffA); PG8_STAGE(PG8_SB(1, 1), cB + hstep + kstep, voffB);
        PG8_WAIT_V(6); PG8_BAR;
    }
    for (;;) {
        const bool has_next = S.next(ui + 1, nxt);
        const char* nA = has_next ? (const char*)g.A + (size_t)nxt.pm * tstep : cA; const char* nB = has_next ? (const char*)g.Bt + (size_t)nxt.pn * tstep : cB;
#pragma unroll 1
        for (int t = 0; t < nt; t += 2) {
            const bool last = (t == nt - 2);
            const char* a1 = cA + (size_t)(t + 1) * kstep;
            const char* a2 = last ? nA : cA + (size_t)(t + 2) * kstep; const char* b2 = last ? nB : cB + (size_t)(t + 2) * kstep;
            const char* a3 = a2 + kstep; const char* b3 = b2 + kstep;
            if (last && has_next) S.a_ready(nxt);
            if constexpr (SP2) {
            PG8_LDB(B0, 0, 0); PG8_LDB(B1, 0, 1); PG8_SCHED; PG8_LDA(At, 0, 0); PG8_STAGE(PG8_SA(1, 1), a1 + hstep, voffA);
            PG8_WAIT_V(8); PG8_WAIT_L(0); PG8_BAR; PG8_MMA(0, 0, At, B0); PG8_MMA(0, 1, At, B1); PG8_BAR; PG8_SCHED;
            PG8_LDA(At, 0, 1); PG8_STAGE(PG8_SB(0, 0), b2, voffB); PG8_STAGE(PG8_SB(0, 1), b2 + hstep, voffB); PG8_STAGE(PG8_SA(0, 0), a2, voffA);
            PG8_WAIT_V(8); PG8_WAIT_L(0); PG8_BAR; PG8_MMA(1, 0, At, B0); PG8_MMA(1, 1, At, B1); PG8_BAR; PG8_SCHED;
            PG8_LDB(B0, 1, 0); PG8_LDB(B1, 1, 1); PG8_SCHED; PG8_LDA(At, 1, 0); PG8_STAGE(PG8_SA(0, 1), a2 + hstep, voffA);
            PG8_WAIT_V(8); PG8_WAIT_L(0); PG8_BAR; PG8_MMA(0, 0, At, B0); PG8_MMA(0, 1, At, B1); PG8_BAR; PG8_SCHED;
            PG8_LDA(At, 1, 1); PG8_STAGE(PG8_SB(1, 0), b3, voffB); PG8_STAGE(PG8_SB(1, 1), b3 + hstep, voffB); PG8_STAGE(PG8_SA(1, 0), a3, voffA);
            PG8_WAIT_V(8); PG8_WAIT_L(0); PG8_BAR; PG8_MMA(1, 0, At, B0); PG8_MMA(1, 1, At, B1); PG8_BAR; PG8_SCHED;
            } else {
            PG8_LDB(B0, 0, 0); PG8_SCHED; PG8_LDA(At, 0, 0); PG8_STAGE(PG8_SA(1, 1), a1 + hstep, voffA);
            PG8_WAIT_L(8); PG8_BAR; PG8_WAIT_L(0); PG8_MMA(0, 0, At, B0); PG8_BAR; PG8_SCHED;
            PG8_LDB(B1, 0, 1); PG8_STAGE(PG8_SB(0, 0), b2, voffB);
            PG8_BAR; PG8_WAIT_L(0); PG8_MMA(0, 1, At, B1); PG8_BAR;
            PG8_LDA(At, 0, 1); PG8_STAGE(PG8_SA(0, 0), a2, voffA);
            PG8_BAR; PG8_WAIT_L(0); PG8_MMA(1, 0, At, B0); PG8_BAR; PG8_SCHED;
            PG8_STAGE(PG8_SB(0, 1), b2 + hstep, voffB);
            PG8_WAIT_V(6); PG8_BAR; PG8_MMA(1, 1, At, B1); PG8_BAR;
            PG8_LDB(B0, 1, 0); PG8_SCHED; PG8_LDA(At, 1, 0); PG8_STAGE(PG8_SA(0, 1), a2 + hstep, voffA);
            PG8_WAIT_L(8); PG8_BAR; PG8_WAIT_L(0); PG8_MMA(0, 0, At, B0); PG8_BAR; PG8_SCHED;
            PG8_LDB(B1, 1, 1); PG8_STAGE(PG8_SB(1, 0), b3, voffB);
            PG8_BAR; PG8_WAIT_L(0); PG8_MMA(0, 1, At, B1); PG8_BAR;
            PG8_LDA(At, 1, 1); PG8_STAGE(PG8_SA(1, 0), a3, voffA);
            PG8_BAR; PG8_WAIT_L(0); PG8_MMA(1, 0, At, B0); PG8_BAR; PG8_SCHED;
            PG8_STAGE(PG8_SB(1, 1), b3 + hstep, voffB);
            PG8_WAIT_V(6); PG8_BAR; PG8_MMA(1, 1, At, B1); PG8_BAR;
            }
        }
        if constexpr (ALIGN_EPI) { if (wr == 0) PG8_BAR; }
        if constexpr (!Epi::AFTER_DRAIN) { unsigned o_ = ~0u; asm volatile("" : "+s"(o_)); const int le_ = (int)__builtin_amdgcn_mbcnt_hi(o_, __builtin_amdgcn_mbcnt_lo(o_, 0u));
            E(acc, cur, wr, wc, le_ & 15, le_ >> 4); S.done(cur); }
        if (!has_next) break;
#pragma unroll
        for (int a = 0; a < 2; ++a)
#pragma unroll
            for (int b = 0; b < 2; ++b)
#pragma unroll
                for (int m = 0; m < 4; ++m)
#pragma unroll
                    for (int n = 0; n < 2; ++n) acc[a][b][m][n] = (f32x4){0.f, 0.f, 0.f, 0.f};
        cur = nxt; cA = nA; cB = nB; ++ui;
        if constexpr (ALIGN_EPI) { if (wr == 1) PG8_BAR; }
    }
    PG8_WAIT_V(0);
    if constexpr (!ALIGN_EPI) { if (wr == 0) PG8_BAR; }
    PG8_BAR;
    if constexpr (Epi::AFTER_DRAIN) { E.fused(acc, cur, wr, wc, fr, fq, lds, wid, lane); S.done(cur); }
#undef PG8_SA
#undef PG8_SB
#undef PG8_STAGE
#undef PG8_GLDS
#undef PG8_LDA
#undef PG8_LDB
#undef PG8_MMA
#undef PG8_WAIT_V
#undef PG8_WAIT_L
#undef PG8_BAR
#undef PG8_SCHED
}
}

#ifndef PG8_SP2
#define PG8_SP2 true
#endif
#ifndef PG8_ALIGN
#define PG8_ALIGN true
#endif
namespace pg8 {
template <bool DQ = false> struct EpiPlainT {
    static constexpr bool PERM = true, AFTER_DRAIN = false;
    bf16_t* O; int ldc; int qcols; float scale0; int pn_mod; const float* sb = nullptr;
    __device__ __forceinline__ void operator()(const f32x4 (&acc)[2][2][4][2], const Unit& u, int wr, int wc, int fr, int fq) const {
        const int pn = pn_mod ? (u.pn % pn_mod) : u.pn;
        const int colt = pn * BM; const float sc = (colt < qcols) ? scale0 : 1.f;
        const int row0 = u.pm * BM + wr * 64 + fr, col0 = colt + wc * 32 + 8 * fq;
        f32x4 sbv[2][2];
        if constexpr (DQ) {
#pragma unroll
            for (int bj = 0; bj < 2; ++bj)
#pragma unroll
                for (int n = 0; n < 2; ++n) sbv[bj][n] = *(const __attribute__((address_space(1))) f32x4*)(sb + (size_t)u.pn * BM + bj * HALF + wc * 32 + 8 * fq + 4 * n); }
#pragma unroll
        for (int ai = 0; ai < 2; ++ai)
#pragma unroll
            for (int m = 0; m < 4; ++m) { bf16_t* rowp = O + (size_t)(row0 + ai * HALF + m * 16) * ldc + col0;
#pragma unroll
                for (int bj = 0; bj < 2; ++bj) { f32x4 v0, v1;
                    if constexpr (DQ) { v0 = __builtin_convertvector(__builtin_bit_cast(v4i32_t, acc[ai][bj][m][0]), f32x4) * sbv[bj][0]; v1 = __builtin_convertvector(__builtin_bit_cast(v4i32_t, acc[ai][bj][m][1]), f32x4) * sbv[bj][1]; }
                    else { v0 = acc[ai][bj][m][0] * sc; v1 = acc[ai][bj][m][1] * sc; }
                    u32x4 w; w.x = cvt_pk_bf16(v0[0], v0[1]); w.y = cvt_pk_bf16(v0[2], v0[3]); w.z = cvt_pk_bf16(v1[0], v1[1]); w.w = cvt_pk_bf16(v1[2], v1[3]);
                    *(u32x4*)(rowp + bj * HALF) = w; } }
    }
};
typedef EpiPlainT<false> EpiPlain;
__device__ __forceinline__ f32x4 dq4(const f32x4& a) { return __builtin_convertvector(__builtin_bit_cast(v4i32_t, a), f32x4); }
template <bool DQ = false> struct EpiProjHT {
    static constexpr bool PERM = true, AFTER_DRAIN = false;
    bf16_t* PJ; int MT; float scale0; const float* sa = nullptr; const float* sb = nullptr;
    __device__ __forceinline__ void operator()(const f32x4 (&acc)[2][2][4][2], const Unit& u, int wr, int wc, int fr, int fq) const {
        const int pn = u.pn; const float sc = (pn < 2) ? scale0 : 1.f;
        const size_t BLK = (size_t)MT * 512;
        f32x4 sbv[2][2];
        if constexpr (DQ) {
#pragma unroll
            for (int bj = 0; bj < 2; ++bj)
#pragma unroll
                for (int n = 0; n < 2; ++n) sbv[bj][n] = *(const __attribute__((address_space(1))) f32x4*)(sb + pn * BM + bj * HALF + wc * 32 + 8 * fq + 4 * n) * sc; }
        float sarv[2][4];
#pragma unroll
        for (int ai = 0; ai < 2; ++ai)
#pragma unroll
            for (int m = 0; m < 4; ++m) { sarv[ai][m] = 1.f; if constexpr (DQ) sarv[ai][m] = ((const __attribute__((address_space(1))) float*)sa)[u.pm * BM + wr * 64 + fr + ai * HALF + m * 16]; }
        size_t bo[2], SAe, SMe; const int rr = u.pm * BM + wr * 64 + fr;
        if (pn < 2) { const int hc0 = pn * 4 + (wc >> 1); SAe = 128 * 64; SMe = 16 * 64;
#pragma unroll
            for (int bj = 0; bj < 2; ++bj) bo[bj] = ((size_t)(hc0 + 2 * bj) * MT + rr) * 64 + (wc & 1) * 32 + 8 * fq; }
        else if (pn < 4) { const int hc0 = (pn - 2) * 4 + (wc >> 1), chunk = (wc & 1) * 4 + fq; SAe = 2 * 8 * 512; SMe = 16 * 8;
#pragma unroll
            for (int bj = 0; bj < 2; ++bj) bo[bj] = BLK + (((size_t)(hc0 + 2 * bj) * (MT / 64) + u.pm * 4 + wr) * 8 + chunk) * 512 + fr * 8; }
        else if (pn < 6) { const int h0 = (pn - 4) * 2; SAe = 2 * 4 * 2048; SMe = 16 * 32;
#pragma unroll
            for (int bj = 0; bj < 2; ++bj) bo[bj] = 2 * BLK + (((size_t)(h0 + bj) * (MT / 64) + u.pm * 4 + wr) * 4 + wc) * 2048 + fr * 32 + 8 * fq; }
        else { const int T = 3 + ((pn - 6) >> 1), h0 = ((pn - 6) & 1) * 2; SAe = 128 * 128; SMe = 16 * 128;
#pragma unroll
            for (int bj = 0; bj < 2; ++bj) bo[bj] = (size_t)T * BLK + ((size_t)(h0 + bj) * MT + rr) * 128 + wc * 32 + 8 * fq; }
#pragma unroll
        for (int ai = 0; ai < 2; ++ai)
#pragma unroll
            for (int m = 0; m < 4; ++m) {
                const float sar = sarv[ai][m];
#pragma unroll
                for (int bj = 0; bj < 2; ++bj) { f32x4 v0, v1;
                    if constexpr (DQ) { v0 = dq4(acc[ai][bj][m][0]) * sbv[bj][0] * sar; v1 = dq4(acc[ai][bj][m][1]) * sbv[bj][1] * sar; }
                    else { v0 = acc[ai][bj][m][0] * sc; v1 = acc[ai][bj][m][1] * sc; }
                    u32x4 w; w.x = cvt_pk_bf16(v0[0], v0[1]); w.y = cvt_pk_bf16(v0[2], v0[3]); w.z = cvt_pk_bf16(v1[0], v1[1]); w.w = cvt_pk_bf16(v1[2], v1[3]);
                    *(u32x4*)(PJ + bo[bj] + ai * SAe + m * SMe) = w; } }
    }
};
typedef EpiProjHT<false> EpiProjH;
__device__ __forceinline__ float silu_f(float x) { return x * __builtin_amdgcn_rcpf(1.0f + __builtin_amdgcn_exp2f(-1.4426950408889634f * x)); }
template <bool OUT8 = false, bool DQ = false> struct EpiSwigluT {
    static constexpr bool PERM = true, AFTER_DRAIN = false;
    bf16_t* O; int ldc; int pn_mod; float out_scale = 1.f; const float* sa = nullptr; const float* sb = nullptr;
    __device__ __forceinline__ void operator()(const f32x4 (&acc)[2][2][4][2], const Unit& u, int wr, int wc, int fr, int fq) const {
        const int pn = pn_mod ? (u.pn % pn_mod) : u.pn;
        const int row0 = u.pm * BM + wr * 64 + fr, col0 = pn * HALF + wc * 32 + 8 * fq;
        f32x4 sbv[2][2];
        if constexpr (DQ) {
#pragma unroll
            for (int bj = 0; bj < 2; ++bj)
#pragma unroll
                for (int n = 0; n < 2; ++n) sbv[bj][n] = *(const __attribute__((address_space(1))) f32x4*)(sb + (size_t)u.pn * BM + bj * HALF + wc * 32 + 8 * fq + 4 * n); }
        float sarv[2][4];
#pragma unroll
        for (int ai = 0; ai < 2; ++ai)
#pragma unroll
            for (int m = 0; m < 4; ++m) { sarv[ai][m] = 1.f; if constexpr (DQ) sarv[ai][m] = ((const __attribute__((address_space(1))) float*)sa)[row0 + ai * HALF + m * 16]; }
#pragma unroll
        for (int ai = 0; ai < 2; ++ai)
#pragma unroll
            for (int m = 0; m < 4; ++m) { bf16_t* rowp = O + (size_t)(row0 + ai * HALF + m * 16) * ldc + col0;
                if constexpr (DQ && OUT8) {
                    const float sar = sarv[ai][m], sau = sar * out_scale;
                    unsigned wq[2];
#pragma unroll
                    for (int n = 0; n < 2; ++n) {
                        const f32x4 t = dq4(acc[ai][0][m][n]) * (sbv[0][n] * sar), uu = dq4(acc[ai][1][m][n]) * (sbv[1][n] * sau);
                        const f32x4 x2 = t * (-1.4426950408889634f);
                        f32x4 e; e[0] = __builtin_amdgcn_exp2f(x2[0]); e[1] = __builtin_amdgcn_exp2f(x2[1]); e[2] = __builtin_amdgcn_exp2f(x2[2]); e[3] = __builtin_amdgcn_exp2f(x2[3]);
                        const f32x4 d = e + 1.0f;
                        f32x4 r; r[0] = __builtin_amdgcn_rcpf(d[0]); r[1] = __builtin_amdgcn_rcpf(d[1]); r[2] = __builtin_amdgcn_rcpf(d[2]); r[3] = __builtin_amdgcn_rcpf(d[3]);
                        const f32x4 hq = (t * r) * uu;
                        int w0 = __builtin_amdgcn_cvt_pk_fp8_f32(__builtin_amdgcn_fmed3f(hq[0], -448.f, 448.f), __builtin_amdgcn_fmed3f(hq[1], -448.f, 448.f), 0, false);
                        w0 = __builtin_amdgcn_cvt_pk_fp8_f32(__builtin_amdgcn_fmed3f(hq[2], -448.f, 448.f), __builtin_amdgcn_fmed3f(hq[3], -448.f, 448.f), w0, true);
                        wq[n] = (unsigned)w0; }
                    typedef unsigned u32x2_t __attribute__((ext_vector_type(2))); u32x2_t w8; w8.x = wq[0]; w8.y = wq[1];
                    *(u32x2_t*)((unsigned char*)O + (size_t)(row0 + ai * HALF + m * 16) * ldc + col0) = w8;
                    continue; }
                f32x4 g0, g1, u0, u1;
                if constexpr (DQ) { const float sar = sarv[ai][m];
                    g0 = dq4(acc[ai][0][m][0]) * sbv[0][0] * sar; g1 = dq4(acc[ai][0][m][1]) * sbv[0][1] * sar; u0 = dq4(acc[ai][1][m][0]) * sbv[1][0] * sar; u1 = dq4(acc[ai][1][m][1]) * sbv[1][1] * sar; }
                else { g0 = acc[ai][0][m][0]; g1 = acc[ai][0][m][1]; u0 = acc[ai][1][m][0]; u1 = acc[ai][1][m][1]; }
                float h[8];
#pragma unroll
                for (int i = 0; i < 4; ++i) { h[i] = silu_f(g0[i]) * u0[i]; h[4 + i] = silu_f(g1[i]) * u1[i]; }
                if constexpr (OUT8) { unsigned char* rp8 = (unsigned char*)O + (size_t)(row0 + ai * HALF + m * 16) * ldc + col0;
                    typedef unsigned u32x2_t __attribute__((ext_vector_type(2))); u32x2_t w8;
#pragma unroll
                    for (int i = 0; i < 8; ++i) h[i] = fminf(fmaxf(h[i] * out_scale, -448.f), 448.f);
                    int w0 = __builtin_amdgcn_cvt_pk_fp8_f32(h[0], h[1], 0, false); w0 = __builtin_amdgcn_cvt_pk_fp8_f32(h[2], h[3], w0, true);
                    int w1 = __builtin_amdgcn_cvt_pk_fp8_f32(h[4], h[5], 0, false); w1 = __builtin_amdgcn_cvt_pk_fp8_f32(h[6], h[7], w1, true);
                    w8.x = (unsigned)w0; w8.y = (unsigned)w1; *(u32x2_t*)rp8 = w8; }
                else { u32x4 w; w.x = cvt_pk_bf16(h[0], h[1]); w.y = cvt_pk_bf16(h[2], h[3]); w.z = cvt_pk_bf16(h[4], h[5]); w.w = cvt_pk_bf16(h[6], h[7]);
                    *(u32x4*)rowp = w; } }
    }
};
typedef EpiSwigluT<false, false> EpiSwiglu;
struct MoeOrder {
    int pt1, pt2, pt3, pt4, pt5, pt6, pt7, pt8; int NT, G, c, nwg;
    __device__ __forceinline__ void init(const unsigned* cnt, int NT_, int G_, int c_) {
        NT = NT_; G = G_; c = c_;
        pt1 = (int)((cnt[0] + 255u) >> 8); pt2 = pt1 + (int)((cnt[1] + 255u) >> 8); pt3 = pt2 + (int)((cnt[2] + 255u) >> 8); pt4 = pt3 + (int)((cnt[3] + 255u) >> 8);
        pt5 = pt4 + (int)((cnt[4] + 255u) >> 8); pt6 = pt5 + (int)((cnt[5] + 255u) >> 8); pt7 = pt6 + (int)((cnt[6] + 255u) >> 8); pt8 = pt7 + (int)((cnt[7] + 255u) >> 8);
        nwg = pt8 * NT;
    }
    __device__ __forceinline__ bool next(int i, Unit& u) const {
        const long L = (long)i * G + c; if (L >= nwg) return false;
        int wgid = (int)L; { const int q = nwg / NXCD, r = nwg % NXCD, xcd = wgid % NXCD, off = wgid / NXCD; wgid = (xcd < r ? xcd * (q + 1) : r * (q + 1) + (xcd - r) * q) + off; }
        int e = 0, lo = 0, hi = pt1;
        if (wgid >= pt1 * NT) { e = 1; lo = pt1; hi = pt2; }
        if (wgid >= pt2 * NT) { e = 2; lo = pt2; hi = pt3; }
        if (wgid >= pt3 * NT) { e = 3; lo = pt3; hi = pt4; }
        if (wgid >= pt4 * NT) { e = 4; lo = pt4; hi = pt5; }
        if (wgid >= pt5 * NT) { e = 5; lo = pt5; hi = pt6; }
        if (wgid >= pt6 * NT) { e = 6; lo = pt6; hi = pt7; }
        if (wgid >= pt7 * NT) { e = 7; lo = pt7; hi = pt8; }
        const int j = wgid - lo * NT, nM = hi - lo;
        const int nig = WGM * NT, gid = j / nig, fm = gid * WGM, gsz = (nM - fm) < WGM ? (nM - fm) : WGM;
        u.pm = lo + fm + ((j % nig) % gsz); u.pn = e * NT + (j % nig) / gsz; return true;
    }
    __device__ __forceinline__ void a_ready(const Unit&) const {}
    __device__ __forceinline__ void done(const Unit&) const {}
};
}
#include <hip/hip_bf16.h>
#include <cmath>
namespace attn_body {
using bf16=__hip_bfloat16;
using bf16x8=__attribute__((ext_vector_type(8)))short;
using s16x4=__attribute__((ext_vector_type(4)))short;
using f32x16=__attribute__((ext_vector_type(16)))float;
using u32x4=__attribute__((ext_vector_type(4)))unsigned;
constexpr int BATCH=4,SEQ=8192,D=64,DMQ=64,DMO=1024;
constexpr int NW=8,QBLK=32,QB=QBLK*NW,KVBLK=64,NQB=SEQ/QB;
constexpr int ATTN_UNIT_ROWS=QB;
__device__ __forceinline__ int crow(int r,int hi){return (r&3)+8*(r>>2)+4*hi;}
#define SBAR() __builtin_amdgcn_sched_barrier(0)
__device__ __forceinline__ void cmask(f32x16&p0,f32x16&p1,int jb,int qrel,int hi){
  const float NEG=-INFINITY; int kb=64*jb+4*hi;
  #pragma unroll
  for(int r=0;r<16;++r){int kv=kb+(r&3)+8*(r>>2); if(kv>qrel)p0[r]=NEG; if(kv+32>qrel)p1[r]=NEG;}
}

typedef const __attribute__((address_space(3))) float* lds_cfptr;
typedef float f32x4a __attribute__((ext_vector_type(4)));
__device__ __forceinline__ void bmask(f32x16&p0,f32x16&p1,int jb,int qrel,int hi,lds_cfptr tabR){
  int j0=383-(qrel-64*jb-4*hi); j0=j0>452?452:j0; const lds_cfptr tp=tabR+512*(j0&3)+(j0&~3);
  #pragma unroll
  for(int g=0;g<4;++g){ const f32x4a a=*(const __attribute__((address_space(3))) f32x4a*)(tp+8*g), b=*(const __attribute__((address_space(3))) f32x4a*)(tp+32+8*g);
    #pragma unroll
    for(int i=0;i<4;++i){ p0[4*g+i]+=a[i]; p1[4*g+i]+=b[i]; } }
  if(jb>=0)cmask(p0,p1,jb,qrel,hi);
}
constexpr int NSLOT=3, SLOTB=8192;
constexpr int VSLOTB=2*SLOTB;
constexpr int LDS_K=0, LDS_V=NSLOT*SLOTB, LDS_WS=LDS_V+NSLOT*VSLOTB, LDS_OST=LDS_WS+NW*64*4, LDS_BYTES=LDS_OST+NW*4096;
constexpr float C2=0.125f*1.4426950408889634f;
__device__ __forceinline__ void glds16(const void*gsrc,unsigned lds_dst){unsigned keep;
  asm volatile("s_mov_b32 %0, m0\n\ts_mov_b32 m0, %2\n\ts_nop 0\n\tglobal_load_lds_dwordx4 %1, off\n\ts_mov_b32 m0, %0":"=&s"(keep):"v"(gsrc),"s"(lds_dst):"memory");}
__device__ __forceinline__ float max3f(float a,float b,float c){float r;asm("v_max3_f32 %0, %1, %2, %3":"=v"(r):"v"(a),"v"(b),"v"(c));return r;}
__device__ __forceinline__ float max2f(float a,float b){float r;asm("v_max_f32_e32 %0, %1, %2":"=v"(r):"v"(a),"v"(b));return r;}
__device__ __forceinline__ float fadd_s(float a,float b){float r;asm("v_add_f32_e32 %0, %1, %2":"=v"(r):"v"(a),"v"(b));return r;}
__device__ __forceinline__ float fsub_s(float a,float b){float r;asm("v_sub_f32_e32 %0, %1, %2":"=v"(r):"v"(a),"v"(b));return r;}
typedef float f32x2_t __attribute__((ext_vector_type(2))); typedef __bf16 bf16x2_t __attribute__((ext_vector_type(2)));
__device__ __forceinline__ unsigned cvtpk_s(float lo,float hi){f32x2_t v={lo,hi};bf16x2_t b=__builtin_convertvector(v,bf16x2_t);return __builtin_bit_cast(unsigned,b);}
#define WAIT_BAR(N) asm volatile("s_waitcnt vmcnt(" #N ") lgkmcnt(0)\n\ts_barrier":::"memory")

__device__ __forceinline__ void qkt(f32x16&p0,f32x16&p1,const char*Kslot,const bf16x8*qr,const f32x16&negm,int r32,int hi){
  const char*kb=Kslot+hi*1024+r32*16;
  #pragma unroll
  for(int d0=0;d0<4;++d0){
    const bf16x8 b0=*reinterpret_cast<const bf16x8*>(kb+d0*2048);
    const bf16x8 b1=*reinterpret_cast<const bf16x8*>(kb+d0*2048+512);
    if(d0==0){p0=__builtin_amdgcn_mfma_f32_32x32x16_bf16(b0,qr[0],negm,0,0,0);p1=__builtin_amdgcn_mfma_f32_32x32x16_bf16(b1,qr[0],negm,0,0,0);}
    else{p0=__builtin_amdgcn_mfma_f32_32x32x16_bf16(b0,qr[d0],p0,0,0,0);p1=__builtin_amdgcn_mfma_f32_32x32x16_bf16(b1,qr[d0],p1,0,0,0);}}
}
typedef __attribute__((address_space(3))) const char* lds_cptr;
typedef short v4i16_t __attribute__((ext_vector_type(4)));
__device__ __forceinline__ void kload8(bf16x8*kf,lds_cptr kp){
  kf[0]=*(const __attribute__((address_space(3))) bf16x8*)(kp);      kf[1]=*(const __attribute__((address_space(3))) bf16x8*)(kp+512);
  kf[2]=*(const __attribute__((address_space(3))) bf16x8*)(kp+2048); kf[3]=*(const __attribute__((address_space(3))) bf16x8*)(kp+2560);
  kf[4]=*(const __attribute__((address_space(3))) bf16x8*)(kp+4096); kf[5]=*(const __attribute__((address_space(3))) bf16x8*)(kp+4608);
  kf[6]=*(const __attribute__((address_space(3))) bf16x8*)(kp+6144); kf[7]=*(const __attribute__((address_space(3))) bf16x8*)(kp+6656);
}
__device__ __forceinline__ void kload2(bf16x8*kf,lds_cptr kp,int j){ kf[2*j]=*(const __attribute__((address_space(3))) bf16x8*)(kp+j*2048); kf[2*j+1]=*(const __attribute__((address_space(3))) bf16x8*)(kp+j*2048+512); }
__device__ __forceinline__ s16x4 vtr(lds_cptr p){ return __builtin_bit_cast(s16x4,__builtin_amdgcn_ds_read_tr16_b64_v4i16((__attribute__((address_space(3))) v4i16_t*)p)); }
__device__ __forceinline__ float rowmax(const f32x16&p0,const f32x16&p1){
  float a=max3f(p0[0],p0[1],p1[0]),b=max3f(p0[2],p0[3],p1[1]);a=max3f(a,p1[2],p1[3]);
  #pragma unroll
  for(int r=4;r<16;r+=4){a=max3f(a,p0[r],p0[r+1]);b=max3f(b,p0[r+2],p0[r+3]);a=max3f(a,p1[r],p1[r+1]);b=max3f(b,p1[r+2],p1[r+3]);}
  const float m=max2f(a,b);
  auto rr=__builtin_amdgcn_permlane32_swap(__float_as_uint(m),__float_as_uint(m),false,false);
  return max2f(__uint_as_float(rr[0]),__uint_as_float(rr[1]));
}
__device__ __forceinline__ void pv(f32x16*o,int vb,bf16x8 pa0,bf16x8 pa1,bf16x8 pa2,bf16x8 pa3){
  #pragma unroll
  for(int d0=0;d0<4;++d0){s16x4 lo[4],hi[4];
    #pragma unroll
    for(int ks=0;ks<4;++ks){
      asm volatile("ds_read_b64_tr_b16 %0,%1 offset:%c2":"=&v"(lo[ks]):"v"(vb),"i"(d0*4096+ks*1024):"memory");
      asm volatile("ds_read_b64_tr_b16 %0,%1 offset:%c2":"=&v"(hi[ks]):"v"(vb),"i"(d0*4096+ks*1024+512):"memory");}
    asm volatile("s_waitcnt lgkmcnt(0)":::"memory");SBAR();
    #define PK(k) (bf16x8){lo[k][0],lo[k][1],lo[k][2],lo[k][3],hi[k][0],hi[k][1],hi[k][2],hi[k][3]}
    o[d0]=__builtin_amdgcn_mfma_f32_32x32x16_bf16(pa0,PK(0),o[d0],0,0,0);
    o[d0]=__builtin_amdgcn_mfma_f32_32x32x16_bf16(pa1,PK(1),o[d0],0,0,0);
    o[d0]=__builtin_amdgcn_mfma_f32_32x32x16_bf16(pa2,PK(2),o[d0],0,0,0);
    o[d0]=__builtin_amdgcn_mfma_f32_32x32x16_bf16(pa3,PK(3),o[d0],0,0,0);
    #undef PK
  }
}

#ifndef ATTN_STORE16
#define ATTN_STORE16(p,v) (*(u32x4*)(p)=(v))
#endif
template<int THRL> __device__ __forceinline__ void attn_unit(int b,const bf16*__restrict__ QHh  ,const bf16*__restrict__ KTh  ,const bf16*__restrict__ VTh  ,int ocol,int qb,bf16*O,char*shm,lds_cfptr tabR,const int tid_in,const bf16*nKT  ,const bf16*nVT,const bool pre  ){
  int tid_=tid_in; asm volatile("":"+v"(tid_)); const int tid=tid_,lane=tid&63,r32=lane&31,hi=lane>>5; const int wid=__builtin_amdgcn_readfirstlane(tid>>6);
  const long rowbase=(long)b*SEQ; const int q0=qb*QB;
  const bf16*Qw=QHh+(rowbase+q0+wid*QBLK)*DMQ;
  const bf16*Kh=KTh+(rowbase>>6)*4096,*Vh=VTh+(rowbase>>6)*8192;
  const unsigned lds0=(unsigned)(uintptr_t)shm;
  float*wsf=(float*)(shm+LDS_WS)+wid*64;
  const bf16*ksrc=Kh+wid*512+lane*8;
  const bf16*vsrc=Vh+wid*512+lane*8;
  const unsigned kdst=lds0+LDS_K+wid*1024, vdst=lds0+LDS_V+wid*1024;
  #define DMA_K(t,slot) glds16(ksrc+(long)(t)*4096,(unsigned)__builtin_amdgcn_readfirstlane(kdst+(slot)))
  #define DMA_V(t,slot) do{ glds16(vsrc+(long)(t)*8192,(unsigned)__builtin_amdgcn_readfirstlane(vdst+2*(slot))); glds16(vsrc+4096+(long)(t)*8192,(unsigned)__builtin_amdgcn_readfirstlane(vdst+2*(slot)+8192)); }while(0)
  const int vb0=(int)(lds0+LDS_V)+((lane>>4)&1)*32+(lane&3)*8+(4*hi+((lane&15)>>2))*64;
  const char*Kbase=shm+LDS_K; bf16x8 kf[8];
  const lds_cptr shm3=(lds_cptr)shm; const lds_cptr kp0=shm3+LDS_K+hi*1024+r32*16; const lds_cptr vp0=shm3+LDS_V+((lane>>4)&1)*32+(lane&3)*8+(4*hi+((lane&15)>>2))*64;
  const int NT=(q0+QB)/KVBLK;
  if(!pre){DMA_K(0,0);DMA_V(0,0);DMA_K(1,SLOTB);}
  bf16x8 qr[4];
  #pragma unroll
  for(int d0=0;d0<4;++d0)qr[d0]=*reinterpret_cast<const bf16x8*>(&Qw[(long)r32*DMQ+d0*16+hi*8]);
  float mhat=0.f,l_reg=0.f;f32x16 o[4];o[0]=f32x16{};o[1]=f32x16{};o[2]=f32x16{};o[3]=f32x16{};const f32x16 negm=f32x16{};
  const int qrel=wid*QBLK+r32;
  #define CMASK(P0,P1,t) do{int jb_=(t)-(NT-4); if(jb_>=-2)bmask(P0,P1,jb_,qrel,hi,tabR);}while(0)
  bool resc=false;
  #define START(P0,P1) do{ const float rm=rowmax(P0,P1); resc=false; \
    { const float dl=rm; mhat=fadd_s(mhat,dl); \
      _Pragma("unroll") for(int r=0;r<16;++r){P0[r]=fsub_s(P0[r],dl);P1[r]=fsub_s(P1[r],dl);} \
      } \
    _Pragma("unroll") for(int r=0;r<16;++r)P0[r]=__builtin_amdgcn_exp2f(P0[r]); }while(0)
  #define RESC() do{ if(resc){ asm volatile("s_waitcnt lgkmcnt(0)":::"memory"); \
      _Pragma("unroll") for(int d_=0;d_<4;++d_) _Pragma("unroll") for(int r=0;r<16;++r)o[d_][r]*=wsf[crow(r,hi)]; } }while(0)
  f32x16 pA0,pA1,pB0,pB1;
  int sl_prev=0,sl_cur=0,sl_next=SLOTB;
  #define ROT() do{sl_prev=sl_cur;sl_cur=sl_next;sl_next=(sl_next==(NSLOT-1)*SLOTB)?0:sl_next+SLOTB;}while(0)
  if(!pre)DMA_K(2,2*SLOTB);
  WAIT_BAR(4);
  qkt(pA0,pA1,Kbase,qr,negm,r32,hi);asm volatile("s_nop 15\n\ts_nop 7":"+v"(pA0),"+v"(pA1));CMASK(pA0,pA1,0);
  START(pA0,pA1);
  _Pragma("unroll") for(int r=0;r<16;++r)pA1[r]=__builtin_amdgcn_exp2f(pA1[r]);
  WAIT_BAR(0);
  DMA_K(3,0);DMA_V(1,SLOTB);
  ROT();
  kload8(kf,kp0+sl_cur);
  WAIT_BAR(3);
  s16x4 vlo[4],vhi[4]; u32x4 pw0,pw1,pw2,pw3;
  #define PKW(P,B) cvtpk_s(P[B],P[B+1])
  #define PAF(k) __builtin_bit_cast(bf16x8,pw##k)
  #define VFS(i) (bf16x8){vlo[i][0],vlo[i][1],vlo[i][2],vlo[i][3],vhi[i][0],vhi[i][1],vhi[i][2],vhi[i][3]}
  #define VRDF(st,f) do{ vlo[st]=vtr(vp_+(((f)>>2)*4096+((f)&3)*1024)); vhi[st]=vtr(vp_+(((f)>>2)*4096+((f)&3)*1024+512)); }while(0)
  #define PIN(x) asm volatile("":"+v"(x))
  #define MX3(a,b,c) __builtin_fmaxf(__builtin_fmaxf((a),(b)),(c))
  #define GAPA(MF,A0,A1,A2,A3,W0,W1,PW) do{ MF; sacc+=A0; sacc+=A1; sacc+=A2; sacc+=A3; PIN(sacc); W0; W1; PIN(PW); SBAR(); }while(0)
  #define EX(v) __builtin_amdgcn_exp2f(v)
  #define GAPB(MF,X,B) do{ MF; X[B]=EX(X[B]); X[B+1]=EX(X[B+1]); X[B+2]=EX(X[B+2]); X[B+3]=EX(X[B+3]); PIN(X); SBAR(); }while(0)
  #define VRD(i) do{ vlo[i]=vtr(vp_+(((i)>>2)*4096+((i)&3)*1024)); vhi[i]=vtr(vp_+(((i)>>2)*4096+((i)&3)*1024+512)); }while(0)
  #define VRD2(i) do{ vlo[i]=vtr(vp_+((((i)>>2)+2)*4096+((i)&3)*1024)); vhi[i]=vtr(vp_+((((i)>>2)+2)*4096+((i)&3)*1024+512)); }while(0)
  #define GAPB2(MF,X,B) do{ MF; X[B]=EX(X[B]-mhat); X[B+1]=EX(X[B+1]-mhat); PIN(X); SBAR(); }while(0)
  #define KRD(G,j) do{ if(G){ kload2(kf,kp0+sl_next,j); SBAR(); } }while(0)
  #define STEP(C0,C1,P0,P1,t,GK,GV,GL) do{ SBAR(); \
    const lds_cptr vp_=vp0+2*sl_prev; \
    float sacc=(P0[0]+P0[1]); \
    GAPA(C0=__builtin_amdgcn_mfma_f32_32x32x16_bf16(kf[0],qr[0],negm,0,0,0), P0[2],P0[3],P0[4],P0[5],     pw0[0]=PKW(P0,0), pw0[1]=PKW(P0,2), pw0); \
    GAPA(C1=__builtin_amdgcn_mfma_f32_32x32x16_bf16(kf[1],qr[0],negm,0,0,0), P0[6],P0[7],P0[8],P0[9],     pw0[2]=PKW(P0,4), pw0[3]=PKW(P0,6), pw0); \
    GAPA(C0=__builtin_amdgcn_mfma_f32_32x32x16_bf16(kf[2],qr[1],C0,0,0,0),   P0[10],P0[11],P0[12],P0[13], pw1[0]=PKW(P0,8), pw1[1]=PKW(P0,10), pw1); \
    GAPA(C1=__builtin_amdgcn_mfma_f32_32x32x16_bf16(kf[3],qr[1],C1,0,0,0),   P0[14],P0[15],P1[0],P1[1],   pw1[2]=PKW(P0,12),pw1[3]=PKW(P0,14), pw1); \
    VRDF(0,0); SBAR(); GAPA(C0=__builtin_amdgcn_mfma_f32_32x32x16_bf16(kf[4],qr[2],C0,0,0,0),   P1[2],P1[3],P1[4],P1[5],     pw2[0]=PKW(P1,0), pw2[1]=PKW(P1,2), pw2); \
    VRDF(1,4); SBAR(); GAPA(C1=__builtin_amdgcn_mfma_f32_32x32x16_bf16(kf[5],qr[2],C1,0,0,0),   P1[6],P1[7],P1[8],P1[9],     pw2[2]=PKW(P1,4), pw2[3]=PKW(P1,6), pw2); \
    VRDF(2,1); SBAR(); GAPA(C0=__builtin_amdgcn_mfma_f32_32x32x16_bf16(kf[6],qr[3],C0,0,0,0),   P1[10],P1[11],P1[12],P1[13], pw3[0]=PKW(P1,8), pw3[1]=PKW(P1,10), pw3); \
    VRDF(3,5); SBAR(); GAPA(C1=__builtin_amdgcn_mfma_f32_32x32x16_bf16(kf[7],qr[3],C1,0,0,0),   P1[14],P1[15],0.f,0.f,       pw3[2]=PKW(P1,12),pw3[3]=PKW(P1,14), pw3); \
    l_reg+=sacc; \
    if(GK){DMA_K((t)+3,sl_cur);} if(GV){DMA_V((t)+1,sl_next);} \
    CMASK(C0,C1,t); \
    { float a=MX3(C0[0],C0[1],C1[0]),b=MX3(C0[2],C0[3],C1[1]); a=MX3(a,C1[2],C1[3]); \
      _Pragma("unroll") for(int r=4;r<16;r+=4){a=MX3(a,C0[r],C0[r+1]);b=MX3(b,C0[r+2],C0[r+3]);a=MX3(a,C1[r],C1[r+1]);b=MX3(b,C1[r+2],C1[r+3]);} \
      float rm=__builtin_fmaxf(a,b); { auto rr=__builtin_amdgcn_permlane32_swap(__float_as_uint(rm),__float_as_uint(rm),false,false); rm=__builtin_fmaxf(__uint_as_float(rr[0]),__uint_as_float(rr[1])); } rm-=mhat;   \
      resc=false; \
      if(__builtin_expect(__any(rm>(float)THRL),0)){ const float dl=__builtin_fmaxf(rm,0.f); mhat+=dl; \
        const float f=__builtin_amdgcn_exp2f(-dl); l_reg*=f; if(hi==0)wsf[r32]=f; resc=true; } } \
    SBAR(); \
    GAPB2(o[0]=__builtin_amdgcn_mfma_f32_32x32x16_bf16(PAF(0),VFS(0),o[0],0,0,0), C0,0); VRDF(0,2); SBAR(); \
    GAPB2(o[1]=__builtin_amdgcn_mfma_f32_32x32x16_bf16(PAF(0),VFS(1),o[1],0,0,0), C0,2); VRDF(1,6); SBAR(); \
    GAPB2(o[0]=__builtin_amdgcn_mfma_f32_32x32x16_bf16(PAF(1),VFS(2),o[0],0,0,0), C0,4); VRDF(2,3); SBAR(); \
    GAPB2(o[1]=__builtin_amdgcn_mfma_f32_32x32x16_bf16(PAF(1),VFS(3),o[1],0,0,0), C0,6); VRDF(3,7); SBAR(); \
    GAPB2(o[0]=__builtin_amdgcn_mfma_f32_32x32x16_bf16(PAF(2),VFS(0),o[0],0,0,0), C0,8); VRDF(0,8); SBAR(); \
    GAPB2(o[1]=__builtin_amdgcn_mfma_f32_32x32x16_bf16(PAF(2),VFS(1),o[1],0,0,0), C0,10); VRDF(1,12); SBAR(); \
    GAPB2(o[0]=__builtin_amdgcn_mfma_f32_32x32x16_bf16(PAF(3),VFS(2),o[0],0,0,0), C0,12); VRDF(2,9); SBAR(); \
    GAPB2(o[1]=__builtin_amdgcn_mfma_f32_32x32x16_bf16(PAF(3),VFS(3),o[1],0,0,0), C0,14); VRDF(3,13); SBAR(); \
    GAPB2(o[2]=__builtin_amdgcn_mfma_f32_32x32x16_bf16(PAF(0),VFS(0),o[2],0,0,0), C1,0); VRDF(0,10); SBAR(); \
    GAPB2(o[3]=__builtin_amdgcn_mfma_f32_32x32x16_bf16(PAF(0),VFS(1),o[3],0,0,0), C1,2); VRDF(1,14); SBAR(); \
    GAPB2(o[2]=__builtin_amdgcn_mfma_f32_32x32x16_bf16(PAF(1),VFS(2),o[2],0,0,0), C1,4); VRDF(2,11); SBAR(); \
    GAPB2(o[3]=__builtin_amdgcn_mfma_f32_32x32x16_bf16(PAF(1),VFS(3),o[3],0,0,0), C1,6); VRDF(3,15); SBAR(); \
    KRD(GL,0); GAPB2(o[2]=__builtin_amdgcn_mfma_f32_32x32x16_bf16(PAF(2),VFS(0),o[2],0,0,0), C1,8); \
    KRD(GL,1); GAPB2(o[3]=__builtin_amdgcn_mfma_f32_32x32x16_bf16(PAF(2),VFS(1),o[3],0,0,0), C1,10); \
    KRD(GL,2); GAPB2(o[2]=__builtin_amdgcn_mfma_f32_32x32x16_bf16(PAF(3),VFS(2),o[2],0,0,0), C1,12); \
    KRD(GL,3); GAPB2(o[3]=__builtin_amdgcn_mfma_f32_32x32x16_bf16(PAF(3),VFS(3),o[3],0,0,0), C1,14); \
    }while(0)
  int t=1;
  #undef CMASK
  #define CMASK(P0,P1,t) do{}while(0)
  for(;t+7<NT;t+=2){
    STEP(pB0,pB1,pA0,pA1,t,true,true,true);     WAIT_BAR(3); RESC(); ROT();
    STEP(pA0,pA1,pB0,pB1,t+1,true,true,true);   WAIT_BAR(3); RESC(); ROT();
  }
  #undef CMASK
  #define CMASK(P0,P1,t) do{int jb_=(t)-(NT-4); if(jb_>=-2)bmask(P0,P1,jb_,qrel,hi,tabR);}while(0)
  #define ENDW(tt) do{ if((tt)+3<NT){WAIT_BAR(3);} else if((tt)+2<NT){WAIT_BAR(2);} else {WAIT_BAR(0);} }while(0)
  for(;t+1<NT;t+=2){
    STEP(pB0,pB1,pA0,pA1,t,(t+3<NT),(t+1<NT),(t+1<NT));       ENDW(t);   RESC(); ROT();
    STEP(pA0,pA1,pB0,pB1,t+1,(t+4<NT),(t+2<NT),(t+2<NT));     ENDW(t+1); RESC(); ROT();
  }
  STEP(pB0,pB1,pA0,pA1,NT-1,false,false,false); RESC();
  { float sacc=pB0[0]+pB0[1]; _Pragma("unroll") for(int r=2;r<16;++r)sacc+=pB0[r]; _Pragma("unroll") for(int r=0;r<16;++r)sacc+=pB1[r]; l_reg+=sacc;
    pw0=(u32x4){PKW(pB0,0),PKW(pB0,2),PKW(pB0,4),PKW(pB0,6)};pw1=(u32x4){PKW(pB0,8),PKW(pB0,10),PKW(pB0,12),PKW(pB0,14)};pw2=(u32x4){PKW(pB1,0),PKW(pB1,2),PKW(pB1,4),PKW(pB1,6)};pw3=(u32x4){PKW(pB1,8),PKW(pB1,10),PKW(pB1,12),PKW(pB1,14)};
    SBAR(); pv(o,vb0+2*sl_cur,PAF(0),PAF(1),PAF(2),PAF(3)); }
  asm volatile("s_waitcnt lgkmcnt(0)\n\ts_barrier":::"memory");
  if(nKT){ const bf16*nk_=nKT+(rowbase>>6)*4096+wid*512+lane*8; const bf16*nv_=nVT+(rowbase>>6)*8192+wid*512+lane*8;
    glds16(nk_,(unsigned)__builtin_amdgcn_readfirstlane(kdst)); glds16(nv_,(unsigned)__builtin_amdgcn_readfirstlane(vdst)); glds16(nv_+4096,(unsigned)__builtin_amdgcn_readfirstlane(vdst+8192));
    glds16(nk_+4096,(unsigned)__builtin_amdgcn_readfirstlane(kdst+SLOTB)); glds16(nk_+2*4096,(unsigned)__builtin_amdgcn_readfirstlane(kdst+2*SLOTB)); }
  #undef PKW
  #undef PAF
  #undef VFS
  #undef VRDF
  #undef PIN
  #undef MX3
  #undef GAPA
  #undef GAPB
  #undef EX
  #undef VRD
  #undef VRD2
  #undef GAPB2
  #undef KRD
  #undef STEP
  #undef ENDW
  {auto rr=__builtin_amdgcn_permlane32_swap(__float_as_uint(l_reg),__float_as_uint(l_reg),false,false);l_reg=__uint_as_float(rr[0])+__uint_as_float(rr[1]);}
  if(hi==0)wsf[32+r32]=l_reg;asm volatile("s_waitcnt lgkmcnt(0)":::"memory");
  float rli[16];
  { const lds_cfptr wl_=(lds_cfptr)(shm3+LDS_WS)+wid*64+32+4*hi;
    #pragma unroll
    for(int g=0;g<4;++g){ const f32x4a v_=*(const __attribute__((address_space(3))) f32x4a*)(wl_+8*g);
      #pragma unroll
      for(int i=0;i<4;++i)rli[4*g+i]=__builtin_amdgcn_rcpf(v_[i]); } }
  bf16*Ow=O+(rowbase+q0+wid*QBLK)*DMO+ocol;
  { bf16*stg=(bf16*)(shm+LDS_OST)+wid*2048;
    #pragma unroll
    for(int hf=0;hf<2;++hf){
      #pragma unroll
      for(int r=0;r<16;++r){const int orow=crow(r,hi);
        #pragma unroll
        for(int d0=0;d0<2;++d0)stg[orow*64+d0*32+r32]=__float2bfloat16(o[2*hf+d0][r]*rli[r]);}
      asm volatile("s_waitcnt lgkmcnt(0)":::"memory");
      #pragma unroll
      for(int i=0;i<4;++i){const int row=i*8+(lane>>3),ch=lane&7; const u32x4 v=*(const u32x4*)(stg+row*64+ch*8); ATTN_STORE16(Ow+(long)row*DMO+hf*64+ch*8,v);}
      asm volatile("s_waitcnt lgkmcnt(0)":::"memory"); } }
  asm volatile("s_waitcnt lgkmcnt(0)":::"memory");
  #undef DMA_K
  #undef DMA_V
  #undef CMASK
  #undef START
  #undef RESC
  #undef ROT
}
constexpr int ATTN_LDS_BYTES=LDS_BYTES;
#undef SBAR
#undef WAIT_BAR
}
#define GAS __attribute__((address_space(1)))
#define LAS __attribute__((address_space(3)))
typedef unsigned short bf16;
typedef unsigned v4u __attribute__((ext_vector_type(4)));
typedef float f32x4 __attribute__((ext_vector_type(4)));
typedef short bf16x8 __attribute__((ext_vector_type(8)));
typedef GAS unsigned gu32;
typedef GAS unsigned long long gu64;
#define RLX_AGENT __ATOMIC_RELAXED, __HIP_MEMORY_SCOPE_AGENT
#define LDS_WAIT() asm volatile("s_waitcnt lgkmcnt(0)" ::: "memory")
#define VM_WAIT() asm volatile("s_waitcnt vmcnt(0)" ::: "memory")
__device__ __forceinline__ unsigned long long rt() { return __builtin_amdgcn_s_memrealtime(); }
__device__ __forceinline__ unsigned f2bf(float f) { unsigned u = __builtin_bit_cast(unsigned, f); return (u + 0x7fffu + ((u >> 16) & 1u)) >> 16; }
typedef float pk_f32x2_t __attribute__((ext_vector_type(2))); typedef __bf16 pk_bf16x2_t __attribute__((ext_vector_type(2)));
__device__ __forceinline__ unsigned pk2(float lo, float hi) { pk_f32x2_t v = {lo, hi}; pk_bf16x2_t b = __builtin_convertvector(v, pk_bf16x2_t); return __builtin_bit_cast(unsigned, b); }

#define XB_TMO      128
#define XB_XCNT(j)  (256  + 64 * (j))
#define XB_XSUB(j)  (1280 + 64 * (j))
#define XB_XGEN(j)  (2304 + 64 * (j))
#define XB_TOP      3328
#define XB_TOPGEN   3392
#define XCD_BAR_WORDS 3456
#define XB_SPIN_CAP (1u << 18)

__device__ __forceinline__ unsigned xb_ld(unsigned* p)              { return __hip_atomic_load(p, __ATOMIC_RELAXED, __HIP_MEMORY_SCOPE_AGENT); }
__device__ __forceinline__ unsigned xb_add(unsigned* p, unsigned v) { return __hip_atomic_fetch_add(p, v, __ATOMIC_RELAXED, __HIP_MEMORY_SCOPE_AGENT); }
__device__ __forceinline__ unsigned xb_xcc_id() { return (unsigned)__builtin_amdgcn_s_getreg((3 << 11) | 20) & 0xFu; }
#define XB_SPIN(cond, bar) do { unsigned _sp = 0; while (cond) { __builtin_amdgcn_s_sleep(1); \
    if ((++_sp & 255u) == 0u) { if (xb_ld(&(bar)[XB_TMO])) break; if (_sp > XB_SPIN_CAP) { atomicAdd(&(bar)[XB_TMO], 1u); break; } } } } while (0)

struct XcdBarrier {
    unsigned* bar; unsigned x;
    volatile LAS unsigned* st;
};

__device__ __forceinline__ XcdBarrier xcd_barrier_post(unsigned* bar, volatile LAS unsigned* st, const int tid) {
    XcdBarrier b; b.bar = bar; b.x = xb_xcc_id(); b.st = st;
    if (tid == 0) (void)xb_add(&bar[XB_XCNT(b.x)], 1u);
    return b;
}
__device__ __forceinline__ void xcd_barrier_complete(unsigned* bar, unsigned x, unsigned& nloc, unsigned& nx) {
    const unsigned G = gridDim.x * gridDim.y * gridDim.z;
    unsigned sum, cnt, mine, sp = 0u;
    for (;;) {
        sum = 0u; cnt = 0u; mine = 0u;
#pragma unroll
        for (unsigned j = 0; j < 16; ++j) { const unsigned c = xb_ld(&bar[XB_XCNT(j)]); sum += c; cnt += (c > 0u) ? 1u : 0u; mine = (j == x) ? c : mine; }
        if (sum == G) break;
        __builtin_amdgcn_s_sleep(1);
        if ((++sp & 255u) == 0u) { if (xb_ld(&bar[XB_TMO])) break; if (sp > XB_SPIN_CAP) { atomicAdd(&bar[XB_TMO], 1u); break; } }
    }
    nloc = mine > 0u ? mine : 1u; nx = cnt > 0u ? cnt : 1u;
}

__device__ __forceinline__ void xcd_barrier(const XcdBarrier& b, const int tid) {
    asm volatile("s_waitcnt vmcnt(0)" ::: "memory");
    __syncthreads();
    if (tid == 0) {
        unsigned* bar = b.bar;
        __builtin_amdgcn_s_waitcnt(0);
        unsigned nloc = b.st[0], nx = b.st[1];
        if (nloc == 0u) { xcd_barrier_complete(bar, b.x, nloc, nx); b.st[0] = nloc; b.st[1] = nx; }
        const unsigned old = xb_add(&bar[XB_XSUB(b.x)], 1u);
        const unsigned gen = old / nloc;
        if (old + 1u == (gen + 1u) * nloc) {
            __builtin_amdgcn_fence(__ATOMIC_RELEASE, "agent");
            asm volatile("s_waitcnt vmcnt(0)" ::: "memory");
            const unsigned og = xb_add(&bar[XB_TOP], 1u);
            const unsigned tg = og / nx;
            if (og + 1u == (tg + 1u) * nx) xb_add(&bar[XB_TOPGEN], 1u);
            else XB_SPIN(xb_ld(&bar[XB_TOPGEN]) == tg, bar);
            __builtin_amdgcn_fence(__ATOMIC_ACQUIRE, "agent");
            xb_add(&bar[XB_XGEN(b.x)], 1u);
            asm volatile("s_waitcnt vmcnt(0)" ::: "memory");
        } else {
            XB_SPIN(xb_ld(&bar[XB_XGEN(b.x)]) == gen, bar);
            __builtin_amdgcn_fence(__ATOMIC_ACQUIRE, "agent");
            asm volatile("s_waitcnt vmcnt(0)" ::: "memory");
        }
    }
    __syncthreads();
}
constexpr int NWAVES = 8;
#ifndef MK_ONE_LAUNCH
#define MK_ONE_LAUNCH 1
#endif
constexpr int NB = 4, SEQ = 8192, DM = 1024, M = NB * SEQ, DEPTH = 4;
constexpr int NPROJ = 3584, INW = 3592, DFF = 3584, NUP = 2 * DFF, NEXP = 8;
constexpr int PJ_AQ = 0, PJ_AK = 512, PJ_AV = 1024, PJ_MQ = 1536, PJ_MK = 2048, PJ_MV = 2560, PJ_MO = 3072;
constexpr float EPS = 1e-6f;
constexpr size_t PJB = (size_t)NB * SEQ * 512;
constexpr int MPAD = 2 * M + NEXP * 256;
constexpr int NCH = SEQ / 64;
constexpr int NPH = 10;
constexpr int PH_TOTAL = 2 + DEPTH * NPH;

constexpr size_t MiB = 1u << 20;
constexpr size_t WS_CTL = 0, CTL_ZERO_BYTES = 1 * MiB;
constexpr size_t WS_MOD = 1 * MiB;
constexpr size_t WS_GATE = 2 * MiB;
constexpr size_t WS_BL = 3 * MiB;
constexpr size_t WS_UN = 4 * MiB;
constexpr size_t WS_NP = 5 * MiB;
constexpr size_t WS_TOK = 6 * MiB;
constexpr size_t WS_ROWIDX = 7 * MiB;
constexpr size_t WS_SA = 8 * MiB;
constexpr size_t WS_SB = 9 * MiB;
constexpr size_t WS_WIN = 16 * MiB;
constexpr size_t WS_WOUT = 44 * MiB;
constexpr size_t WS_WUP = 52 * MiB;
constexpr size_t WS_WDN = 80 * MiB;
constexpr size_t WS_WMUP = 94 * MiB;
constexpr size_t WS_WMDN = 206 * MiB;
constexpr size_t WS_H = 262 * MiB;
constexpr size_t WS_Y = 326 * MiB;
constexpr size_t WS_R = 458 * MiB;
constexpr size_t WS_X16 = 920 * MiB;
constexpr size_t WS_END = 984 * MiB;
static_assert(WS_Y + (size_t)MPAD * 1024 * 2 <= WS_R && WS_R + (size_t)MPAD * 3584 * 2 <= WS_END, "d_ws map");
constexpr int CW_TMO = 0, CW_CODE = 1, CW_BAR = 4096, CW_MOECNT = 8192;

constexpr int RING_OFF = 0, RING_BYTES = 131072;
constexpr int LDSCTL_OFF = RING_BYTES, MISC_OFF = LDSCTL_OFF + 320;
constexpr int BIAS_OFF = 132096;
constexpr int LDS_BYTES = 163840;
static_assert(MISC_OFF + 128 <= BIAS_OFF && BIAS_OFF + 8192 <= LDS_BYTES, "LDS map");

__device__ const int T5_BUCKET[128] = {0, 1, 2, 3, 4, 5, 6, 7, 8, 9, 10, 11, 12, 13, 14, 15, 16, 16, 16, 17, 17, 18, 18, 18, 19, 19, 19, 20, 20, 20, 20, 21, 21, 21, 21, 22, 22, 22, 22, 22, 23, 23, 23, 23, 23, 23, 24, 24, 24, 24, 24, 24, 25, 25, 25, 25, 25, 25, 25, 26, 26, 26, 26, 26, 26, 26, 26, 27, 27, 27, 27, 27, 27, 27, 27, 27, 27, 28, 28, 28, 28, 28, 28, 28, 28, 28, 28, 29, 29, 29, 29, 29, 29, 29, 29, 29, 29, 29, 29, 30, 30, 30, 30, 30, 30, 30, 30, 30, 30, 30, 30, 30, 30, 31, 31, 31, 31, 31, 31, 31, 31, 31, 31, 31, 31, 31, 31, 31};

typedef unsigned v2u __attribute__((ext_vector_type(2)));
typedef float v2f __attribute__((ext_vector_type(2)));
#ifndef PROBE_TIMER
#define PROBE_TIMER 0
#endif
#ifndef PROBE_SEL_A
#define PROBE_SEL_A 0
#endif
#ifndef PROBE_SEL_D
#define PROBE_SEL_D 0
#endif
#ifndef PROBE_US_PER_UNIT
#define PROBE_US_PER_UNIT 25.0f
#endif
constexpr float W8D_SCALE = 32.0f, H8_SCALE = 2.0f; constexpr int W8D_EXP = 127 - 3;
#ifndef PH_MASK
#define PH_MASK 0xFFFFFFu
#endif
#define PHM(b) ((PH_MASK >> (b)) & 1u)
struct Frame {
    LAS unsigned char* lds;
    volatile LAS unsigned* MISC;
    gu32* ctl;
    int tid, lane, wave, wave0, vcu, bx, G;
    unsigned char* ws;
    const __attribute__((address_space(4))) void* karg;
    float* out;
    __device__ __forceinline__ const float* in(int i) const { return (const float*)(const GAS float*)(((const float* const __attribute__((address_space(4)))*)karg)[i]); }
};
#define PHASE_BEGIN() do { unsigned o_ = ~0u; asm volatile("" : "+s"(o_)); int t_ = (int)__builtin_amdgcn_mbcnt_hi(o_, __builtin_amdgcn_mbcnt_lo(o_, 0u)) + 64 * F.wave0; asm volatile("" : "+v"(t_));   \
    F.tid = t_; F.lane = t_ & 63; F.wave = __builtin_amdgcn_readfirstlane(t_ >> 6); ws_ = (GAS unsigned char*)args.ws; asm volatile("" : "+s"(ws_)); F.ws = (unsigned char*)ws_; F.ctl = (gu32*)(ws_ + WS_CTL); \
    int b_ = blockIdx.x; asm volatile("" : "+s"(b_)); F.bx = b_; F.vcu = (F.G % 8 == 0) ? (b_ % 8) * (F.G / 8) + b_ / 8 : b_; \
    const __attribute__((address_space(4))) void* k_ = (const __attribute__((address_space(4))) void*)__builtin_amdgcn_kernarg_segment_ptr(); asm volatile("" : "+s"(k_)); F.karg = k_; } while (0)
__device__ __forceinline__ float lx_xor(float v, int o, int lane) { return __int_as_float(__builtin_amdgcn_ds_bpermute((lane ^ o) << 2, __float_as_int(v))); }
__device__ __forceinline__ float lx_up(float v, int o, int lane) { return __int_as_float(__builtin_amdgcn_ds_bpermute((lane - o) << 2, __float_as_int(v))); }
__device__ __forceinline__ float lx_get(float v, int src  ) { return __int_as_float(__builtin_amdgcn_readlane(__float_as_int(v), src)); }
__device__ __forceinline__ float wave_sum(float v, int lane) {
#pragma unroll
    for (int o = 1; o < 64; o <<= 1) v += lx_xor(v, o, lane);
    return v;
}
__device__ __forceinline__ float wave_sum_dpp(float v) {
    v += __int_as_float(__builtin_amdgcn_update_dpp(0, __float_as_int(v), 0xB1, 0xF, 0xF, true));
    v += __int_as_float(__builtin_amdgcn_update_dpp(0, __float_as_int(v), 0x4E, 0xF, 0xF, true));
    v += __int_as_float(__builtin_amdgcn_update_dpp(0, __float_as_int(v), 0x141, 0xF, 0xF, true));
    v += __int_as_float(__builtin_amdgcn_update_dpp(0, __float_as_int(v), 0x140, 0xF, 0xF, true));
    v += __int_as_float(__builtin_amdgcn_update_dpp(0, __float_as_int(v), 0x142, 0xA, 0xF, false));
    v += __int_as_float(__builtin_amdgcn_update_dpp(0, __float_as_int(v), 0x143, 0xC, 0xF, false));
    return __int_as_float(__builtin_amdgcn_readlane(__float_as_int(v), 63));
}
__device__ __forceinline__ float wave_max_dpp(float v) {
    v = fmaxf(v, __int_as_float(__builtin_amdgcn_update_dpp(0, __float_as_int(v), 0xB1, 0xF, 0xF, true)));
    v = fmaxf(v, __int_as_float(__builtin_amdgcn_update_dpp(0, __float_as_int(v), 0x4E, 0xF, 0xF, true)));
    v = fmaxf(v, __int_as_float(__builtin_amdgcn_update_dpp(0, __float_as_int(v), 0x141, 0xF, 0xF, true)));
    v = fmaxf(v, __int_as_float(__builtin_amdgcn_update_dpp(0, __float_as_int(v), 0x140, 0xF, 0xF, true)));
    v = fmaxf(v, __int_as_float(__builtin_amdgcn_update_dpp(0, __float_as_int(v), 0x142, 0xA, 0xF, false)));
    v = fmaxf(v, __int_as_float(__builtin_amdgcn_update_dpp(0, __float_as_int(v), 0x143, 0xC, 0xF, false)));
    return __int_as_float(__builtin_amdgcn_readlane(__float_as_int(v), 63));
}
#define DPPF(old_, v_, ctrl_, rm_, bc_) __int_as_float(__builtin_amdgcn_update_dpp((old_), __float_as_int(v_), (ctrl_), (rm_), 0xF, (bc_)))
__device__ __forceinline__ float wave_max_dpp_any(float v) {
    const int NI = (int)0xff800000;
    v = fmaxf(v, DPPF(NI, v, 0xB1, 0xF, false)); v = fmaxf(v, DPPF(NI, v, 0x4E, 0xF, false)); v = fmaxf(v, DPPF(NI, v, 0x141, 0xF, false)); v = fmaxf(v, DPPF(NI, v, 0x140, 0xF, false));
    v = fmaxf(v, DPPF(NI, v, 0x142, 0xA, false)); v = fmaxf(v, DPPF(NI, v, 0x143, 0xC, false));
    return __int_as_float(__builtin_amdgcn_readlane(__float_as_int(v), 63));
}
__device__ __forceinline__ float wave_scan_sum_dpp(float v) {
    v += DPPF(0, v, 0x111, 0xF, true); v += DPPF(0, v, 0x112, 0xF, true); v += DPPF(0, v, 0x114, 0xF, true); v += DPPF(0, v, 0x118, 0xF, true);
    v += DPPF(0, v, 0x142, 0xA, false); v += DPPF(0, v, 0x143, 0xC, false);
    return v;
}
__device__ __forceinline__ float wave_scan_max_dpp(float v) {
    const int NI = (int)0xff800000;
    v = fmaxf(v, DPPF(NI, v, 0x111, 0xF, false)); v = fmaxf(v, DPPF(NI, v, 0x112, 0xF, false)); v = fmaxf(v, DPPF(NI, v, 0x114, 0xF, false)); v = fmaxf(v, DPPF(NI, v, 0x118, 0xF, false));
    v = fmaxf(v, DPPF(NI, v, 0x142, 0xA, false)); v = fmaxf(v, DPPF(NI, v, 0x143, 0xC, false));
    return v;
}
__device__ __forceinline__ float sum8_dpp(float v) { v += DPPF(0, v, 0xB1, 0xF, true); v += DPPF(0, v, 0x4E, 0xF, true); v += DPPF(0, v, 0x141, 0xF, true); return v; }
__device__ __forceinline__ float sum16_dpp(float v) { v += DPPF(0, v, 0xB1, 0xF, true); v += DPPF(0, v, 0x4E, 0xF, true); v += DPPF(0, v, 0x141, 0xF, true); v += DPPF(0, v, 0x140, 0xF, true); return v; }
__device__ __forceinline__ float sum_halves(float v) { auto r_ = __builtin_amdgcn_permlane32_swap(__float_as_uint(v), __float_as_uint(v), false, false); return __uint_as_float(r_[0]) + __uint_as_float(r_[1]); }
__device__ __forceinline__ unsigned pk4_i8(float a, float b, float c, float d) {
    const float MG = 12582912.0f;
    const unsigned ua = __float_as_uint(a + MG), ub = __float_as_uint(b + MG), uc = __float_as_uint(c + MG), ud = __float_as_uint(d + MG);
    return __builtin_amdgcn_perm(ub, ua, 0x0c0c0400u) | __builtin_amdgcn_perm(ud, uc, 0x04000c0cu);
}
__device__ __forceinline__ float wave_max(float v, int lane) {
#pragma unroll
    for (int o = 1; o < 64; o <<= 1) v = fmaxf(v, lx_xor(v, o, lane));
    return v;
}
__device__ __forceinline__ float bf2f(unsigned short b) { return __uint_as_float((unsigned)b << 16); }
__device__ __forceinline__ float bflo(unsigned w) { return __uint_as_float(w << 16); }
__device__ __forceinline__ float bfhi(unsigned w) { return __uint_as_float(w & 0xffff0000u); }

__device__ __forceinline__ void p_ada(Frame& F) {
    LAS float* cact = (LAS float*)(F.lds);
    LAS float* red = (LAS float*)(F.lds + 16384);
    for (int i = F.tid; i < NB * DM; i += NWAVES * 64) { const float v = F.in(1)[i]; cact[i] = v / (1.0f + __expf(-v)); }
    __syncthreads();
    float* mod = (float*)(F.ws + WS_MOD);
    for (int item = F.bx; item < DEPTH * 48; item += F.G) {
        const int l = item / 48, col0 = (item % 48) * 128, q = F.tid & 31, kg = F.tid >> 5;
        const float* w = F.in(3) + ((size_t)l * DM + kg * 64) * (6 * DM) + col0 + 4 * q;
        f32x4 acc[4];
#pragma unroll
        for (int b = 0; b < 4; ++b) acc[b] = (f32x4){0.f, 0.f, 0.f, 0.f};
#pragma unroll 8
        for (int k = 0; k < 64; ++k) { const f32x4 wv = *(const GAS f32x4*)(w + (size_t)k * (6 * DM));
#pragma unroll
            for (int b = 0; b < 4; ++b) acc[b] += cact[b * DM + kg * 64 + k] * wv; }
#pragma unroll
        for (int b = 0; b < 4; ++b) *(LAS f32x4*)&red[(kg * 4 + b) * 128 + 4 * q] = acc[b];
        __syncthreads();
        { const int b = F.tid >> 7, ci = F.tid & 127; float s = 0.f;
#pragma unroll
          for (int g = 0; g < 16; ++g) s += red[(g * 4 + b) * 128 + ci];
          mod[(size_t)(l * NB + b) * (6 * DM) + col0 + ci] = s + F.in(4)[l * (6 * DM) + col0 + ci]; }
        __syncthreads();
    }
}
__device__ __forceinline__ void tr_item(const float* W, int ldw, int N, int K, bf16* WT, int rstride, int roff, LAS float* scr, int item, int lane) {
    const int nblk = N / 32, kb = item / nblk, nb = item % nblk, k0 = 64 * kb, n0 = 32 * nb;
    float wv[32];
#pragma unroll
    for (int i = 0; i < 32; ++i) wv[i] = W[(size_t)(k0 + 2 * i + (lane >> 5)) * ldw + n0 + (lane & 31)];
#pragma unroll
    for (int i = 0; i < 32; ++i) scr[(2 * i + (lane >> 5)) * 33 + (lane & 31)] = wv[i];
    LDS_WAIT(); asm volatile("" ::: "memory");
    const int c = lane & 7;
#pragma unroll
    for (int j = 0; j < 4; ++j) { const int n = (lane >> 3) + 8 * j; const LAS float* s = scr + (8 * c) * 33 + n;
        v4u o; o.x = pk2(s[0 * 33], s[1 * 33]); o.y = pk2(s[2 * 33], s[3 * 33]); o.z = pk2(s[4 * 33], s[5 * 33]); o.w = pk2(s[6 * 33], s[7 * 33]);
        const int nn = n0 + n, orow = (nn >> 7) * rstride + roff + (nn & 127);
        *(GAS v4u*)(WT + (size_t)orow * K + k0 + 8 * c) = o; }
    LDS_WAIT(); asm volatile("" ::: "memory");
}
__device__ __forceinline__ unsigned pk4_fp8(float a, float b, float c, float d) {
    a = fminf(fmaxf(a, -448.f), 448.f); b = fminf(fmaxf(b, -448.f), 448.f); c = fminf(fmaxf(c, -448.f), 448.f); d = fminf(fmaxf(d, -448.f), 448.f);
    int w = __builtin_amdgcn_cvt_pk_fp8_f32(a, b, 0, false); w = __builtin_amdgcn_cvt_pk_fp8_f32(c, d, w, true); return (unsigned)w;
}
__device__ __forceinline__ void tr_item_fp8(const float* W, int ldw, int N, int K, unsigned char* WT, int rstride, int roff, LAS float* scr, int item, int lane, float sc) {
    const int nblk = N / 32, kb = item / nblk, nb = item % nblk, k0 = 64 * kb, n0 = 32 * nb;
    float wv[32];
#pragma unroll
    for (int i = 0; i < 32; ++i) wv[i] = W[(size_t)(k0 + 2 * i + (lane >> 5)) * ldw + n0 + (lane & 31)];
#pragma unroll
    for (int i = 0; i < 32; ++i) scr[(2 * i + (lane >> 5)) * 33 + (lane & 31)] = wv[i];
    LDS_WAIT(); asm volatile("" ::: "memory");
    const int n = lane & 31, half = lane >> 5; const LAS float* s = scr + (32 * half) * 33 + n;
    const int nn = n0 + n, orow = (nn >> 7) * rstride + roff + (nn & 127);
#pragma unroll
    for (int q = 0; q < 2; ++q) { v4u o;
        o.x = pk4_fp8(s[(16 * q + 0) * 33] * sc, s[(16 * q + 1) * 33] * sc, s[(16 * q + 2) * 33] * sc, s[(16 * q + 3) * 33] * sc);
        o.y = pk4_fp8(s[(16 * q + 4) * 33] * sc, s[(16 * q + 5) * 33] * sc, s[(16 * q + 6) * 33] * sc, s[(16 * q + 7) * 33] * sc);
        o.z = pk4_fp8(s[(16 * q + 8) * 33] * sc, s[(16 * q + 9) * 33] * sc, s[(16 * q + 10) * 33] * sc, s[(16 * q + 11) * 33] * sc);
        o.w = pk4_fp8(s[(16 * q + 12) * 33] * sc, s[(16 * q + 13) * 33] * sc, s[(16 * q + 14) * 33] * sc, s[(16 * q + 15) * 33] * sc);
        *(GAS v4u*)(WT + (size_t)orow * K + k0 + 32 * half + 16 * q) = o; }
    LDS_WAIT(); asm volatile("" ::: "memory");
}
__device__ __forceinline__ void q8_item(Frame& F, const float* W, int ldw, unsigned char* WT, float* SB, int orow0, int n0, const LAS float* KM = nullptr  ) {
    LAS float* T = (LAS float*)(F.lds); LAS float* PM = (LAS float*)(F.lds + 145920);
    const int n = F.tid & 31, t = F.tid >> 5;
    float mx = 0.f;
#pragma unroll 1
    for (int i0 = 0; i0 < 64; i0 += 32) { float wv[32];
#pragma unroll
        for (int i = 0; i < 32; ++i) wv[i] = ((const GAS float*)W)[(size_t)(t + 16 * (i0 + i)) * ldw + n0 + n];
#pragma unroll
        for (int i = 0; i < 32; ++i) { const int k = t + 16 * (i0 + i); const float v = KM ? wv[i] * KM[k] : wv[i]; T[k * 32 + (n ^ (k & 31))] = v; mx = fmaxf(mx, fabsf(v)); } }
    PM[t * 32 + n] = mx;
    __syncthreads();
    float cm = 0.f;
#pragma unroll
    for (int g = 0; g < 16; ++g) cm = fmaxf(cm, PM[g * 32 + n]);
    const float inv = cm > 0.f ? 127.0f / cm : 0.f;
    unsigned char* dst = WT + (size_t)(orow0 + n) * 1024 + 64 * t;
#pragma unroll
    for (int q = 0; q < 4; ++q) { v4u o; unsigned w_[4];
#pragma unroll
        for (int d = 0; d < 4; ++d) { const int k = 64 * t + 16 * q + 4 * d;
            w_[d] = pk4_i8(T[k * 32 + (n ^ (k & 31))] * inv, T[(k + 1) * 32 + (n ^ ((k + 1) & 31))] * inv, T[(k + 2) * 32 + (n ^ ((k + 2) & 31))] * inv, T[(k + 3) * 32 + (n ^ ((k + 3) & 31))] * inv); }
        o.x = w_[0]; o.y = w_[1]; o.z = w_[2]; o.w = w_[3];
        *(GAS v4u*)(dst + 16 * q) = o; }
    if (t == 0) SB[orow0 + n] = cm * (1.0f / 127.0f);
    __syncthreads();
}
constexpr int TRI = 1792;
__device__ __forceinline__ void p_convert_dense(Frame& F) {
    {
        LAS float* scr = (LAS float*)(F.lds + RING_OFF + F.wave * 16384);
        const int gw = F.vcu * NWAVES + F.wave, NGW = F.G * NWAVES;
        constexpr int N1 = DEPTH * 512, N2 = 2 * TRI;
        for (int it = gw; it < N1 + N2; it += NGW) {
            if (it < N1) { }
            else { const int r0 = it - N1, j = r0 / TRI, rr = r0 % TRI; tr_item_fp8(F.in(16) + (size_t)j * DFF * DM, DM, DM, DFF, (unsigned char*)(F.ws + WS_WDN) + (size_t)j * DM * DFF, 128, 0, scr, rr, F.lane, W8D_SCALE); }
        }
    }
    __syncthreads();
    {   LAS float* KM = (LAS float*)(F.lds + 145920 + 2048); LAS float* BS = (LAS float*)(F.lds + 145920 + 2048 + 4096);
        for (int it = F.bx; it < DEPTH * 32; it += F.G) { const int l = it / 32, nb = it % 32;
            { const int blk = F.wave;
              const float li = 0.8f - 0.6f * expf(-0.3f * (float)l);
              const float g0 = (blk < 4) ? F.in(11)[(size_t)l * 128 + F.lane] * (1.0f - li) : F.in(12)[(size_t)l * 512 + (blk - 4) * 128 + F.lane];
              const float g1 = (blk < 4) ? F.in(11)[(size_t)l * 128 + 64 + F.lane] * (1.0f - li) : F.in(12)[(size_t)l * 512 + (blk - 4) * 128 + 64 + F.lane];
              const float bs = wave_max_dpp(fmaxf(fabsf(g0), fabsf(g1))) * (8.0f / 127.0f);
              if (F.lane == 0) { BS[blk] = bs; if (nb == 0) ((float*)(F.ws + WS_SB + 409600))[l * 8 + blk] = bs; } }
            __syncthreads();
            for (int k = F.tid; k < DM; k += NWAVES * 64) KM[k] = BS[k >> 7];
            __syncthreads();
            q8_item(F, F.in(13) + (size_t)l * DM * DM, DM, (unsigned char*)(F.ws + WS_WOUT) + (size_t)l * DM * DM, (float*)(F.ws + WS_SB + 393216) + l * DM, 32 * nb, 32 * nb, KM);
        }
    }
    for (int it = F.bx; it < DEPTH * 112 + 2 * 224; it += F.G) {
        if (it < DEPTH * 112) { const int l = it / 112, nb = it % 112;
            q8_item(F, F.in(6) + (size_t)l * DM * INW, INW, (unsigned char*)(F.ws + WS_WIN) + (size_t)l * NPROJ * DM, (float*)(F.ws + WS_SB) + l * NPROJ, 32 * nb, 32 * nb); }
        else { const int r = it - DEPTH * 112, j = r / 224, which = (r % 224) / 112, nb = r % 112, nn = 32 * nb;
            q8_item(F, (which ? F.in(15) : F.in(14)) + (size_t)j * DM * DFF, DFF, (unsigned char*)(F.ws + WS_WUP) + (size_t)j * NUP * DM, (float*)(F.ws + WS_SB + 65536) + j * NUP, (nn >> 7) * 256 + which * 128 + (nn & 127), nn); }
    }
}
__device__ __forceinline__ void p_convert_moe(Frame& F, int j) {
    {   LAS float* scr = (LAS float*)(F.lds + RING_OFF + 40960 + F.wave * 8448);
        const int gw = F.vcu * NWAVES + F.wave, NGW = F.G * NWAVES;
        for (int it = gw; it < NEXP * TRI; it += NGW) { const int e = it / TRI, rr = it % TRI; const size_t we = (size_t)(j * NEXP + e);
            tr_item_fp8(F.in(20) + we * DFF * DM, DM, DM, DFF, (unsigned char*)(F.ws + WS_WMDN) + (size_t)e * DM * DFF, 128, 0, scr, rr, F.lane, W8D_SCALE); } }
    __syncthreads();
    for (int it = F.bx; it < NEXP * 224; it += F.G) { const int e = it / 224, which = (it % 224) / 112, nb = it % 112, nn = 32 * nb; const size_t we = (size_t)(j * NEXP + e);
        q8_item(F, (which ? F.in(19) : F.in(18)) + we * DM * DFF, DFF, (unsigned char*)(F.ws + WS_WMUP) + (size_t)e * NUP * DM, (float*)(F.ws + WS_SB + 131072) + e * NUP, (nn >> 7) * 256 + which * 128 + (nn & 127), nn); }
}

__device__ __forceinline__ void row_phase(Frame& F, const int l, const int mode) {
    const bool has_res = mode != 0;
    const bool moe = (l & 1) != 0;
    const int ln = (mode == 2) ? l + 1 : l;
    const bool do_norm = (mode != 2) || (l + 1 < DEPTH);
    const bool do_gates = do_norm && (mode != 1);
    const bool do_router = (mode == 1) && moe;
    const bool y_moe = (mode == 2) && moe;
    const bool x_in_f32 = (mode == 0);
    const bool x_out_f32 = (mode == 2 && l == DEPTH - 1);
    const float* xsrc = F.in(0); bf16* X16 = (bf16*)(F.ws + WS_X16);
    const float* mod = (const float*)(F.ws + WS_MOD);
    LAS float* W8 = (LAS float*)(F.lds);
    LAS int* te = (LAS int*)(F.lds + 32768);
    LAS float* tg = (LAS float*)(F.lds + 32768 + 1024);
    LAS int* tl = (LAS int*)(F.lds + 32768 + 2048);
    LAS int* lcnt = (LAS int*)(F.lds + 32768 + 3072);
    float* gate = (float*)(F.ws + WS_GATE);
    bf16* H = (bf16*)(F.ws + WS_H);
    const bf16* Y = (const bf16*)(F.ws + WS_Y);
    const int mj = l >> 1;
    gu32* gcnt = F.ctl + CW_MOECNT + 64 * mj;
    int* tok_e = (int*)(F.ws + WS_TOK); int* tok_p = (int*)(F.ws + WS_TOK + 262144); float* tok_g = (float*)(F.ws + WS_TOK + 524288);
    int* rowidx = (int*)(F.ws + WS_ROWIDX);
    if (do_gates) { for (int i = F.tid; i < DM * 8; i += NWAVES * 64) W8[i] = F.in(6)[((size_t)ln * DM + (i >> 3)) * INW + NPROJ + (i & 7)]; }
    if (do_router) { for (int i = F.tid; i < DM * 8; i += NWAVES * 64) W8[i] = F.in(17)[(size_t)mj * DM * 8 + i]; }
    if (y_moe && F.tid == 0) { int pb = 0; for (int e = 0; e < NEXP; ++e) { lcnt[16 + e] = pb; pb += (int)((gcnt[e] + 255u) >> 8) * 256; } }
    __syncthreads();
    for (int item = F.bx; item < M / 128; item += F.G) {
        const int b = item / (SEQ / 128);
        if (do_router && F.tid < 8) lcnt[F.tid] = 0;
        float ms0 = 0.f, ms1 = 0.f, mg0 = 0.f, mg1 = 0.f;
        if (y_moe && F.lane < 16) { const size_t r_ = (size_t)item * 128 + F.wave * 16 + F.lane;
            ms0 = __int_as_float(lcnt[16 + tok_e[r_ * 2]] + tok_p[r_ * 2]); ms1 = __int_as_float(lcnt[16 + tok_e[r_ * 2 + 1]] + tok_p[r_ * 2 + 1]); mg0 = tok_g[r_ * 2]; mg1 = tok_g[r_ * 2 + 1]; }
        struct RowSet { f32x4 fx[4]; v2u bx[4], y0[4], y1[4]; float g0, g1; };
#define ROW_LOAD(ii, S) do { const size_t r_ = (size_t)item * 128 + F.wave * 16 + (ii); \
            if (x_in_f32) { _Pragma("unroll") for (int j = 0; j < 4; ++j) S.fx[j] = *(const GAS f32x4*)(xsrc + r_ * DM + 4 * F.lane + 256 * j); } \
            else { _Pragma("unroll") for (int j = 0; j < 4; ++j) S.bx[j] = *(const GAS v2u*)(X16 + r_ * DM + 4 * F.lane + 256 * j); } \
            if (has_res) { if (!y_moe) { _Pragma("unroll") for (int j = 0; j < 4; ++j) S.y0[j] = *(const GAS v2u*)(Y + r_ * DM + 4 * F.lane + 256 * j); } \
                else { const size_t s0_ = (size_t)__builtin_amdgcn_readlane(__float_as_int(ms0), (ii)), s1_ = (size_t)__builtin_amdgcn_readlane(__float_as_int(ms1), (ii)); \
                    S.g0 = __int_as_float(__builtin_amdgcn_readlane(__float_as_int(mg0), (ii))); S.g1 = __int_as_float(__builtin_amdgcn_readlane(__float_as_int(mg1), (ii))); \
                    _Pragma("unroll") for (int j = 0; j < 4; ++j) { S.y0[j] = *(const GAS v2u*)(Y + s0_ * DM + 4 * F.lane + 256 * j); S.y1[j] = *(const GAS v2u*)(Y + s1_ * DM + 4 * F.lane + 256 * j); } } } } while (0)
        const float gbias_ = (do_gates && F.lane < 8) ? ((const GAS float*)F.in(7))[ln * 8 + F.lane] : 0.f;
        RowSet SA_, SB_; SA_.g0 = SA_.g1 = SB_.g0 = SB_.g1 = 0.f;
        ROW_LOAD(0, SA_); if (!x_in_f32) ROW_LOAD(1, SB_);
        f32x4 cy[4], ca[4], cb[4];
#pragma unroll
        for (int j = 0; j < 4; ++j) { const int col = 4 * F.lane + 256 * j;
            if (has_res) { const f32x4 g = *(const GAS f32x4*)(mod + (size_t)(l * NB + b) * (6 * DM) + (mode == 1 ? 2 : 5) * DM + col);
                           const f32x4 ng = *(const GAS f32x4*)(F.in(5) + (size_t)(l * 4 + (mode == 1 ? 1 : 3)) * DM + col); cy[j] = g * ng; }
            if (do_norm) { const int sub = (mode == 1) ? 1 : 0;
                           const f32x4 sc = *(const GAS f32x4*)(mod + (size_t)(ln * NB + b) * (6 * DM) + (sub ? 4 : 1) * DM + col);
                           const f32x4 sh = *(const GAS f32x4*)(mod + (size_t)(ln * NB + b) * (6 * DM) + (sub ? 3 : 0) * DM + col);
                           const f32x4 ng = *(const GAS f32x4*)(F.in(5) + (size_t)(ln * 4 + (sub ? 2 : 0)) * DM + col);
                           ca[j] = ng * (sc + 1.0f); cb[j] = sh; } }
        auto row_body = [&](const int i, RowSet& S, const int pd) __attribute__((always_inline)) {
            const int rl = F.wave * 16 + i; const size_t row = (size_t)item * 128 + rl;
            f32x4 xv[4]; v2u cy0[4], cy1[4]; const float g0 = S.g0, g1 = S.g1;
#pragma unroll
            for (int j = 0; j < 4; ++j) { if (x_in_f32) xv[j] = S.fx[j]; else { const v2u w_ = S.bx[j]; xv[j] = (f32x4){bflo(w_.x), bfhi(w_.x), bflo(w_.y), bfhi(w_.y)}; } cy0[j] = S.y0[j]; cy1[j] = S.y1[j]; }
            { const int in_ = (i + pd < 16) ? i + pd : 15; ROW_LOAD(in_, S); }
            if (has_res) {
                f32x4 yv[4];
                if (!y_moe) {
#pragma unroll
                    for (int j = 0; j < 4; ++j) { const v2u w = cy0[j]; yv[j] = (f32x4){bflo(w.x), bfhi(w.x), bflo(w.y), bfhi(w.y)}; }
                } else {
#pragma unroll
                    for (int j = 0; j < 4; ++j) { const v2u w0 = cy0[j], w1 = cy1[j];
                        yv[j] = (f32x4){g0 * bflo(w0.x) + g1 * bflo(w1.x), g0 * bfhi(w0.x) + g1 * bfhi(w1.x), g0 * bflo(w0.y) + g1 * bflo(w1.y), g0 * bfhi(w0.y) + g1 * bfhi(w1.y)}; }
                }
                float ss = 0.f;
#pragma unroll
                for (int j = 0; j < 4; ++j) ss += (yv[j].x * yv[j].x + yv[j].y * yv[j].y) + (yv[j].z * yv[j].z + yv[j].w * yv[j].w);
                const float rstd = __builtin_amdgcn_rsqf(wave_sum_dpp(ss) * (1.0f / DM) + EPS);
#pragma unroll
                for (int j = 0; j < 4; ++j) xv[j] += cy[j] * (yv[j] * rstd);
                if (x_out_f32) {
#pragma unroll
                    for (int j = 0; j < 4; ++j) *(GAS f32x4*)(F.out + row * DM + 4 * F.lane + 256 * j) = xv[j];
                } else {
#pragma unroll
                    for (int j = 0; j < 4; ++j) { v2u w; w.x = pk2(xv[j].x, xv[j].y); w.y = pk2(xv[j].z, xv[j].w); *(GAS v2u*)(X16 + row * DM + 4 * F.lane + 256 * j) = w; } }
            }
            if (!has_res) {
#pragma unroll
                for (int j = 0; j < 4; ++j) { v2u w; w.x = pk2(xv[j].x, xv[j].y); w.y = pk2(xv[j].z, xv[j].w); *(GAS v2u*)(X16 + row * DM + 4 * F.lane + 256 * j) = w; } }
            if (do_norm) {
                float ss = 0.f;
#pragma unroll
                for (int j = 0; j < 4; ++j) ss += (xv[j].x * xv[j].x + xv[j].y * xv[j].y) + (xv[j].z * xv[j].z + xv[j].w * xv[j].w);
                const float rstd = __builtin_amdgcn_rsqf(wave_sum_dpp(ss) * (1.0f / DM) + EPS);
                f32x4 hv[4];
                float am = 0.f;
#pragma unroll
                for (int j = 0; j < 4; ++j) { hv[j] = (xv[j] * rstd) * ca[j] + cb[j]; am = fmaxf(fmaxf(am, fmaxf(fabsf(hv[j].x), fabsf(hv[j].y))), fmaxf(fabsf(hv[j].z), fabsf(hv[j].w))); }
                am = wave_max_dpp(am); const float qinv = am > 0.f ? 127.0f * __builtin_amdgcn_rcpf(am) : 0.f;
#pragma unroll
                for (int j = 0; j < 4; ++j) *(GAS unsigned*)((unsigned char*)H + row * DM + 4 * F.lane + 256 * j) = pk4_i8(hv[j].x * qinv, hv[j].y * qinv, hv[j].z * qinv, hv[j].w * qinv);
                if (F.lane == 0) ((float*)(F.ws + WS_SA))[row] = am * (1.0f / 127.0f);
                if (do_gates || do_router) {
                    float a8[8];
#pragma unroll
                    for (int o = 0; o < 8; ++o) a8[o] = 0.f;
#pragma unroll
                    for (int j = 0; j < 4; ++j)
#pragma unroll
                        for (int cc = 0; cc < 4; ++cc) { const int k = 4 * F.lane + 256 * j + cc; const f32x4 w0 = *(const LAS f32x4*)&W8[k * 8], w1 = *(const LAS f32x4*)&W8[k * 8 + 4]; const float hk = hv[j][cc];
                            a8[0] += hk * w0.x; a8[1] += hk * w0.y; a8[2] += hk * w0.z; a8[3] += hk * w0.w; a8[4] += hk * w1.x; a8[5] += hk * w1.y; a8[6] += hk * w1.z; a8[7] += hk * w1.w; }
#pragma unroll
                    for (int o = 0; o < 8; ++o) a8[o] = wave_sum_dpp(a8[o]);
                    if (do_gates) {
                        float v = a8[0];
#pragma unroll
                        for (int o = 1; o < 8; ++o) v = (F.lane == o) ? a8[o] : v;
                        if (F.lane < 8) gate[row * 8 + F.lane] = v + gbias_;
                    } else {
                        int e0 = 0; float v0 = a8[0];
#pragma unroll
                        for (int o = 1; o < 8; ++o) if (a8[o] > v0) { v0 = a8[o]; e0 = o; }
                        int e1 = -1; float v1 = -INFINITY;
#pragma unroll
                        for (int o = 0; o < 8; ++o) if (o != e0 && a8[o] > v1) { v1 = a8[o]; e1 = o; }
                        const float g0 = __builtin_amdgcn_rcpf(1.0f + __expf(v1 - v0));
                        if (F.lane == 0) { te[rl * 2] = e0; te[rl * 2 + 1] = e1; tg[rl * 2] = g0; tg[rl * 2 + 1] = 1.0f - g0; }
                    }
                }
            }
        };
        if (x_in_f32) {
#pragma unroll 1
            for (int i = 0; i < 16; ++i) row_body(i, SA_, 1);
        } else {
#pragma unroll 1
            for (int i = 0; i < 16; i += 2) { row_body(i, SA_, 2); row_body(i + 1, SB_, 2); }
        }
#undef ROW_LOAD
        if (do_router) {
            __syncthreads();
            if (F.tid < 256) tl[F.tid] = __hip_atomic_fetch_add(&lcnt[te[F.tid]], 1, __ATOMIC_RELAXED, __HIP_MEMORY_SCOPE_WORKGROUP);
            __syncthreads();
            if (F.tid < 8) lcnt[8 + F.tid] = (int)__hip_atomic_fetch_add(gcnt + F.tid, (unsigned)lcnt[F.tid], __ATOMIC_RELAXED, __HIP_MEMORY_SCOPE_AGENT);
            __syncthreads();
            if (F.tid < 256) { const int e = te[F.tid], pos = lcnt[8 + e] + tl[F.tid]; const int tok = item * 128 + (F.tid >> 1);
                tok_e[tok * 2 + (F.tid & 1)] = e; tok_p[tok * 2 + (F.tid & 1)] = pos; tok_g[tok * 2 + (F.tid & 1)] = tg[F.tid]; rowidx[(size_t)e * M + pos] = tok; }
            __syncthreads();
        }
    }
}
typedef float f32x16 __attribute__((ext_vector_type(16)));
typedef short v4i16_t __attribute__((ext_vector_type(4)));
#define MFMA32(a, b, c) __builtin_amdgcn_mfma_f32_32x32x16_bf16(a, b, c, 0, 0, 0)
__device__ __forceinline__ int crow16(int r, int hi) { return (r & 3) + 8 * (r >> 2) + 4 * hi; }
constexpr float KSCALE = 0.08838834764831845f;
constexpr int ML_CW_OFF = 140288;
static_assert(ML_CW_OFF >= BIAS_OFF + 8192 && ML_CW_OFF + 5120 <= LDS_BYTES, "LDS map (conv taps)");
__device__ __forceinline__ int opq(int v) { asm volatile("" : "+v"(v)); return v; }
__device__ __forceinline__ void chunk_gates(const float fpre, int lane, float& bj) {
    float lf = fminf(fpre, 0.f) - __logf(1.0f + __expf(-fabsf(fpre)));
    bj = wave_scan_sum_dpp(lf);
}
__device__ __forceinline__ bf16x8 tr_frag(const LAS unsigned short* panel, int row0, int lane) {
    const LAS unsigned short* p = panel + (row0 + 4 * (lane >> 5) + ((lane & 15) >> 2)) * 32 + ((lane >> 4) & 1) * 16 + (lane & 3) * 4;
    const v4i16_t lo = __builtin_amdgcn_ds_read_tr16_b64_v4i16((LAS v4i16_t*)p), hi = __builtin_amdgcn_ds_read_tr16_b64_v4i16((LAS v4i16_t*)(p + 8 * 32));
    return (bf16x8){lo[0], lo[1], lo[2], lo[3], hi[0], hi[1], hi[2], hi[3]};
}
__device__ __forceinline__ void load_conv_taps(Frame& F, int l, int h) {
    LAS float* CW = (LAS float*)(F.lds + ML_CW_OFF);
    for (int i = F.tid; i < 1280; i += NWAVES * 64) {
        const int jj = i >> 8, cc = i & 255, ch = (cc < 128) ? (h * 128 + cc) : (512 + h * 128 + (cc - 128));
        CW[i] = (jj < 4) ? F.in(8)[((size_t)l * 4 + jj) * 1024 + ch] : F.in(9)[(size_t)l * 1024 + ch];
    }
}
__device__ __forceinline__ void conv8(const LAS unsigned short* XR, const LAS float* CW, int cwc, int j, int c, float (&acc)[8]) {
    { const f32x4 b0 = *(const LAS f32x4*)(CW + 1024 + cwc), b1 = *(const LAS f32x4*)(CW + 1024 + cwc + 4);
      acc[0] = b0.x; acc[1] = b0.y; acc[2] = b0.z; acc[3] = b0.w; acc[4] = b1.x; acc[5] = b1.y; acc[6] = b1.z; acc[7] = b1.w; }
#pragma unroll
    for (int jj = 0; jj < 4; ++jj) { const v4u w = *(const LAS v4u*)(XR + (j + jj) * 136 + 8 * c);
        const f32x4 t0 = *(const LAS f32x4*)(CW + jj * 256 + cwc), t1 = *(const LAS f32x4*)(CW + jj * 256 + cwc + 4);
        acc[0] += bflo(w.x) * t0.x; acc[1] += bfhi(w.x) * t0.y; acc[2] += bflo(w.y) * t0.z; acc[3] += bfhi(w.y) * t0.w;
        acc[4] += bflo(w.z) * t1.x; acc[5] += bfhi(w.z) * t1.y; acc[6] += bflo(w.w) * t1.z; acc[7] += bfhi(w.w) * t1.w; }
#pragma unroll
    for (int i = 0; i < 8; ++i) acc[i] = acc[i] * __builtin_amdgcn_rcpf(1.0f + __expf(-acc[i]));
}
struct Taps8 { float t[5][8]; };
__device__ __forceinline__ void load_taps8(Frame& F, int l, int ch0  , Taps8& T) {
#pragma unroll
    for (int jj = 0; jj < 5; ++jj) { const float* src = (jj < 4) ? F.in(8) + ((size_t)l * 4 + jj) * 1024 + ch0 : F.in(9) + (size_t)l * 1024 + ch0;
        const f32x4 a = *(const GAS f32x4*)src, b = *(const GAS f32x4*)(src + 4);
        T.t[jj][0] = a.x; T.t[jj][1] = a.y; T.t[jj][2] = a.z; T.t[jj][3] = a.w; T.t[jj][4] = b.x; T.t[jj][5] = b.y; T.t[jj][6] = b.z; T.t[jj][7] = b.w; }
}
template <int NR> __device__ __forceinline__ void conv_rows(const LAS unsigned short* XR, const Taps8& T, int j0, int c, float (&out)[NR][8]) {
    float x[NR + 3][8];
#pragma unroll
    for (int r = 0; r < NR + 3; ++r) { const v4u w = *(const LAS v4u*)(XR + (j0 + r) * 136 + 8 * c);
        x[r][0] = bflo(w.x); x[r][1] = bfhi(w.x); x[r][2] = bflo(w.y); x[r][3] = bfhi(w.y); x[r][4] = bflo(w.z); x[r][5] = bfhi(w.z); x[r][6] = bflo(w.w); x[r][7] = bfhi(w.w); }
#pragma unroll
    for (int i = 0; i < NR; ++i)
#pragma unroll
        for (int e = 0; e < 8; ++e) { float a = T.t[4][e];
#pragma unroll
            for (int jj = 0; jj < 4; ++jj) a += x[i + jj][e] * T.t[jj][e];
            out[i][e] = a * __builtin_amdgcn_rcpf(1.0f + __expf(-a)); }
}
constexpr int ML_KW_OFF = 145920;
static_assert(ML_KW_OFF >= ML_CW_OFF + 5120 + 512 && ML_KW_OFF + 16384 <= LDS_BYTES, "LDS map (mLSTM panels)");
constexpr size_t WS_GST = WS_R + 288 * MiB;
__device__ __forceinline__ void mlstm_pass1(Frame& F, const int l) {
    LAS unsigned short* KR = (LAS unsigned short*)(F.lds);
    LAS unsigned short* KW = (LAS unsigned short*)(F.lds + 18432);
    LAS unsigned short* VP = (LAS unsigned short*)(F.lds + 34816);
    LAS float* WJ = (LAS float*)(F.lds + 51200);
    const float* gate = (const float*)(F.ws + WS_GATE);
    const bf16* PJ = (const bf16*)(F.ws + WS_R);
    float* GST = (float*)(F.ws + WS_GST); float* GN = (float*)(F.ws + WS_UN);
    float* GB = (float*)(F.ws + WS_BL); float* GM = (float*)(F.ws + WS_BL + 8192);
    const int r32 = F.lane & 31, hi = F.lane >> 5;
    for (int blk = F.bx; blk < 256; blk += F.G) {
        const int bh = blk >> 4, b = bh >> 2, h = bh & 3, n0 = (blk & 15) * 8;
        __syncthreads();
        Taps8 TK; load_taps8(F, l, 512 + h * 128 + 8 * (F.tid & 15), TK);
        v4u pk[3], pv[2]; float pgf = 0.f, pgi = 0.f;
        f32x16 acc0 = {}, acc1 = {}, gna = {}; float mg = -1e30f, bsum = 0.f;
        const bf16x8 ones8 = (bf16x8){(short)0x3F80, (short)0x3F80, (short)0x3F80, (short)0x3F80, (short)0x3F80, (short)0x3F80, (short)0x3F80, (short)0x3F80};
#define LDG(basep, off) (*(const GAS v4u*)((const GAS char*)(basep) + (off)))
        const unsigned lo_lin = (unsigned)F.tid * 16u;
#define P1_LOAD(nn) do { const int n_ = (nn); const long t0_ = (long)b * SEQ + (long)n_ * 64; \
            const char* bk_ = (const char*)PJ + (4 * PJB + ((long)h * M + t0_ - 3) * 128) * 2; const char* bv_ = (const char*)PJ + (5 * PJB + ((long)h * M + t0_) * 128) * 2; \
            _Pragma("unroll") for (int s = 0; s < 3; ++s) { const int jr = (F.tid >> 4) + 32 * s; pk[s] = (v4u){0u, 0u, 0u, 0u}; \
                if ((s < 2 || F.tid < 48) && n_ * 64 + jr - 3 >= 0) pk[s] = LDG(bk_ + s * 8192, lo_lin); } \
            _Pragma("unroll") for (int s = 0; s < 2; ++s) pv[s] = LDG(bv_ + s * 8192, lo_lin); \
            if (F.wave == 0) { pgf = ((const GAS float*)gate)[(t0_ + F.lane) * 8 + 4 + h]; pgi = ((const GAS float*)gate)[(t0_ + F.lane) * 8 + h]; } } while (0)
        P1_LOAD(n0);
#pragma unroll 1
        for (int k = 0; k < 8; ++k) {
            const int n = n0 + k;
#pragma unroll
            for (int s = 0; s < 3; ++s) { const int p = F.tid + 512 * s; if (p < 1072) *(LAS v4u*)(KR + (p >> 4) * 136 + 8 * (p & 15)) = pk[s]; }
#pragma unroll
            for (int s = 0; s < 2; ++s) { const int p = F.tid + 512 * s, j = p >> 4, c = p & 15; *(LAS v4u*)(VP + (c >> 2) * 2048 + j * 32 + (c & 3) * 8) = pv[s]; }
            if (F.wave == 0) {
                float bj; const float ig = pgi; chunk_gates(pgf, F.lane, bj);
                const float blast = lx_get(bj, 63), a = blast - bj + ig, mloc = wave_max_dpp_any(a);
                const float mnew = fmaxf(blast + mg, mloc);
                WJ[F.lane] = __expf(a - mnew) * KSCALE;
                if (F.lane == 0) WJ[64] = __expf(blast + mg - mnew);
                mg = mnew; bsum += blast;
            }
            __syncthreads();
            if (k + 1 < 8) P1_LOAD(n + 1);
            { const int c = F.tid & 15, j0 = 2 * (F.tid >> 4); float kc[2][8]; conv_rows<2>(KR, TK, j0, c, kc);
#pragma unroll
              for (int i = 0; i < 2; ++i) { const float wj = WJ[j0 + i];
#pragma unroll
                for (int e = 0; e < 8; ++e) kc[i][e] *= wj;
                v4u o; o.x = pk2(kc[i][0], kc[i][1]); o.y = pk2(kc[i][2], kc[i][3]); o.z = pk2(kc[i][4], kc[i][5]); o.w = pk2(kc[i][6], kc[i][7]);
                *(LAS v4u*)(KW + (c >> 2) * 2048 + (j0 + i) * 32 + (c & 3) * 8) = o; }
            }
            __syncthreads();
            { const int dkb = F.wave & 3, dvh = F.wave >> 2; const float dec = WJ[64];
              acc0 *= dec; acc1 *= dec; gna *= dec;
#pragma unroll
              for (int ks = 0; ks < 4; ++ks) {
                  const bf16x8 a = tr_frag(KW + dkb * 2048, 16 * ks, F.lane);
                  const bf16x8 b0 = tr_frag(VP + (dvh * 2) * 2048, 16 * ks, F.lane), b1 = tr_frag(VP + (dvh * 2 + 1) * 2048, 16 * ks, F.lane);
                  acc0 = MFMA32(a, b0, acc0); acc1 = MFMA32(a, b1, acc1); gna = MFMA32(a, ones8, gna); } }
            __syncthreads();
        }
        { const int dkb = F.wave & 3, dvh = F.wave >> 2; float* g = GST + (size_t)blk * 16384;
#pragma unroll
          for (int r = 0; r < 16; ++r) { const int dk = dkb * 32 + crow16(r, hi); g[dk * 128 + dvh * 64 + r32] = acc0[r]; g[dk * 128 + dvh * 64 + 32 + r32] = acc1[r]; }
          if (dvh == 0 && r32 == 0) {
#pragma unroll
              for (int r = 0; r < 16; ++r) GN[(size_t)blk * 128 + dkb * 32 + crow16(r, hi)] = gna[r]; }
          if (F.tid == 0) { GB[blk] = bsum; GM[blk] = mg; } }
#undef P1_LOAD
#undef LDG
    }
}
__device__ __forceinline__ void mlstm_pass2(Frame& F) {
    LAS float* DEC = (LAS float*)(F.lds); LAS float* WN = (LAS float*)(F.lds + 512);
    const float* GST = (const float*)(F.ws + WS_GST); float* CST = (float*)(F.ws + WS_GST + 16 * MiB);
    const float* GN = (const float*)(F.ws + WS_UN); float* CN = (float*)(F.ws + WS_NP);
    const float* GB = (const float*)(F.ws + WS_BL); const float* GM = (const float*)(F.ws + WS_BL + 8192); float* CM = (float*)(F.ws + WS_BL + 16384);
    for (int item = F.bx; item < 256; item += F.G) {
        const int bh = item >> 4, seg = item & 15;
        __syncthreads();
        if (F.wave == 0) {
            const int l16 = F.lane & 15;
            const float blv = ((const GAS float*)GB)[bh * 16 + l16], mlv = ((const GAS float*)GM)[bh * 16 + l16];
            float m = 0.f, decv = 0.f, wnv = 0.f, cmv = 0.f;
#pragma unroll
            for (int g = 0; g < 16; ++g) { const float bl = lx_get(blv, g), ml = lx_get(mlv, g), mn = fmaxf(bl + m, ml);
                const float d_ = __expf(bl + m - mn), w_ = __expf(ml - mn);
                if (F.lane == g) { decv = d_; wnv = w_; cmv = m; }
                m = mn; }
            if (F.lane < 16) { DEC[F.lane] = decv; WN[F.lane] = wnv; if (seg == 0) CM[bh * 16 + F.lane] = cmv; } }
        __syncthreads();
        { const size_t e0 = (size_t)seg * 1024 + 2 * F.tid; const float* u = GST + (size_t)bh * 16 * 16384 + e0; float* cp = CST + (size_t)bh * 16 * 16384 + e0;
          v2f uv[16];
#pragma unroll
          for (int g = 0; g < 16; ++g) uv[g] = *(const GAS v2f*)(u + (size_t)g * 16384);
          float c0 = 0.f; asm volatile("" : "+v"(c0)); float c1 = c0;
#pragma unroll
          for (int g = 0; g < 16; ++g) { *(GAS v2f*)(cp + (size_t)g * 16384) = (v2f){c0, c1}; const float d = DEC[g], w = WN[g]; c0 = c0 * d + uv[g].x * w; c1 = c1 * d + uv[g].y * w; } }
        if (F.tid < 8) { const int dk = seg * 8 + F.tid; float nv = 0.f; float gv[16];
#pragma unroll
            for (int g = 0; g < 16; ++g) gv[g] = ((const GAS float*)GN)[((size_t)bh * 16 + g) * 128 + dk];
#pragma unroll
            for (int g = 0; g < 16; ++g) { const size_t idx = ((size_t)bh * 16 + g) * 128 + dk; ((GAS float*)CN)[idx] = nv; nv = DEC[g] * nv + WN[g] * gv[g]; } }
    }
}
#if PROBE_TIMER
#define TSTF(cat) do { if (threadIdx.x == 0) { volatile LAS unsigned* TA_ = (volatile LAS unsigned*)(F.lds + LDSCTL_OFF + 64); const unsigned t_ = (unsigned)__builtin_amdgcn_s_memrealtime(); TA_[cat] += t_ - TA_[32]; TA_[32] = t_; } } while (0)
#else
#define TSTF(cat) do { } while (0)
#endif
__device__ __forceinline__ void mlstm_pass3(Frame& F, const int l) {
    LAS unsigned short* QR = (LAS unsigned short*)(F.lds);
    LAS unsigned short* KR = (LAS unsigned short*)(F.lds + 18432);
    LAS float* HM = (LAS float*)(F.lds);
    LAS unsigned short* QS = (LAS unsigned short*)(F.lds + 36864);
    LAS unsigned short* KS = (LAS unsigned short*)(F.lds + 54272);
    LAS unsigned short* VP = (LAS unsigned short*)(F.lds + 71680);
    LAS unsigned short* CPS = (LAS unsigned short*)(F.lds + 88064);
    LAS float* NPS = (LAS float*)(F.lds + 122880);
    LAS float* MROW = (LAS float*)(F.lds + 123392);
    LAS float* WJ = (LAS float*)(F.lds + 124416);
    LAS float* WSCR = (LAS float*)(F.lds + 124672) + F.wave * 64;
    LAS unsigned short* KW = (LAS unsigned short*)(F.lds + ML_KW_OFF);
    const LAS float* CW = (const LAS float*)(F.lds + ML_CW_OFF);
    const float* gate = (const float*)(F.ws + WS_GATE);
    const bf16* PJ = (const bf16*)(F.ws + WS_R);
    const float* CST = (const float*)(F.ws + WS_GST + 16 * MiB); const float* CN = (const float*)(F.ws + WS_NP);
    const float* CM = (const float*)(F.ws + WS_BL + 16384);
    bf16* MIXED = (bf16*)(F.ws + WS_R + 224 * MiB);
    for (int blk = F.bx; blk < 256; blk += F.G) {
        const int bh = blk >> 4, b = bh >> 2, h = bh & 3, n0 = (blk & 15) * 8;
        __syncthreads();
        load_conv_taps(F, l, h);
        v4u pq[3], pk[3], pv[2], po[2]; float pgf = 0.f, pgi = 0.f;
        f32x16 acc0, acc1, gna; float mst = 0.f;
        const bf16x8 ones8 = (bf16x8){(short)0x3F80, (short)0x3F80, (short)0x3F80, (short)0x3F80, (short)0x3F80, (short)0x3F80, (short)0x3F80, (short)0x3F80};
        { const int lane = opq(F.tid) & 63, r32 = lane & 31, hi = lane >> 5, dkb = F.wave & 3, dvh = F.wave >> 2; const float* g = CST + (size_t)blk * 16384;
#pragma unroll
          for (int r = 0; r < 16; ++r) { const int dk = dkb * 32 + crow16(r, hi); acc0[r] = ((const GAS float*)g)[dk * 128 + dvh * 64 + r32]; acc1[r] = ((const GAS float*)g)[dk * 128 + dvh * 64 + 32 + r32]; }
#pragma unroll
          for (int r = 0; r < 16; ++r) gna[r] = ((const GAS float*)CN)[(size_t)blk * 128 + dkb * 32 + crow16(r, hi)];
          mst = ((const GAS float*)CM)[blk]; }
        LAS float* GN = (LAS float*)(F.lds + ML_CW_OFF + 5120);
        if (F.tid < 128) GN[F.tid] = F.in(12)[(size_t)l * 512 + h * 128 + F.tid];
#define LDG(basep, off) (*(const GAS v4u*)((const GAS char*)(basep) + (off)))
#define P3_LOAD(nn) do { const int n_ = (nn); const long t0_ = (long)b * SEQ + (long)n_ * 64; const int tq_ = opq(F.tid); const unsigned lo_lin = (unsigned)tq_ * 16u; \
            const char* bq_ = (const char*)PJ + (3 * PJB + ((long)h * M + t0_ - 3) * 128) * 2; const char* bv_ = (const char*)PJ + (5 * PJB + ((long)h * M + t0_) * 128) * 2; \
            _Pragma("unroll") for (int s = 0; s < 3; ++s) { const int jr = (tq_ >> 4) + 32 * s; pq[s] = (v4u){0u, 0u, 0u, 0u}; pk[s] = (v4u){0u, 0u, 0u, 0u}; \
                if ((s < 2 || tq_ < 48) && n_ * 64 + jr - 3 >= 0) { pq[s] = LDG(bq_ + s * 8192, lo_lin); pk[s] = LDG(bq_ + PJB * 2 + s * 8192, lo_lin); } } \
            _Pragma("unroll") for (int s = 0; s < 2; ++s) pv[s] = LDG(bv_ + s * 8192, lo_lin); } while (0)
#define P3_LOAD2(nn) do { const int n_ = (nn); const long t0_ = (long)b * SEQ + (long)n_ * 64; const int tq_ = opq(F.tid); const unsigned lo_lin = (unsigned)tq_ * 16u; \
            { const char* bo_ = (const char*)PJ + (6 * PJB + ((long)h * M + t0_) * 128) * 2; po[0] = LDG(bo_, 2u * lo_lin); po[1] = LDG(bo_ + 16, 2u * lo_lin); } \
            if (F.wave == 0) { pgf = ((const GAS float*)gate)[(t0_ + tq_) * 8 + 4 + h]; pgi = ((const GAS float*)gate)[(t0_ + tq_) * 8 + h]; } } while (0)
        P3_LOAD(n0); P3_LOAD2(n0);
        float rbs_; { const float bs_ = ((const GAS float*)(F.ws + WS_SB + 409600))[l * 8 + 4 + h]; rbs_ = bs_ > 0.f ? 1.0f / bs_ : 0.f; }
#pragma unroll 1
        for (int k = 0; k < 8; ++k) {
            const int n = n0 + k; const size_t t0 = (size_t)b * SEQ + (size_t)n * 64;
            { const int tf = opq(F.tid);
#pragma unroll
            for (int s = 0; s < 3; ++s) { const int p = tf + 512 * s; if (p < 1072) { *(LAS v4u*)(QR + (p >> 4) * 136 + 8 * (p & 15)) = pq[s]; *(LAS v4u*)(KR + (p >> 4) * 136 + 8 * (p & 15)) = pk[s]; } }
#pragma unroll
            for (int s = 0; s < 2; ++s) { const int p = tf + 512 * s, j = p >> 4, c = p & 15; *(LAS v4u*)(VP + (c >> 2) * 2048 + j * 32 + (c & 3) * 8) = pv[s]; }
            { const int lane = tf & 63, r32 = lane & 31, hi = lane >> 5, dkb = F.wave & 3, dvh = F.wave >> 2;
#pragma unroll
              for (int g = 0; g < 4; ++g) { v2u w0, w1; w0.x = pk2(acc0[4 * g], acc0[4 * g + 1]); w0.y = pk2(acc0[4 * g + 2], acc0[4 * g + 3]); w1.x = pk2(acc1[4 * g], acc1[4 * g + 1]); w1.y = pk2(acc1[4 * g + 2], acc1[4 * g + 3]);
                  *(LAS v2u*)(CPS + (dvh * 64 + r32) * 136 + dkb * 32 + 8 * g + 4 * hi) = w0; *(LAS v2u*)(CPS + (dvh * 64 + 32 + r32) * 136 + dkb * 32 + 8 * g + 4 * hi) = w1; } }
            { const int lane = tf & 63, hi = lane >> 5, dkb = F.wave & 3;
              if ((F.wave >> 2) == 0 && (lane & 31) == 0) {
#pragma unroll
                  for (int r = 0; r < 16; ++r) NPS[dkb * 32 + crow16(r, hi)] = gna[r]; } } }
            const v4u o0 = po[0], o1 = po[1];
            if (F.wave == 0) { const int ln = opq(F.tid) & 63;
                float bj; const float ig = pgi; chunk_gates(pgf, ln, bj);
                const float g = ig - bj; float pm = g;
                pm = wave_scan_max_dpp(pm);
                MROW[ln] = fmaxf(mst, pm); MROW[64 + ln] = g; MROW[128 + ln] = bj;
                const float blast = lx_get(bj, 63), a = blast - bj + ig, mloc = wave_max_dpp_any(a), mnew = fmaxf(blast + mst, mloc);
                WJ[ln] = __expf(a - mnew) * KSCALE;
                if (ln == 0) { MROW[192] = mst; MROW[193] = __expf(blast + mst - mnew); }
                mst = mnew;
            }
            __syncthreads();
            if (k + 1 < 8) { P3_LOAD(n + 1); P3_LOAD2(n + 1); }
            { const int tq = opq(F.tid), qk = tq >> 8, c = tq & 15, j0 = 4 * ((tq >> 4) & 15); float oc[4][8];
              Taps8 TQK;
#pragma unroll
              for (int jj = 0; jj < 5; ++jj) { const f32x4 a = *(const LAS f32x4*)(CW + jj * 256 + qk * 128 + 8 * c), b2 = *(const LAS f32x4*)(CW + jj * 256 + qk * 128 + 8 * c + 4);
                  TQK.t[jj][0] = a.x; TQK.t[jj][1] = a.y; TQK.t[jj][2] = a.z; TQK.t[jj][3] = a.w; TQK.t[jj][4] = b2.x; TQK.t[jj][5] = b2.y; TQK.t[jj][6] = b2.z; TQK.t[jj][7] = b2.w; }
              conv_rows<4>(qk ? KR : QR, TQK, j0, c, oc);
#pragma unroll
              for (int i = 0; i < 4; ++i) { v4u o; o.x = pk2(oc[i][0], oc[i][1]); o.y = pk2(oc[i][2], oc[i][3]); o.z = pk2(oc[i][4], oc[i][5]); o.w = pk2(oc[i][6], oc[i][7]);
                *(LAS v4u*)((qk ? KS : QS) + (j0 + i) * 136 + 8 * c) = o;
                if (qk) { const float wj = WJ[j0 + i];
#pragma unroll
                    for (int e = 0; e < 8; ++e) oc[i][e] *= wj;
                    v4u ow; ow.x = pk2(oc[i][0], oc[i][1]); ow.y = pk2(oc[i][2], oc[i][3]); ow.z = pk2(oc[i][4], oc[i][5]); ow.w = pk2(oc[i][6], oc[i][7]);
                    *(LAS v4u*)(KW + (c >> 2) * 2048 + (j0 + i) * 32 + (c & 3) * 8) = ow; } }
            }
            __syncthreads();
            {
                const int lane = opq(F.tid) & 63, r32 = lane & 31, hi = lane >> 5;
                const int lb = F.wave >> 2, dvb = F.wave & 3, lrow = lb * 32 + r32;
                f32x16 st0 = {}, st1 = {}, qc = {};
                {   const LAS unsigned short* qp = QS + lrow * 136 + 8 * hi; const LAS unsigned short* kp0 = KS + r32 * 136 + 8 * hi; const LAS unsigned short* kp1 = KS + (32 + r32) * 136 + 8 * hi;
                    const LAS unsigned short* cp = CPS + (dvb * 32 + r32) * 136 + 8 * hi;
                    bf16x8 qf = *(const LAS bf16x8*)qp, k0 = *(const LAS bf16x8*)kp0, k1 = *(const LAS bf16x8*)kp1, cf = *(const LAS bf16x8*)cp;
#pragma unroll
                    for (int ks = 0; ks < 8; ++ks) {
                        bf16x8 qf2 = qf, k02 = k0, k12 = k1, cf2 = cf;
                        if (ks < 7) { qf2 = *(const LAS bf16x8*)(qp + 16 * (ks + 1)); k02 = *(const LAS bf16x8*)(kp0 + 16 * (ks + 1)); k12 = *(const LAS bf16x8*)(kp1 + 16 * (ks + 1)); cf2 = *(const LAS bf16x8*)(cp + 16 * (ks + 1)); }
                        st0 = MFMA32(k0, qf, st0);
                        st1 = MFMA32(k1, qf, st1);
                        qc = MFMA32(qf, cf, qc);
                        qf = qf2; k0 = k02; k1 = k12; cf = cf2;
                    }
                }
                const bf16x8 vf0 = tr_frag(VP + dvb * 2048, 0, lane), vf1 = tr_frag(VP + dvb * 2048, 16, lane);
                f32x4 gk[4], gk2[4];
#pragma unroll
                for (int q4 = 0; q4 < 4; ++q4) { gk[q4] = *(const LAS f32x4*)(MROW + 64 + 8 * q4 + 4 * hi); gk2[q4] = *(const LAS f32x4*)(MROW + 96 + 8 * q4 + 4 * hi); }
                const float Ml = MROW[lrow], mprev = MROW[192];
                float rs = 0.f; f32x16 hacc = {};
                {   float sw[16];
#pragma unroll
                    for (int r = 0; r < 16; ++r) { const int s = crow16(r, hi); const float v = st0[r] * KSCALE * __expf(gk[r >> 2][r & 3] - Ml); sw[r] = (s <= lrow) ? v : 0.f; rs += sw[r]; }
                    v4u pa; pa.x = pk2(sw[0], sw[1]); pa.y = pk2(sw[2], sw[3]); pa.z = pk2(sw[4], sw[5]); pa.w = pk2(sw[6], sw[7]);
                    hacc = MFMA32(__builtin_bit_cast(bf16x8, pa), vf0, hacc);
                    pa.x = pk2(sw[8], sw[9]); pa.y = pk2(sw[10], sw[11]); pa.z = pk2(sw[12], sw[13]); pa.w = pk2(sw[14], sw[15]);
                    hacc = MFMA32(__builtin_bit_cast(bf16x8, pa), vf1, hacc);
                }
                if (lb) { float sw[16];
                    const bf16x8 vf2 = tr_frag(VP + dvb * 2048, 32, lane), vf3 = tr_frag(VP + dvb * 2048, 48, lane);
#pragma unroll
                    for (int r = 0; r < 16; ++r) { const int s = 32 + crow16(r, hi); const float v = st1[r] * KSCALE * __expf(gk2[r >> 2][r & 3] - Ml); sw[r] = (s <= lrow) ? v : 0.f; rs += sw[r]; }
                    v4u pa; pa.x = pk2(sw[0], sw[1]); pa.y = pk2(sw[2], sw[3]); pa.z = pk2(sw[4], sw[5]); pa.w = pk2(sw[6], sw[7]);
                    hacc = MFMA32(__builtin_bit_cast(bf16x8, pa), vf2, hacc);
                    pa.x = pk2(sw[8], sw[9]); pa.y = pk2(sw[10], sw[11]); pa.z = pk2(sw[12], sw[13]); pa.w = pk2(sw[14], sw[15]);
                    hacc = MFMA32(__builtin_bit_cast(bf16x8, pa), vf3, hacc);
                }
                rs = sum_halves(rs);
                float qn = 0.f;
#pragma unroll
                for (int q8 = 0; q8 < 8; ++q8) { const v4u w = *(const LAS v4u*)(QS + lrow * 136 + 64 * hi + 8 * q8); const LAS float* np = NPS + 64 * hi + 8 * q8;
                    qn += bflo(w.x) * np[0] + bfhi(w.x) * np[1] + bflo(w.y) * np[2] + bfhi(w.y) * np[3] + bflo(w.z) * np[4] + bfhi(w.z) * np[5] + bflo(w.w) * np[6] + bfhi(w.w) * np[7]; }
                qn = sum_halves(qn);
                const float dec = __expf(mprev - Ml), den = dec * qn + rs, ml = MROW[128 + lrow] + Ml;
                const float inv = __builtin_amdgcn_rcpf(fmaxf(fabsf(den), __expf(-ml)));
                if (hi == 0) { WSCR[r32] = dec; WSCR[32 + r32] = inv; }
                LDS_WAIT(); asm volatile("" ::: "memory");
                f32x4 dc4[4], iv4[4];
#pragma unroll
                for (int q4 = 0; q4 < 4; ++q4) { dc4[q4] = *(const LAS f32x4*)(WSCR + 8 * q4 + 4 * hi); iv4[q4] = *(const LAS f32x4*)(WSCR + 32 + 8 * q4 + 4 * hi); }
#pragma unroll
                for (int r = 0; r < 16; ++r) { const int lr = crow16(r, hi); HM[(lb * 32 + lr) * 132 + dvb * 32 + r32] = (dc4[r >> 2][r & 3] * qc[r] + hacc[r]) * iv4[r >> 2][r & 3]; }
            }
            {
                const int lane = opq(F.tid) & 63, dkb = F.wave & 3, dvh = F.wave >> 2; const float dec = MROW[193];
                acc0 *= dec; acc1 *= dec; gna *= dec;
#pragma unroll
                for (int ks = 0; ks < 4; ++ks) {
                    const bf16x8 a = tr_frag(KW + dkb * 2048, 16 * ks, lane);
                    const bf16x8 b0 = tr_frag(VP + (dvh * 2) * 2048, 16 * ks, lane), b1 = tr_frag(VP + (dvh * 2 + 1) * 2048, 16 * ks, lane);
                    acc0 = MFMA32(a, b0, acc0); acc1 = MFMA32(a, b1, acc1); gna = MFMA32(a, ones8, gna); }
            }
            __syncthreads();
            {   const int te = opq(F.tid), lr = te >> 3, part = te & 7;
                const float ov[16] = {bflo(o0.x), bfhi(o0.x), bflo(o0.y), bfhi(o0.y), bflo(o0.z), bfhi(o0.z), bflo(o0.w), bfhi(o0.w), bflo(o1.x), bfhi(o1.x), bflo(o1.y), bfhi(o1.y), bflo(o1.z), bfhi(o1.z), bflo(o1.w), bfhi(o1.w)};
                float hv[16]; float ss = 0.f;
#pragma unroll
                for (int i = 0; i < 16; ++i) { hv[i] = HM[lr * 132 + 16 * part + i] * __builtin_amdgcn_rcpf(1.0f + __expf(-ov[i])); ss += hv[i] * hv[i]; }
                ss = sum8_dpp(ss);
                const float rstd = __builtin_amdgcn_rsqf(ss * (1.0f / 128.0f) + EPS);
                const LAS float* gn = GN + 16 * part;
                const float r2 = rstd * rbs_;
                float q[16];
#pragma unroll
                for (int i = 0; i < 16; ++i) q[i] = __builtin_amdgcn_fmed3f(hv[i] * r2 * gn[i], -127.f, 127.f);
                v4u w0; w0.x = pk4_i8(q[0], q[1], q[2], q[3]); w0.y = pk4_i8(q[4], q[5], q[6], q[7]); w0.z = pk4_i8(q[8], q[9], q[10], q[11]); w0.w = pk4_i8(q[12], q[13], q[14], q[15]);
                *(GAS v4u*)((unsigned char*)MIXED + (t0 + lr) * DM + 512 + h * 128 + 16 * part) = w0;
            }
            __syncthreads();
        }
#undef P3_LOAD
#undef P3_LOAD2
#undef LDG
    }
}
__device__ __forceinline__ void build_bias_table(Frame& F) {
    LAS float* tab = (LAS float*)(F.lds + BIAS_OFF);
    const int h = (F.vcu >> 4) & 3;
    for (int i = F.tid; i < 4 * 512; i += NWAVES * 64) { const int sft = i >> 9, j = (i & 511) + sft, d = 383 - j;
        float v = 0.f; if (j < 512 && d >= 0 && d < 128) v = (F.in(2)[T5_BUCKET[d] * 4 + h] - F.in(2)[31 * 4 + h]) * 1.4426950408889634f;
        tab[i] = v; }
    __syncthreads();
}
__device__ __forceinline__ void attn_phase_diff(Frame& F, unsigned char* lds_generic, const int l) {
    const bf16* PJ = (const bf16*)(F.ws + WS_R); bf16* AO = (bf16*)(F.ws + WS_Y); bf16* MIXED = (bf16*)(F.ws + WS_R + 224 * MiB);
    const int s = F.vcu & 15, bh = F.vcu >> 4, b = bh >> 2, hh = bh & 3;
    if (bh >= 16) return;
#pragma unroll 1
    for (int u4 = 0; u4 < 4; ++u4) {
        const int cc = u4 >> 1, qb = (u4 & 1) ? 31 - s : s, hc = hh * 2 + cc;
        const int hcn = hh * 2 + ((u4 + 1) >> 1);
        attn_body::attn_unit<8>(b, (const attn_body::bf16*)(PJ + (size_t)hc * M * 64), (const attn_body::bf16*)(PJ + PJB + (size_t)hc * M * 64), (const attn_body::bf16*)(PJ + 2 * PJB + (size_t)hh * M * 128), cc * 512 + hh * 128, qb,
                                (attn_body::bf16*)AO, (char*)lds_generic + RING_OFF, (attn_body::lds_cfptr)(F.lds + BIAS_OFF), F.tid,
                                (u4 < 3) ? (const attn_body::bf16*)(PJ + PJB + (size_t)hcn * M * 64) : (const attn_body::bf16*)nullptr, (const attn_body::bf16*)(PJ + 2 * PJB + (size_t)hh * M * 128), u4 > 0);
    }
    asm volatile("s_waitcnt vmcnt(0)" ::: "memory"); __syncthreads();
    const float lam_init = 0.8f - 0.6f * expf(-0.3f * (float)l);
    const float* lv = F.in(10) + (size_t)l * 256; const int ll = opq(F.tid) & 63;
    const float s01 = wave_sum_dpp(lv[ll] * lv[64 + ll]), s23 = wave_sum_dpp(lv[128 + ll] * lv[192 + ll]);
    const float lam = expf(s01) - expf(s23) + lam_init;
#pragma unroll 1
    for (int qi = 0; qi < 2; ++qi) {
        const int qb = qi ? 31 - s : s;
        {   const int ln = opq(F.tid) & 63, sub = ln >> 4, i16 = ln & 15;
            float gn[8];
#pragma unroll
            for (int k = 0; k < 8; ++k) gn[k] = F.in(11)[(size_t)l * 128 + 8 * i16 + k] * (1.0f - lam_init);
            const float bs_ = ((const GAS float*)(F.ws + WS_SB + 409600))[l * 8 + hh], qs = bs_ > 0.f ? 1.0f / bs_ : 0.f;
            v4u a0v[8], a1v[8];
#pragma unroll
            for (int it = 0; it < 8; ++it) { const size_t row = (size_t)b * SEQ + (size_t)qb * 256 + it * 32 + F.wave * 4 + sub;
                a0v[it] = *(const GAS v4u*)(AO + row * DM + hh * 128 + 8 * i16); a1v[it] = *(const GAS v4u*)(AO + row * DM + 512 + hh * 128 + 8 * i16); }
#pragma unroll
            for (int it = 0; it < 8; ++it) {
                const size_t row = (size_t)b * SEQ + (size_t)qb * 256 + it * 32 + F.wave * 4 + sub;
                const v4u a0 = a0v[it], a1 = a1v[it];
                const float o0[8] = {bflo(a0.x), bfhi(a0.x), bflo(a0.y), bfhi(a0.y), bflo(a0.z), bfhi(a0.z), bflo(a0.w), bfhi(a0.w)};
                const float o1[8] = {bflo(a1.x), bfhi(a1.x), bflo(a1.y), bfhi(a1.y), bflo(a1.z), bfhi(a1.z), bflo(a1.w), bfhi(a1.w)};
                float a[8]; float ss = 0.f;
#pragma unroll
                for (int k = 0; k < 8; ++k) { a[k] = o0[k] - lam * o1[k]; ss += a[k] * a[k]; }
                ss = sum16_dpp(ss);
                const float rstd = __builtin_amdgcn_rsqf(ss * (1.0f / 128.0f) + EPS);
                const float r2 = rstd * qs;
                float q[8];
#pragma unroll
                for (int k = 0; k < 8; ++k) q[k] = __builtin_amdgcn_fmed3f(a[k] * r2 * gn[k], -127.f, 127.f);
                v2u w; w.x = pk4_i8(q[0], q[1], q[2], q[3]); w.y = pk4_i8(q[4], q[5], q[6], q[7]);
                *(GAS v2u*)((unsigned char*)MIXED + row * DM + hh * 128 + 8 * i16) = w;
            }
        }
    }
}
__device__ __forceinline__ void moe_gather(Frame& F, const int mj) {
    gu32* gcnt = F.ctl + CW_MOECNT + 64 * mj;
    const bf16* H = (const bf16*)(F.ws + WS_H); bf16* HS = (bf16*)(F.ws + WS_Y); const int* rowidx = (const int*)(F.ws + WS_ROWIDX);
    unsigned cn[8]; int pb[9]; pb[0] = 0;
#pragma unroll
    for (int e = 0; e < 8; ++e) { cn[e] = gcnt[e]; pb[e + 1] = pb[e] + (int)((cn[e] + 255u) >> 8) * 256; }
    const int gw = F.vcu * NWAVES + F.wave, NGW = F.G * NWAVES;
    for (int slot0 = gw; slot0 < pb[8]; slot0 += 4 * NGW) {
        int tok[4]; bool ok[4];
#pragma unroll
        for (int u = 0; u < 4; ++u) { const int slot = slot0 + u * NGW; int e = 0, base = 0; unsigned ce = cn[0];
#pragma unroll
            for (int k = 1; k < 8; ++k) if (slot >= pb[k]) { e = k; base = pb[k]; ce = cn[k]; }
            const int pos = slot - base; ok[u] = slot < pb[8] && (unsigned)pos < ce; tok[u] = ok[u] ? ((const GAS int*)rowidx)[(size_t)e * M + pos] : 0; }
        v4u v0[4]; float sa_[4];
#pragma unroll
        for (int u = 0; u < 4; ++u) { v0[u] = (v4u){0u, 0u, 0u, 0u}; sa_[u] = 0.f;
            if (ok[u]) { v0[u] = *(const GAS v4u*)((const unsigned char*)H + (size_t)tok[u] * DM + 16 * F.lane); sa_[u] = ((const GAS float*)(F.ws + WS_SA))[tok[u]]; } }
#pragma unroll
        for (int u = 0; u < 4; ++u) { const int slot = slot0 + u * NGW; if (slot < pb[8]) {
            *(GAS v4u*)((unsigned char*)HS + (size_t)slot * DM + 16 * F.lane) = v0[u];
            if (F.lane == 0) ((GAS float*)(F.ws + WS_SA + 262144))[slot] = sa_[u]; } }
    }
}
struct Args { const float* in[21]; float* out; unsigned char* ws; int ph_lo, ph_hi; };
__global__ void __launch_bounds__(NWAVES * 64, 2) hymba_fwd(Args args) {
    extern __shared__ __attribute__((aligned(16))) unsigned char lds[];
    Frame F;
    F.lds = (LAS unsigned char*)lds;
    F.MISC = (volatile LAS unsigned*)(F.lds + MISC_OFF);
    GAS unsigned char* ws_;
    F.G = gridDim.x; F.wave0 = __builtin_amdgcn_readfirstlane((int)threadIdx.x >> 6); PHASE_BEGIN();
    F.out = (float*)(GAS float*)args.out;
    for (int u = F.tid; u < (BIAS_OFF - LDSCTL_OFF) / 4; u += NWAVES * 64) ((LAS unsigned*)(F.lds + LDSCTL_OFF))[u] = 0u;
    __syncthreads();
    XcdBarrier bar; bar.bar = (unsigned*)(F.ctl + CW_BAR); bar.x = 0; bar.st = nullptr;
    if (MK_ONE_LAUNCH) bar = xcd_barrier_post((unsigned*)(F.ctl + CW_BAR), F.MISC + 8, F.tid);
    const int lo = args.ph_lo, hi = args.ph_hi;
#if PROBE_TIMER
    volatile LAS unsigned* TACC = (volatile LAS unsigned*)(F.lds + LDSCTL_OFF + 64);
    if (threadIdx.x == 0) TACC[32] = (unsigned)__builtin_amdgcn_s_memrealtime();
#define TST(cat) do { if (threadIdx.x == 0) { const unsigned t_ = (unsigned)__builtin_amdgcn_s_memrealtime(); TACC[cat] += t_ - TACC[32]; TACC[32] = t_; } } while (0)
#else
#define TST(cat) do { } while (0)
#endif
#define IN(k) (lo <= (k) && (k) < hi)
#define SEAM(k) do { if (MK_ONE_LAUNCH && IN(k) && IN((k) + 1)) { XcdBarrier b2_ = bar; asm volatile("" : "+s"(b2_.bar)); unsigned o2_ = ~0u; asm volatile("" : "+s"(o2_)); xcd_barrier(b2_, (int)__builtin_amdgcn_mbcnt_hi(o2_, __builtin_amdgcn_mbcnt_lo(o2_, 0u)) + 64 * F.wave0); } TST(15); } while (0)
#define H ((bf16*)(F.ws + WS_H))
#define Y ((bf16*)(F.ws + WS_Y))
#define PROJ ((bf16*)(F.ws + WS_R))
#define MIXED ((bf16*)(F.ws + WS_R + 224 * MiB))
#define HID ((bf16*)(F.ws + WS_R))

    if (IN(0) && PHM(0)) { PHASE_BEGIN(); p_ada(F); p_convert_dense(F); } TST(0); SEAM(0);
    if (IN(1) && PHM(1)) { PHASE_BEGIN(); row_phase(F, 0, 0); } TST(0); SEAM(1);
#pragma unroll 1
    for (int l = 0; l < DEPTH; ++l) {
        const int pb = 2 + l * NPH; const bool moe = (l & 1) != 0; const int mj = l >> 1;
        if (IN(pb + 0) && PHM(2)) { PHASE_BEGIN();
            pg8::Gemm g{H  , (const bf16*)((const unsigned char*)(F.ws + WS_WIN) + (size_t)l * NPROJ * DM), M, NPROJ, DM / 2}; pg8::StaticOrder S; S.init(M, NPROJ, F.G, (int)F.bx);
            pg8::EpiProjHT<true> E{PROJ, M, attn_body::C2, (const float*)(F.ws + WS_SA), (const float*)(F.ws + WS_SB) + l * NPROJ};
            pg8::gemm_phase<pg8::EpiProjHT<true>, pg8::StaticOrder, PG8_ALIGN, PG8_SP2, false, true>(F.lds + RING_OFF, g, S, E, F.tid);
        } TST(1); SEAM(pb + 0);
        if (IN(pb + 1) && PHM(3)) { PHASE_BEGIN(); mlstm_pass1(F, l); } TST(2); SEAM(pb + 1);
        if (IN(pb + 2) && PHM(4)) { PHASE_BEGIN(); mlstm_pass2(F); } TST(3); SEAM(pb + 2);
        if (IN(pb + 3)) { PHASE_BEGIN(); if (PHM(5)) { if (l == 0 || !MK_ONE_LAUNCH) build_bias_table(F);        attn_phase_diff(F, lds, l); __syncthreads(); } TST(4); if (PHM(6)) mlstm_pass3(F, l); } TST(16); SEAM(pb + 3);
        if (IN(pb + 4) && PHM(8)) { PHASE_BEGIN();
            pg8::Gemm g{MIXED  , (const bf16*)((const unsigned char*)(F.ws + WS_WOUT) + (size_t)l * DM * DM), M, DM, DM / 2}; pg8::StaticOrder S; S.init(M, DM, F.G, (int)F.bx);
            pg8::EpiPlainT<true> E{Y, DM, 0, 1.f, 0, (const float*)(F.ws + WS_SB + 393216) + l * DM};
            pg8::gemm_phase<pg8::EpiPlainT<true>, pg8::StaticOrder, PG8_ALIGN, PG8_SP2, false, true>(F.lds + RING_OFF, g, S, E, F.tid);
        } TST(6); SEAM(pb + 4);
        if (IN(pb + 5)) { PHASE_BEGIN(); if (PHM(9)) row_phase(F, l, 1); TST(7); if (moe && PHM(10)) p_convert_moe(F, mj); } TST(8); SEAM(pb + 5);
        if (moe) { if (IN(pb + 6) && PHM(11)) { PHASE_BEGIN(); moe_gather(F, mj); } TST(9); SEAM(pb + 6); }
        if (IN(pb + 7)) {
            if (!moe) { if (PHM(12)) { PHASE_BEGIN();
                pg8::Gemm g{H  , (const bf16*)((const unsigned char*)(F.ws + WS_WUP) + (size_t)mj * NUP * DM), M, NUP, DM / 2}; pg8::StaticOrder S; S.init(M, NUP, F.G, (int)F.bx);
                pg8::EpiSwigluT<true, true> E{HID, DFF, 0, H8_SCALE, (const float*)(F.ws + WS_SA), (const float*)(F.ws + WS_SB + 65536) + mj * NUP};
                pg8::gemm_phase<pg8::EpiSwigluT<true, true>, pg8::StaticOrder, PG8_ALIGN, PG8_SP2, false, true>(F.lds + RING_OFF, g, S, E, F.tid);
                }
            } else if (PHM(13)) { PHASE_BEGIN(); pg8::MoeOrder S; S.init((const unsigned*)(F.ctl + CW_MOECNT + 64 * mj), NUP / 256, F.G, (int)F.bx);
                pg8::Gemm g{Y  , (const bf16*)(F.ws + WS_WMUP), MPAD, NEXP * NUP, DM / 2};
                pg8::EpiSwigluT<true, true> E8{HID, DFF, NUP / 256, H8_SCALE, (const float*)(F.ws + WS_SA + 262144), (const float*)(F.ws + WS_SB + 131072)};
                pg8::gemm_phase<pg8::EpiSwigluT<true, true>, pg8::MoeOrder, PG8_ALIGN, PG8_SP2, false, true>(F.lds + RING_OFF, g, S, E8, F.tid);
            }
        } TST(moe ? 11 : 10); SEAM(pb + 7);
        if (IN(pb + 8)) {
            if (!moe) { if (PHM(14)) { PHASE_BEGIN(); pg8::StaticOrder S; S.init(M, DM, F.G, (int)F.bx);
                pg8::EpiPlain E{Y, DM, 0, 1.f, 0};
                pg8::Gemm g{HID  , (const bf16*)((const unsigned char*)(F.ws + WS_WDN) + (size_t)mj * DM * DFF), M, DM, DFF / 2, W8D_EXP, W8D_EXP};
                pg8::gemm_phase<pg8::EpiPlain, pg8::StaticOrder, false, PG8_SP2, true>(F.lds + RING_OFF, g, S, E, F.tid);
                }
            } else if (PHM(15)) { PHASE_BEGIN(); pg8::MoeOrder S; S.init((const unsigned*)(F.ctl + CW_MOECNT + 64 * mj), DM / 256, F.G, (int)F.bx);
                pg8::EpiPlain E{Y  , DM, 0, 1.f, DM / 256};
                pg8::Gemm g{HID  , (const bf16*)(F.ws + WS_WMDN), MPAD, NEXP * DM, DFF / 2, W8D_EXP, W8D_EXP};
                pg8::gemm_phase<pg8::EpiPlain, pg8::MoeOrder, false, PG8_SP2, true>(F.lds + RING_OFF, g, S, E, F.tid);
            }
        } TST(moe ? 13 : 12); SEAM(pb + 8);
        if (IN(pb + 9) && PHM(16)) { PHASE_BEGIN(); row_phase(F, l, 2); } TST(14);
        if (l + 1 < DEPTH) SEAM(pb + 9);
    }
#if PROBE_TIMER
    if (blockIdx.x == 0) {
        __syncthreads();
        if (threadIdx.x == 0) {
            asm volatile("s_waitcnt vmcnt(0)" ::: "memory");
            unsigned sa = 0u, sd = 0u;
#pragma unroll
            for (int c = 0; c < 24; ++c) { if ((PROBE_SEL_A >> c) & 1) sa += TACC[c]; if ((PROBE_SEL_D >> c) & 1) sd += TACC[c]; }
            args.out[0] += 5.0f + (float)sa * (0.01f / PROBE_US_PER_UNIT);
            const unsigned long long t0 = __builtin_amdgcn_s_memrealtime();
            while ((unsigned)(__builtin_amdgcn_s_memrealtime() - t0) < sd) __builtin_amdgcn_s_sleep(8);
        }
    }
#endif
#undef IN
#undef SEAM
#undef H
#undef Y
#undef PROJ
#undef MIXED
#undef HID
}

extern "C" void kernel_launch(void* const* d_in, const int* in_sizes, int n_in, void* d_out, int out_size, void* d_ws, size_t ws_size, hipStream_t stream) {
    static int grid = 0;
    if (grid == 0) {
        if (n_in != 21 || out_size != M * DM || ws_size < WS_END) { fprintf(stderr, "kernel_launch: unexpected shapes (n_in %d out %d ws %zu)\n", n_in, out_size, ws_size); grid = -1; return; }
        if (hipFuncSetAttribute((const void*)hymba_fwd, hipFuncAttributeMaxDynamicSharedMemorySize, LDS_BYTES) != hipSuccess) { fprintf(stderr, "kernel_launch: hipFuncSetAttribute failed\n"); grid = -1; return; }
        int dev = 0, cus = 0, per_cu = 0;
        (void)hipGetDevice(&dev); (void)hipDeviceGetAttribute(&cus, hipDeviceAttributeMultiprocessorCount, dev);
        (void)hipOccupancyMaxActiveBlocksPerMultiprocessor(&per_cu, (const void*)hymba_fwd, NWAVES * 64, LDS_BYTES);
        (void)hipGetLastError();
        if (MK_ONE_LAUNCH && (cus < 256 || per_cu < 1)) { fprintf(stderr, "kernel_launch: needs 256 CUs with one resident workgroup each (cus %d, per_cu %d)\n", cus, per_cu); grid = -1; return; }
        grid = 256;
    }
    if (grid < 0) return;
    (void)hipMemsetAsync((char*)d_ws + WS_CTL, 0, CTL_ZERO_BYTES, stream);
    Args a{};
    for (int i = 0; i < 21; ++i) a.in[i] = (const float*)d_in[i];
    a.out = (float*)d_out; a.ws = (unsigned char*)d_ws;
#if MK_ONE_LAUNCH
    a.ph_lo = 0; a.ph_hi = PH_TOTAL;
    hipLaunchKernelGGL(hymba_fwd, dim3(grid), dim3(NWAVES * 64), LDS_BYTES, stream, a);
#else
    for (int p = 0; p < PH_TOTAL; ++p) {
        const int rel = (p - 2) % NPH, l = (p - 2) / NPH;
        if (p >= 2 && rel == 6 && !(l & 1)) continue;
        a.ph_lo = p; a.ph_hi = p + 1;
        hipLaunchKernelGGL(hymba_fwd, dim3(grid), dim3(NWAVES * 64), LDS_BYTES, stream, a);
    }
#endif
}
```
